# Optimizing an MI355X kernel written in HIP

```python
import math
import jax
import jax.numpy as jnp
from jax import lax
import numpy as np

D_MODEL = 2048
BATCH = 16
SEQ = 2048
DEPTH = 2

GRID_W = 64
CTX_LEN = 256
EPS = 1e-6
N_EVEN = (DEPTH + 1) // 2
N_ODD = DEPTH // 2

CONV_WIDTH = D_MODEL // 2
CONV_K = 3
LRU_WIDTH = D_MODEL // 2
LRU_HEADS = 8
LRU_BLOCK = LRU_WIDTH // LRU_HEADS
LRU_CONV_K = 4
LRU_C = 8.0
EVEN_IN_COLS = 3 * CONV_WIDTH + 2 * LRU_WIDTH
DIFF_HEADS = 8
DIFF_QK_DIM = 128
DIFF_V_DIM = 2 * DIFF_QK_DIM
DIFF_QK_COLS = DIFF_HEADS * 2 * DIFF_QK_DIM
DIFF_V_COLS = DIFF_HEADS * DIFF_V_DIM
ODD_IN_COLS = 2 * DIFF_QK_COLS + DIFF_V_COLS
ROPE_AXIS_DIM = DIFF_QK_DIM // 2
ROPE_BASE = 10000.0
Q_BLOCK = 128
N_EXPERTS = 16
N_GROUPS = 4
EXPERTS_PER_GROUP = N_EXPERTS // N_GROUPS
TOP_K = 2
EXPERT_FF = 1024

kernel_name = 'hybrid_conv_rglru_diffattn_moe_dit'


def _rmsnorm(x, g):
    xf = x.astype(jnp.float32)
    xf = xf * lax.rsqrt(jnp.mean(xf * xf, axis=-1, keepdims=True) + EPS)
    return (xf * g.astype(jnp.float32)).astype(x.dtype)


def _dwconv(u, w, pad):
    return lax.conv_general_dilated(
        u, w[:, None, :].astype(u.dtype), window_strides=(1,), padding=[pad],
        dimension_numbers=('NWC', 'WIO', 'NWC'), feature_group_count=u.shape[-1])


def _linear_scan(a, b, h0=None):
    if h0 is not None:
        b = b.at[:, 0].add(a[:, 0] * h0)

    def combine(left, right):
        a_l, b_l = left
        a_r, b_r = right
        return a_l * a_r, a_r * b_l + b_r

    return lax.associative_scan(combine, (a, b), axis=1)[1]


def _rglru_coeffs(u, wa, ba, wi, bi, lam):
    bsz, n, w = u.shape
    ub = u.reshape(bsz, n, LRU_HEADS, LRU_BLOCK)
    r = jax.nn.sigmoid(jnp.einsum('bshi,hij->bshj', ub, wa).reshape(bsz, n, w) + ba)
    i = jax.nn.sigmoid(jnp.einsum('bshi,hij->bshj', ub, wi).reshape(bsz, n, w) + bi)
    log_a = -LRU_C * r * jax.nn.softplus(-lam)
    a = jnp.exp(log_a)
    b = jnp.sqrt(-jnp.expm1(2.0 * log_a)) * (i * u)
    return a, b


def _bi_rglru(u_ctx, u_lat, wa, ba, wi, bi, lam):
    out_c, out_l = 0.0, 0.0
    for d in range(2):
        uc = u_ctx if d == 0 else u_ctx[:, ::-1]
        ul = u_lat if d == 0 else u_lat[:, ::-1]
        a_c, b_c = _rglru_coeffs(uc, wa[d], ba[d], wi[d], bi[d], lam[d])
        h_c = _linear_scan(a_c, b_c)
        a_l, b_l = _rglru_coeffs(ul, wa[d], ba[d], wi[d], bi[d], lam[d])
        h_l = _linear_scan(a_l, b_l, h_c[:, -1])
        if d == 1:
            h_c, h_l = h_c[:, ::-1], h_l[:, ::-1]
        out_c = out_c + h_c
        out_l = out_l + h_l
    return out_c, out_l


def _conv_lru_mixer(h_ctx, h_lat, w_in, conv_a_w, conv_b_w, conv_b_b,
                    lru_wa, lru_ba, lru_wi, lru_bi, lru_lam, w_out):
    cuts = [CONV_WIDTH, 2 * CONV_WIDTH, 3 * CONV_WIDTH, 3 * CONV_WIDTH + LRU_WIDTH]

    def branches(h):
        gb, gc, xa, yb, xb = jnp.split(h @ w_in, cuts, axis=-1)
        y_a = gb * _dwconv(gc * xa, conv_a_w, (1, 1))
        u = _dwconv(xb, conv_b_w, (2, 1)) + conv_b_b
        return y_a, jax.nn.gelu(yb), u

    ya_c, gate_c, u_c = branches(h_ctx)
    ya_l, gate_l, u_l = branches(h_lat)
    hr_c, hr_l = _bi_rglru(u_c, u_l, lru_wa, lru_ba, lru_wi, lru_bi, lru_lam)
    y_ctx = jnp.concatenate([ya_c, gate_c * hr_c], axis=-1) @ w_out
    y_lat = jnp.concatenate([ya_l, gate_l * hr_l], axis=-1) @ w_out
    return y_ctx, y_lat


def _axial_rope_tables(n_tok, dtype):
    rows = n_tok // GRID_W
    row = jnp.repeat(jnp.arange(rows, dtype=jnp.float32), GRID_W)
    col = jnp.tile(jnp.arange(GRID_W, dtype=jnp.float32), rows)
    inv = ROPE_BASE ** (-jnp.arange(0, ROPE_AXIS_DIM, 2, dtype=jnp.float32) / ROPE_AXIS_DIM)
    ang_r = row[:, None] * inv
    ang_c = col[:, None] * inv
    ang = jnp.concatenate([ang_r, ang_r, ang_c, ang_c], axis=-1)
    return jnp.cos(ang).astype(dtype), jnp.sin(ang).astype(dtype)


def _apply_axial_rope(t, cos, sin):
    half = ROPE_AXIS_DIM // 2
    tr = t.reshape(t.shape[:-1] + (2, 2, half))
    rot = jnp.stack([-tr[..., 1, :], tr[..., 0, :]], axis=-2).reshape(t.shape)
    return t * cos[:, None, None, :] + rot * sin[:, None, None, :]


def _diff_softmax_mix(q, k, v, lam):
    s = jnp.einsum('bqhmd,bkhmd->bhmqk', q, k).astype(jnp.float32) * (DIFF_QK_DIM ** -0.5)
    p = jax.nn.softmax(s, axis=-1)
    w = p[:, :, 0] - lam * p[:, :, 1]
    return jnp.einsum('bhqk,bkhe->bqhe', w.astype(v.dtype), v)


def _diff_head_out(o, g, lam_init, w_out):
    bsz, n = o.shape[0], o.shape[1]
    of = o.astype(jnp.float32)
    of = of * lax.rsqrt(jnp.mean(of * of, axis=-1, keepdims=True) + EPS)
    of = of * g.astype(jnp.float32) * (1.0 - lam_init)
    return of.astype(o.dtype).reshape(bsz, n, DIFF_V_COLS) @ w_out


def _diff_attn_mixer(h_ctx, h_lat, w_in, lq1, lk1, lq2, lk2, subln_g, w_out, lam_init, ctx_out):
    bsz, n, _ = h_lat.shape
    n_ctx = h_ctx.shape[1]
    q, k, v = jnp.split(h_lat @ w_in, [DIFF_QK_COLS, 2 * DIFF_QK_COLS], axis=-1)
    q = q.reshape(bsz, n, DIFF_HEADS, 2, DIFF_QK_DIM)
    k = k.reshape(bsz, n, DIFF_HEADS, 2, DIFF_QK_DIM)
    v = v.reshape(bsz, n, DIFF_HEADS, DIFF_V_DIM)
    cos, sin = _axial_rope_tables(n, h_lat.dtype)
    q = _apply_axial_rope(q, cos, sin)
    k = _apply_axial_rope(k, cos, sin)
    kc, vc = jnp.split(h_ctx @ w_in[:, DIFF_QK_COLS:], [DIFF_QK_COLS], axis=-1)
    kc = kc.reshape(bsz, n_ctx, DIFF_HEADS, 2, DIFF_QK_DIM)
    vc = vc.reshape(bsz, n_ctx, DIFF_HEADS, DIFF_V_DIM)
    k_all = jnp.concatenate([kc, k], axis=1)
    v_all = jnp.concatenate([vc, v], axis=1)
    lam = (jnp.exp(jnp.sum(lq1.astype(jnp.float32) * lk1.astype(jnp.float32)))
           - jnp.exp(jnp.sum(lq2.astype(jnp.float32) * lk2.astype(jnp.float32))) + lam_init)
    n_blk = n // Q_BLOCK
    qb = q.reshape(bsz, n_blk, Q_BLOCK, DIFF_HEADS, 2, DIFF_QK_DIM).swapaxes(0, 1)
    o = lax.map(lambda qi: _diff_softmax_mix(qi, k_all, v_all, lam), qb)
    o = o.swapaxes(0, 1).reshape(bsz, n, DIFF_HEADS, DIFF_V_DIM)
    y_lat = _diff_head_out(o, subln_g, lam_init, w_out)
    y_ctx = None
    if ctx_out:
        qc = (h_ctx @ w_in[:, :DIFF_QK_COLS]).reshape(bsz, n_ctx, DIFF_HEADS, 2, DIFF_QK_DIM)
        y_ctx = _diff_head_out(_diff_softmax_mix(qc, kc, vc, lam), subln_g, lam_init, w_out)
    return y_ctx, y_lat


def _moe(h, router_w, router_b, w_gate, w_up, w_down):
    n_tok = h.shape[0]
    scores = jax.nn.sigmoid((h @ router_w).astype(jnp.float32))
    sel = (scores + router_b.astype(jnp.float32)).reshape(n_tok, N_GROUPS, EXPERTS_PER_GROUP)
    grp_score = jnp.sum(lax.top_k(sel, 2)[0], axis=-1)
    g_idx = jnp.argmax(grp_score, axis=-1)
    in_grp = (jnp.arange(N_GROUPS)[None, :] == g_idx[:, None])[:, :, None]
    masked = jnp.where(in_grp, sel, -jnp.inf).reshape(n_tok, N_EXPERTS)
    _, top_idx = lax.top_k(masked, TOP_K)
    top_s = jnp.take_along_axis(scores, top_idx, axis=-1)
    gates = top_s / jnp.sum(top_s, axis=-1, keepdims=True)
    comb = jnp.sum(jax.nn.one_hot(top_idx, N_EXPERTS, dtype=jnp.float32) * gates[..., None], axis=1)
    comb = comb.astype(h.dtype)
    out = jnp.zeros_like(h)
    for e in range(N_EXPERTS):
        hid = jax.nn.silu(h @ w_gate[e]) * (h @ w_up[e])
        out = out + comb[:, e:e + 1] * (hid @ w_down[e])
    return out


def setup_inputs(seed: int = 0) -> dict:
    key = jax.random.key(seed)
    ks = iter(jax.random.split(key, 40))

    def nrm(shape, scale):
        return jax.random.normal(next(ks), shape, jnp.float32) * scale

    d = D_MODEL
    u = jax.random.uniform(next(ks), (N_EVEN, 2, LRU_WIDTH), jnp.float32, minval=0.9, maxval=0.999)
    a0 = u ** (1.0 / LRU_C)
    return {
        'x': nrm((BATCH, SEQ, d), 1.0),
        'c': nrm((BATCH, d), 1.0),
        'ctx': nrm((BATCH, CTX_LEN, d), 1.0),
        'c_ctx': nrm((d,), 1.0),
        'ada_w': nrm((DEPTH, d, 6 * d), 0.5 * d ** -0.5),
        'ada_b': nrm((DEPTH, 6 * d), 0.01),
        'norm_mix_g': 1.0 + nrm((DEPTH, d), 0.02),
        'norm_ffn_g': 1.0 + nrm((DEPTH, d), 0.02),
        'final_g': 1.0 + nrm((d,), 0.02),
        'w_in_e': nrm((N_EVEN, d, EVEN_IN_COLS), d ** -0.5),
        'conv_a_w': nrm((N_EVEN, CONV_K, CONV_WIDTH), CONV_K ** -0.5),
        'conv_b_w': nrm((N_EVEN, LRU_CONV_K, LRU_WIDTH), LRU_CONV_K ** -0.5),
        'conv_b_b': nrm((N_EVEN, LRU_WIDTH), 0.01),
        'lru_wa': nrm((N_EVEN, 2, LRU_HEADS, LRU_BLOCK, LRU_BLOCK), LRU_BLOCK ** -0.5),
        'lru_ba': nrm((N_EVEN, 2, LRU_WIDTH), 0.01),
        'lru_wi': nrm((N_EVEN, 2, LRU_HEADS, LRU_BLOCK, LRU_BLOCK), LRU_BLOCK ** -0.5),
        'lru_bi': nrm((N_EVEN, 2, LRU_WIDTH), 0.01),
        'lru_lam': jnp.log(a0) - jnp.log1p(-a0),
        'w_out_e': nrm((N_EVEN, CONV_WIDTH + LRU_WIDTH, d), (CONV_WIDTH + LRU_WIDTH) ** -0.5),
        'w_in_o': nrm((N_ODD, d, ODD_IN_COLS), d ** -0.5),
        'lam_q1': nrm((N_ODD, DIFF_QK_DIM), 0.1),
        'lam_k1': nrm((N_ODD, DIFF_QK_DIM), 0.1),
        'lam_q2': nrm((N_ODD, DIFF_QK_DIM), 0.1),
        'lam_k2': nrm((N_ODD, DIFF_QK_DIM), 0.1),
        'subln_g': 1.0 + nrm((N_ODD, DIFF_V_DIM), 0.02),
        'w_out_o': nrm((N_ODD, DIFF_V_COLS, d), DIFF_V_COLS ** -0.5),
        'router_w': nrm((d, N_EXPERTS), d ** -0.5),
        'router_b': nrm((N_EXPERTS,), 0.01),
        'exp_w_gate': nrm((DEPTH, N_EXPERTS, d, EXPERT_FF), d ** -0.5),
        'exp_w_up': nrm((DEPTH, N_EXPERTS, d, EXPERT_FF), d ** -0.5),
        'exp_w_down': nrm((DEPTH, N_EXPERTS, EXPERT_FF, d), EXPERT_FF ** -0.5),
    }


def reference(x, c, ctx, c_ctx, ada_w, ada_b, norm_mix_g, norm_ffn_g, final_g,
              w_in_e, conv_a_w, conv_b_w, conv_b_b, lru_wa, lru_ba, lru_wi, lru_bi, lru_lam, w_out_e,
              w_in_o, lam_q1, lam_k1, lam_q2, lam_k2, subln_g, w_out_o,
              router_w, router_b, exp_w_gate, exp_w_up, exp_w_down):
    d = x.shape[-1]
    silu_c = jax.nn.silu(c)
    silu_cc = jax.nn.silu(c_ctx)
    x_lat, x_ctx = x, ctx
    for l in range(DEPTH):
        last = l == DEPTH - 1
        i = l // 2
        sh1, sc1, g1, sh2, sc2, g2 = jnp.split((silu_c @ ada_w[l] + ada_b[l])[:, None, :], 6, axis=-1)
        sh1c, sc1c, g1c, sh2c, sc2c, g2c = jnp.split(silu_cc @ ada_w[l] + ada_b[l], 6, axis=-1)
        h_lat = _rmsnorm(x_lat, norm_mix_g[l]) * (1.0 + sc1) + sh1
        h_ctx = _rmsnorm(x_ctx, norm_mix_g[l]) * (1.0 + sc1c) + sh1c
        if l % 2 == 0:
            y_ctx, y_lat = _conv_lru_mixer(h_ctx, h_lat, w_in_e[i], conv_a_w[i], conv_b_w[i], conv_b_b[i],
                                           lru_wa[i], lru_ba[i], lru_wi[i], lru_bi[i], lru_lam[i], w_out_e[i])
        else:
            lam_init = 0.8 - 0.6 * math.exp(-0.3 * l)
            y_ctx, y_lat = _diff_attn_mixer(h_ctx, h_lat, w_in_o[i], lam_q1[i], lam_k1[i], lam_q2[i],
                                            lam_k2[i], subln_g[i], w_out_o[i], lam_init, not last)
        x_lat = x_lat + g1 * y_lat
        f_lat = _rmsnorm(x_lat, norm_ffn_g[l]) * (1.0 + sc2) + sh2
        if last:
            y = _moe(f_lat.reshape(-1, d), router_w, router_b, exp_w_gate[l], exp_w_up[l], exp_w_down[l])
            x_lat = x_lat + g2 * y.reshape(x_lat.shape)
        else:
            x_ctx = x_ctx + g1c * y_ctx
            f_ctx = _rmsnorm(x_ctx, norm_ffn_g[l]) * (1.0 + sc2c) + sh2c
            n_ctx_tok = f_ctx.shape[0] * f_ctx.shape[1]
            y = _moe(jnp.concatenate([f_ctx.reshape(-1, d), f_lat.reshape(-1, d)], axis=0),
                     router_w, router_b, exp_w_gate[l], exp_w_up[l], exp_w_down[l])
            x_ctx = x_ctx + g2c * y[:n_ctx_tok].reshape(x_ctx.shape)
            x_lat = x_lat + g2 * y[n_ctx_tok:].reshape(x_lat.shape)
    return _rmsnorm(x_lat, final_g)
```

```cpp
#include <hip/hip_runtime.h>
#include <cstdio>
#include <cstdint>

#ifndef MK_LAUNCHES
#define MK_LAUNCHES 0
#endif
#ifndef MK_STOP
#define MK_STOP 99
#endif
#ifndef MK_NAIVE
#define MK_NAIVE 0
#endif

#define LAS __attribute__((address_space(3)))
typedef unsigned short bf16_t;
typedef short bf16x8 __attribute__((ext_vector_type(8)));
typedef short s16x4 __attribute__((ext_vector_type(4)));
typedef float f32x4 __attribute__((ext_vector_type(4)));
typedef float f32x16 __attribute__((ext_vector_type(16)));
typedef unsigned u32x4 __attribute__((ext_vector_type(4)));
typedef unsigned u32x2 __attribute__((ext_vector_type(2)));

constexpr int D = 2048, NB = 16, SEQ = 2048, CTXL = 256;
constexpr int NLAT = NB * SEQ, NCTX = NB * CTXL, NTOK = NLAT + NCTX;
constexpr int NE = 16, FF = 1024, KVL = CTXL + SEQ;
constexpr int MODW = 6 * D;
constexpr float EPS = 1e-6f;
constexpr int NPHASE = 17;

constexpr size_t al256(size_t x) { return (x + 255) & ~(size_t)255; }
constexpr size_t WS_CTL = 0, CTL_BYTES = 65536;
constexpr int CW_BAR = 0, CW_CNT = 4096;
constexpr size_t WS_MOD = WS_CTL + CTL_BYTES;
constexpr size_t WS_ROPE = WS_MOD + al256((size_t)2 * 17 * MODW * 4);
constexpr size_t WS_GW = WS_ROPE + 16384;
constexpr size_t WS_W1 = WS_GW + (size_t)2 * 8 * 2 * 128 * 128 * 2;
constexpr size_t WS_W3 = WS_W1 + (size_t)5120 * 2048 * 2;
constexpr size_t WS_WQKV = WS_W3 + (size_t)2048 * 2048 * 2;
constexpr size_t WS_WO = WS_WQKV + (size_t)6144 * 2048 * 2;
constexpr size_t WS_WGU = WS_WO + (size_t)2048 * 2048 * 2;
constexpr size_t WS_WD = WS_WGU + (size_t)32 * 2048 * 2048 * 2;
constexpr size_t WS_XC = WS_WD + (size_t)32 * 2048 * 1024 * 2;
constexpr size_t WS_HB = WS_XC + (size_t)NCTX * D * 4;
constexpr size_t WS_R1 = WS_HB + (size_t)NTOK * D * 2;
constexpr size_t R1_BYTES = (size_t)2 * NTOK * D * 2;
constexpr size_t WS_HID = WS_R1 + R1_BYTES;
constexpr size_t HID_ROWS = 77824, HID_BYTES = HID_ROWS * FF * 2;
constexpr size_t WS_LIST = WS_HID + HID_BYTES;
constexpr size_t WS_LISTG = WS_LIST + (size_t)NE * NTOK * 4;
constexpr size_t WS_END = WS_LISTG + (size_t)NE * NTOK * 4;
constexpr size_t WS_ATTSCR = WS_WGU;
static_assert((size_t)NTOK * 1024 * 4 <= HID_BYTES && (size_t)NLAT * D * 2 <= HID_BYTES && (size_t)2 * 16 * 17 * MODW * 4 <= HID_BYTES, "HID aliases");
static_assert((size_t)256 * 65536 * 4 <= (size_t)16 * 2048 * 2048 * 2, "attention scratch fits in layer-0 expert weights");

constexpr int STAGE_BYTES = 131072;
constexpr int LX = STAGE_BYTES;
constexpr int LX_BAR = LX + 0;
constexpr int LX_PRE = LX + 64;
constexpr int LX_CNT = LX + 192;
constexpr int LX_LCNT = LX + 256;
constexpr int LX_LBASE = LX + 320;
constexpr int LX_REC = LX + 512;
constexpr int LX_RECG = LX + 2048;
constexpr int LX_MISC = LX + 4096;
constexpr int LDS_BYTES = STAGE_BYTES + 8192;
constexpr int ROWCH = 192;

struct Params { const float* in[31]; float* out; unsigned char* ws; int ph_lo, ph_hi; int fin_mode, stop; };

__device__ __forceinline__ const float* inptr(const Params& p, int i) { asm volatile("" : "+s"(i)); return p.in[i]; }
__device__ __forceinline__ unsigned cvt_pk_bf16(float lo, float hi) { unsigned r; asm("v_cvt_pk_bf16_f32 %0, %1, %2" : "=v"(r) : "v"(lo), "v"(hi)); return r; }
__device__ __forceinline__ float bflo(unsigned w) { return __uint_as_float(w << 16); }
__device__ __forceinline__ float bfhi(unsigned w) { return __uint_as_float(w & 0xffff0000u); }
__device__ __forceinline__ float bf2f(bf16_t b) { return __uint_as_float(((unsigned)b) << 16); }
__device__ __forceinline__ float fsigmoid(float x) { return __builtin_amdgcn_rcpf(1.0f + __expf(-x)); }
__device__ __forceinline__ float fsilu(float x) { return x * fsigmoid(x); }
__device__ __forceinline__ float fgelu_tanh(float x) { const float z = 1.5957691216057308f * (x + 0.044715f * x * x * x); return x * fsigmoid(z); }
__device__ __forceinline__ u32x4 pack8(const float (&v)[8]) { u32x4 w; w.x = cvt_pk_bf16(v[0], v[1]); w.y = cvt_pk_bf16(v[2], v[3]); w.z = cvt_pk_bf16(v[4], v[5]); w.w = cvt_pk_bf16(v[6], v[7]); return w; }
__device__ __forceinline__ void unpack8(const u32x4 w, float (&v)[8]) { v[0] = bflo(w.x); v[1] = bfhi(w.x); v[2] = bflo(w.y); v[3] = bfhi(w.y); v[4] = bflo(w.z); v[5] = bfhi(w.z); v[6] = bflo(w.w); v[7] = bfhi(w.w); }

#define XB_TMO      128
#define XB_XCNT(j)  (256  + 64 * (j))
#define XB_XSUB(j)  (1280 + 64 * (j))
#define XB_XGEN(j)  (2304 + 64 * (j))
#define XB_TOP      3328
#define XB_TOPGEN   3392
#define XCD_BAR_WORDS 3456
#define XB_SPIN_CAP (1u << 18)
__device__ __forceinline__ unsigned xb_ld(unsigned* p)              { return __hip_atomic_load(p, __ATOMIC_RELAXED, __HIP_MEMORY_SCOPE_AGENT); }
__device__ __forceinline__ unsigned xb_add(unsigned* p, unsigned v) { return __hip_atomic_fetch_add(p, v, __ATOMIC_RELAXED, __HIP_MEMORY_SCOPE_AGENT); }
__device__ __forceinline__ unsigned xb_xcc_id() { return (unsigned)__builtin_amdgcn_s_getreg((3 << 11) | 20) & 0xFu; }
#define XB_SPIN(cond, bar) do { unsigned _sp = 0; while (cond) { __builtin_amdgcn_s_sleep(1); \
    if ((++_sp & 255u) == 0u) { if (xb_ld(&(bar)[XB_TMO])) break; if (_sp > XB_SPIN_CAP) { atomicAdd(&(bar)[XB_TMO], 1u); break; } } } } while (0)
struct XcdBarrier { unsigned* bar; unsigned x; volatile LAS unsigned* st; };
__device__ __forceinline__ XcdBarrier xcd_barrier_post(unsigned* bar, volatile LAS unsigned* st) {
    XcdBarrier b; b.bar = bar; b.x = xb_xcc_id(); b.st = st;
    if (threadIdx.x == 0) (void)xb_add(&bar[XB_XCNT(b.x)], 1u);
    return b;
}
__device__ __forceinline__ void xcd_barrier_complete(unsigned* bar, unsigned x, unsigned& nloc, unsigned& nx) {
    const unsigned G = gridDim.x * gridDim.y * gridDim.z;
    unsigned sum, cnt, mine, sp = 0u;
    for (;;) {
        sum = 0u; cnt = 0u; mine = 0u;
#pragma unroll
        for (unsigned j = 0; j < 16; ++j) { const unsigned c = xb_ld(&bar[XB_XCNT(j)]); sum += c; cnt += (c > 0u) ? 1u : 0u; mine = (j == x) ? c : mine; }
        if (sum == G) break;
        __builtin_amdgcn_s_sleep(1);
        if ((++sp & 255u) == 0u) { if (xb_ld(&bar[XB_TMO])) break; if (sp > XB_SPIN_CAP) { atomicAdd(&bar[XB_TMO], 1u); break; } }
    }
    nloc = mine > 0u ? mine : 1u; nx = cnt > 0u ? cnt : 1u;
}
__device__ __forceinline__ void xcd_barrier(const XcdBarrier& b) {
    asm volatile("s_waitcnt vmcnt(0)" ::: "memory");
    __syncthreads();
    if (threadIdx.x == 0) {
        unsigned* bar = b.bar;
        __builtin_amdgcn_s_waitcnt(0);
        unsigned nloc = b.st[0], nx = b.st[1];
        if (nloc == 0u) { xcd_barrier_complete(bar, b.x, nloc, nx); b.st[0] = nloc; b.st[1] = nx; }
        const unsigned old = xb_add(&bar[XB_XSUB(b.x)], 1u);
        const unsigned gen = old / nloc;
        if (old + 1u == (gen + 1u) * nloc) {
            __builtin_amdgcn_fence(__ATOMIC_RELEASE, "agent");
            asm volatile("s_waitcnt vmcnt(0)" ::: "memory");
            const unsigned og = xb_add(&bar[XB_TOP], 1u);
            const unsigned tg = og / nx;
            if (og + 1u == (tg + 1u) * nx) xb_add(&bar[XB_TOPGEN], 1u);
            else XB_SPIN(xb_ld(&bar[XB_TOPGEN]) == tg, bar);
            __builtin_amdgcn_fence(__ATOMIC_ACQUIRE, "agent");
            xb_add(&bar[XB_XGEN(b.x)], 1u);
            asm volatile("s_waitcnt vmcnt(0)" ::: "memory");
        } else {
            XB_SPIN(xb_ld(&bar[XB_XGEN(b.x)]) == gen, bar);
            __builtin_amdgcn_fence(__ATOMIC_ACQUIRE, "agent");
            asm volatile("s_waitcnt vmcnt(0)" ::: "memory");
        }
    }
    __syncthreads();
}

struct Frame {
    LAS unsigned char* lds;
    int tid, lane, wave, G, bx;
    unsigned char* ws;
    float* out;
};
__device__ __forceinline__ int lane_id() { return (int)__builtin_amdgcn_mbcnt_hi(~0u, __builtin_amdgcn_mbcnt_lo(~0u, 0u)); }
__device__ __forceinline__ int tid_rebuild(int wave) { int t = wave * 64 + lane_id(); asm volatile("" : "+v"(t)); return t; }
__device__ __forceinline__ void refresh(Frame& F) { const int t = tid_rebuild(F.wave); F.tid = t; F.lane = t & 63; }
__device__ __forceinline__ int modrow_of(int t) { return t < NLAT ? (t >> 11) : 16; }

constexpr int XT_W1 = 20 * 32, XT_W3 = 8 * 32, XT_WQKV = 24 * 32, XT_WO = 8 * 32, XT_WGU = 32 * 8 * 32, XT_WD = 32 * 8 * 16;
constexpr int XT_TOTAL = XT_W1 + XT_W3 + XT_WQKV + XT_WO + XT_WGU + XT_WD;
constexpr int ADA_UNITS = 2 * 16 * 24;
constexpr int P0_UNITS = XT_TOTAL + ADA_UNITS + 1 + 16;

__device__ __forceinline__ void xpose_tile(const Frame& F, const float* srcg  , int ld, bf16_t* dst, int K, int rb, int kb) {
    LAS unsigned* T = (LAS unsigned*)F.lds;
    const int l = F.lane, w = F.wave, kq = l >> 3, c4 = (l & 7) * 4;
    const float* s = srcg + (size_t)(kb * 64 + 2 * kq) * ld + c4;
    f32x4 v0[4], v1[4];
#pragma unroll
    for (int it = 0; it < 4; ++it) { v0[it] = *(const f32x4*)(s + (size_t)(16 * it) * ld); v1[it] = *(const f32x4*)(s + (size_t)(16 * it + 1) * ld); }
#pragma unroll
    for (int it = 0; it < 4; ++it)
#pragma unroll
        for (int j = 0; j < 4; ++j) T[(w * 32 + c4 + j) * 36 + 8 * it + kq] = cvt_pk_bf16(v0[it][j], v1[it][j]);
    __syncthreads();
#pragma unroll
    for (int it = 0; it < 4; ++it) { const int q = F.tid + 512 * it, row = q >> 3, piece = q & 7;
        const u32x4 v = *(const LAS u32x4*)(T + row * 36 + piece * 4);
        *(u32x4*)(dst + (size_t)(rb * 256 + row) * K + kb * 64 + piece * 8) = v; }
    __syncthreads();
}

__device__ __forceinline__ void p0_prologue(const Frame& F, const Params& p) {
    unsigned char* ws = F.ws;
    for (int u = F.bx; u < P0_UNITS; u += F.G) {
        if (u < XT_TOTAL) {
            int T = u; const int gi = F.wave;
            const float* src; int ld, col0, K, rb, kb; bf16_t* dst;
            if (T < XT_W1) { rb = T >> 5; kb = T & 31; K = 2048; ld = 5120; src = inptr(p, 9); dst = (bf16_t*)(ws + WS_W1);
                col0 = rb < 8 ? (gi < 4 ? 1024 + rb * 128 + gi * 32 : 2048 + rb * 128 + (gi - 4) * 32) : rb < 12 ? (rb - 8) * 256 + gi * 32 : rb < 16 ? 3072 + (rb - 12) * 256 + gi * 32 : 4096 + (rb - 16) * 256 + gi * 32; }
            else if ((T -= XT_W1) < XT_W3) { rb = T >> 5; kb = T & 31; K = 2048; ld = 2048; src = inptr(p, 18); dst = (bf16_t*)(ws + WS_W3); col0 = rb * 256 + gi * 32; }
            else if ((T -= XT_W3) < XT_WQKV) { rb = T >> 5; kb = T & 31; K = 2048; ld = 6144; src = inptr(p, 19); dst = (bf16_t*)(ws + WS_WQKV);
                if (rb < 16) { const int part = rb >> 3, head = rb & 7, g4 = gi & 3, m = g4 >> 1, a = g4 & 1; col0 = part * 2048 + head * 256 + m * 128 + a * 64 + (gi >= 4 ? 32 : 0); }
                else col0 = 4096 + (rb - 16) * 256 + gi * 32; }
            else if ((T -= XT_WQKV) < XT_WO) { rb = T >> 5; kb = T & 31; K = 2048; ld = 2048; src = inptr(p, 25); dst = (bf16_t*)(ws + WS_WO); col0 = rb * 256 + gi * 32; }
            else if ((T -= XT_WO) < XT_WGU) { const int le = T >> 8; rb = (T >> 5) & 7; kb = T & 31; K = 2048; ld = 1024;
                src = (gi < 4 ? inptr(p, 28) : inptr(p, 29)) + (size_t)le * 2048 * 1024; col0 = rb * 128 + (gi & 3) * 32; dst = (bf16_t*)(ws + WS_WGU) + (size_t)le * 2048 * 2048; }
            else { T -= XT_WGU; const int le = T >> 7; rb = (T >> 4) & 7; kb = T & 15; K = 1024; ld = 2048;
                src = inptr(p, 30) + (size_t)le * 1024 * 2048; col0 = rb * 256 + gi * 32; dst = (bf16_t*)(ws + WS_WD) + (size_t)le * 2048 * 1024; }
            xpose_tile(F, src + col0, ld, dst, K, rb, kb);
        } else if (u < XT_TOTAL + ADA_UNITS) {
            const int a = u - XT_TOTAL, l = a / 384, rem = a % 384, kc = rem / 24, cb = rem % 24;
            LAS float* sl = (LAS float*)F.lds;
            const float* cin = inptr(p, 1); const float* cctx = inptr(p, 3);
            for (int i = F.tid; i < 17 * 128; i += 512) { const int r = i >> 7, k = i & 127; const float cv = r < 16 ? cin[r * D + kc * 128 + k] : cctx[kc * 128 + k]; sl[i] = cv / (1.0f + expf(-cv)); }
            __syncthreads();
            const int col = cb * 512 + F.tid;
            const float* wp = inptr(p, 4) + ((size_t)l * D + kc * 128) * MODW + col;
            float acc[17];
#pragma unroll
            for (int r = 0; r < 17; ++r) acc[r] = 0.f;
            for (int k0 = 0; k0 < 128; k0 += 8) {
                float wv[8];
#pragma unroll
                for (int j = 0; j < 8; ++j) wv[j] = wp[(size_t)(k0 + j) * MODW];
#pragma unroll
                for (int r = 0; r < 17; ++r) { const f32x4 s0 = *(const LAS f32x4*)(sl + r * 128 + k0), s1 = *(const LAS f32x4*)(sl + r * 128 + k0 + 4);
                    acc[r] += s0[0] * wv[0] + s0[1] * wv[1] + s0[2] * wv[2] + s0[3] * wv[3] + s1[0] * wv[4] + s1[1] * wv[5] + s1[2] * wv[6] + s1[3] * wv[7]; }
            }
            float* part = (float*)(ws + WS_HID) + ((size_t)(l * 16 + kc) * 17) * MODW + col;
#pragma unroll
            for (int r = 0; r < 17; ++r) part[(size_t)r * MODW] = acc[r];
            __syncthreads();
        } else if (u == XT_TOTAL + ADA_UNITS) {
            float* rc = (float*)(ws + WS_ROPE); float* rs = rc + 2048;
            for (int i = F.tid; i < 2048; i += 512) { const int pos = i >> 5, j = i & 31;
                const float inv = exp2f(-(float)(2 * j) * (13.287712379549449f / 64.0f)); const float ang = (float)pos * inv;
                rc[i] = cosf(ang); rs[i] = sinf(ang); }
        } else {
            const int q = u - (XT_TOTAL + ADA_UNITS + 1), d = q >> 3, h = q & 7;
            bf16_t* gw = (bf16_t*)(ws + WS_GW) + (size_t)(d * 8 + h) * 2 * 128 * 128;
            const float* wa = inptr(p, 13) + (size_t)(d * 8 + h) * 128 * 128; const float* wi = inptr(p, 15) + (size_t)(d * 8 + h) * 128 * 128;
            for (int i = F.tid; i < 128 * 128; i += 512) { const int k = i >> 7, j = i & 127, half = j >> 6, o = j & 63;
                gw[(size_t)(half * 128 + o) * 128 + k] = (bf16_t)(cvt_pk_bf16(wa[i], 0.f) & 0xffffu);
                gw[(size_t)(half * 128 + 64 + o) * 128 + k] = (bf16_t)(cvt_pk_bf16(wi[i], 0.f) & 0xffffu); }
        }
    }
}

__device__ __forceinline__ void p1_modreduce(const Frame& F, const Params& p) {
    const float* part = (const float*)(F.ws + WS_HID); float* mod = (float*)(F.ws + WS_MOD);
    const int n4 = 2 * 17 * MODW / 4; const float* adab = inptr(p, 5);
    for (int i = F.bx * 512 + F.tid; i < n4; i += F.G * 512) {
        const int e = i * 4, l = e / (17 * MODW), rr = (e / MODW) % 17, n = e % MODW;
        f32x4 s = *(const f32x4*)(adab + (size_t)l * MODW + n);
#pragma unroll
        for (int kc = 0; kc < 16; ++kc) s += *(const f32x4*)(part + ((size_t)(l * 16 + kc) * 17 + rr) * MODW + n);
        *(f32x4*)(mod + e) = s;
    }
}

template <int MODE>
__device__ __forceinline__ void row_phase(const Frame& F, const Params& p, const int l, const int fin_mode) {
    unsigned char* ws = F.ws;
    const float* mod = (const float*)(ws + WS_MOD);
    bf16_t* HB = (bf16_t*)(ws + WS_HB);
    float* XC = (float*)(ws + WS_XC);
    const bf16_t* Y0 = (const bf16_t*)(ws + WS_R1); const bf16_t* Y1 = Y0 + (size_t)NTOK * D;
    const int nrows = (MODE == 3 || (MODE == 1 && l == 1)) ? NLAT : NTOK;
    const int chunk = (nrows + F.G - 1) / F.G, r_begin = F.bx * chunk, r_end = min(nrows, r_begin + chunk);
    const int lane = F.lane, w = F.wave;
    LAS float* wl = (LAS float*)F.lds;
    LAS int* lcnt = (LAS int*)(F.lds + LX_LCNT); LAS int* lbase = (LAS int*)(F.lds + LX_LBASE);
    LAS int* rec = (LAS int*)(F.lds + LX_REC); LAS float* recg = (LAS float*)(F.lds + LX_RECG);
    LAS float* rbl = (LAS float*)(F.lds + LX_MISC);
    if (MODE == 1) {
        const float* rw = inptr(p, 26);
        for (int i = F.tid; i < 2048 * 16; i += 512) { const int k = i >> 4, e = i & 15; wl[e * 2048 + k] = rw[i]; }
        if (F.tid < 16) { lcnt[F.tid] = 0; rbl[F.tid] = inptr(p, 27)[F.tid]; }
        __syncthreads();
    }
    const float* gain = MODE == 0 ? inptr(p, 6) : MODE == 1 ? inptr(p, 7) + (size_t)l * D : MODE == 2 ? inptr(p, 6) + D : inptr(p, 8);
    const int sh_off = (MODE == 1) ? 6144 : 0, sc_off = (MODE == 1) ? 8192 : 2048;
    const int lmod = (MODE == 2) ? 1 : l;
    const float* xin0 = inptr(p, 0); const float* xin2 = inptr(p, 2);
    for (int rs = r_begin; rs < r_end; rs += ROWCH) {
        const int re = min(r_end, rs + ROWCH);
        for (int t = rs + w; t < re; t += 8) {
            const int b = modrow_of(t);
            const float* src;
            if (MODE == 0 || (MODE == 3 && fin_mode == 2)) src = t < NLAT ? xin0 + (size_t)t * D : xin2 + (size_t)(t - NLAT) * D;
            else src = t < NLAT ? F.out + (size_t)t * D : XC + (size_t)(t - NLAT) * D;
            f32x4 v[8];
#pragma unroll
            for (int j = 0; j < 8; ++j) v[j] = *(const f32x4*)(src + 256 * j + 4 * lane);
            if (MODE == 2 || (MODE == 3 && fin_mode == 0)) {
                const float* g2 = mod + ((size_t)l * 17 + b) * MODW + 10240;
#pragma unroll
                for (int j = 0; j < 8; ++j) { const int col = 256 * j + 4 * lane;
                    const u32x2 a = *(const u32x2*)(Y0 + (size_t)t * D + col), c = *(const u32x2*)(Y1 + (size_t)t * D + col);
                    const f32x4 g = *(const f32x4*)(g2 + col);
                    v[j][0] += g[0] * (bflo(a.x) + bflo(c.x)); v[j][1] += g[1] * (bfhi(a.x) + bfhi(c.x));
                    v[j][2] += g[2] * (bflo(a.y) + bflo(c.y)); v[j][3] += g[3] * (bfhi(a.y) + bfhi(c.y)); }
                if (MODE == 2) { float* dst = t < NLAT ? F.out + (size_t)t * D : XC + (size_t)(t - NLAT) * D;
#pragma unroll
                    for (int j = 0; j < 8; ++j) *(f32x4*)(dst + 256 * j + 4 * lane) = v[j]; }
            }
            float ss = 0.f;
#pragma unroll
            for (int j = 0; j < 8; ++j) ss += v[j][0] * v[j][0] + v[j][1] * v[j][1] + v[j][2] * v[j][2] + v[j][3] * v[j][3];
#pragma unroll
            for (int o = 32; o >= 1; o >>= 1) ss += __shfl_xor(ss, o);
            const float rstd = 1.0f / sqrtf(ss * (1.0f / 2048.0f) + EPS);
            if (MODE == 3) {
                float* dst = F.out + (size_t)t * D;
#pragma unroll
                for (int j = 0; j < 8; ++j) { const f32x4 g = *(const f32x4*)(gain + 256 * j + 4 * lane); *(f32x4*)(dst + 256 * j + 4 * lane) = v[j] * rstd * g; }
            } else {
                const float* shp = mod + ((size_t)lmod * 17 + b) * MODW + sh_off; const float* scp = mod + ((size_t)lmod * 17 + b) * MODW + sc_off;
#pragma unroll
                for (int j = 0; j < 8; ++j) { const int col = 256 * j + 4 * lane;
                    const f32x4 g = *(const f32x4*)(gain + col), sc = *(const f32x4*)(scp + col), sh = *(const f32x4*)(shp + col);
                    v[j] = v[j] * rstd * g * (1.0f + sc) + sh;
                    u32x2 o; o.x = cvt_pk_bf16(v[j][0], v[j][1]); o.y = cvt_pk_bf16(v[j][2], v[j][3]);
                    *(u32x2*)(HB + (size_t)t * D + col) = o; }
                if (MODE == 1) {
                    float pe[16];
#pragma unroll
                    for (int e = 0; e < 16; ++e) { float s = 0.f;
#pragma unroll
                        for (int j = 0; j < 8; ++j) { const f32x4 wv = *(const LAS f32x4*)(wl + e * 2048 + 256 * j + 4 * lane); s += v[j][0] * wv[0] + v[j][1] * wv[1] + v[j][2] * wv[2] + v[j][3] * wv[3]; }
                        pe[e] = s; }
#pragma unroll
                    for (int e = 0; e < 16; ++e) {
#pragma unroll
                        for (int o = 32; o >= 1; o >>= 1) pe[e] += __shfl_xor(pe[e], o); }
                    float scv[16], sel[16];
#pragma unroll
                    for (int e = 0; e < 16; ++e) { scv[e] = 1.0f / (1.0f + expf(-pe[e])); sel[e] = scv[e] + rbl[e]; }
                    float best = -3.0e38f, bs1 = 0.f, bs2 = 0.f; int be1 = 0, be2 = 1;
#pragma unroll
                    for (int g = 0; g < 4; ++g) {
                        const float a0 = sel[4 * g], a1 = sel[4 * g + 1], a2 = sel[4 * g + 2], a3 = sel[4 * g + 3];
                        const float c0 = scv[4 * g], c1 = scv[4 * g + 1], c2 = scv[4 * g + 2], c3 = scv[4 * g + 3];
                        int i1 = 0; float m1 = a0, s1 = c0; if (a1 > m1) { m1 = a1; i1 = 1; s1 = c1; } if (a2 > m1) { m1 = a2; i1 = 2; s1 = c2; } if (a3 > m1) { m1 = a3; i1 = 3; s1 = c3; }
                        int i2 = -1; float m2 = -3.0e38f, s2 = 0.f;
                        if (i1 != 0 && a0 > m2) { m2 = a0; i2 = 0; s2 = c0; } if (i1 != 1 && a1 > m2) { m2 = a1; i2 = 1; s2 = c1; } if (i1 != 2 && a2 > m2) { m2 = a2; i2 = 2; s2 = c2; } if (i1 != 3 && a3 > m2) { m2 = a3; i2 = 3; s2 = c3; }
                        const float gs = m1 + m2;
                        if (gs > best) { best = gs; be1 = 4 * g + i1; be2 = 4 * g + i2; bs1 = s1; bs2 = s2; }
                    }
                    if (lane == 0) { const float inv = 1.0f / (bs1 + bs2); const int rl = t - rs;
                        const int p1 = __hip_atomic_fetch_add(lcnt + be1, 1, __ATOMIC_RELAXED, __HIP_MEMORY_SCOPE_WORKGROUP), p2 = __hip_atomic_fetch_add(lcnt + be2, 1, __ATOMIC_RELAXED, __HIP_MEMORY_SCOPE_WORKGROUP);
                        rec[rl * 2] = (be1 << 16) | p1; rec[rl * 2 + 1] = (be2 << 16) | p2; recg[rl * 2] = bs1 * inv; recg[rl * 2 + 1] = bs2 * inv; }
                }
            }
        }
        if (MODE == 1) {
            __syncthreads();
            unsigned* cntg = (unsigned*)(ws + WS_CTL) + CW_CNT + l * 64;
            if (F.tid < 16) lbase[F.tid] = (int)__hip_atomic_fetch_add(cntg + F.tid, (unsigned)lcnt[F.tid], __ATOMIC_RELAXED, __HIP_MEMORY_SCOPE_AGENT);
            __syncthreads();
            int* list = (int*)(ws + WS_LIST); float* listg = (float*)(ws + WS_LISTG);
            const int nrec = (re - rs) * 2;
            for (int i = F.tid; i < nrec; i += 512) { const int rr = rec[i], e = rr >> 16, pos = lbase[e] + (rr & 0xffff); const int t = rs + (i >> 1);
                list[(size_t)e * NTOK + pos] = t * 2 + (i & 1); listg[(size_t)e * NTOK + pos] = recg[i]; }
            __syncthreads();
            if (F.tid < 16) lcnt[F.tid] = 0;
            __syncthreads();
        }
    }
}

namespace pg8 {
constexpr int BM = 256, BK = 64, HALF = 128, HTB = HALF * BK * 2, NXCD = 8, WGM = 8;
__host__ __device__ __forceinline__ int lds_byte(int r, int c) { const int st = (r >> 4) * 2 + (c >> 5), rr = r & 15, cc = c & 31, ob = rr * 64 + cc * 2; return st * 1024 + (ob ^ (((ob >> 9) & 1) << 5)); }
__host__ __device__ __forceinline__ void stage_rc(int b, int& R, int& C) { const int st = b / 1024, sb = b % 1024, swz = sb ^ (((sb >> 9) & 1) << 5); R = (st >> 1) * 16 + swz / 64; C = (st & 1) * 32 + (swz % 64) / 2; }
__host__ __device__ __forceinline__ int perm32(int rho) { const int n = rho >> 4, i = rho & 15; return 8 * (i >> 2) + 4 * n + (i & 3); }

struct Unit { int pm, pn, e, pos0, cnt; };

__device__ __forceinline__ bool static_map(long L, int nM, int nN, int& pm, int& pn) {
    const int nwg = nM * nN; if (L >= nwg) return false;
    int wgid = (int)L; { const int q = nwg / NXCD, r = nwg % NXCD, xcd = wgid % NXCD, off = wgid / NXCD; wgid = (xcd < r ? xcd * (q + 1) : r * (q + 1) + (xcd - r) * q) + off; }
    const int nig = WGM * nN, gid = wgid / nig, fm = gid * WGM, gsz = (nM - fm) < WGM ? (nM - fm) : WGM;
    pm = fm + ((wgid % nig) % gsz); pn = (wgid % nig) / gsz; return true;
}
__device__ __forceinline__ bool static_next(int i, int G, int c, int nM, int nN, int& pm, int& pn) { return static_map((long)i * G + c, nM, nN, pm, pn); }
struct DenseSched {
    static constexpr bool GATHER = false;
    const char* A; const char* B; int nM, nN, K, G, c;
    __device__ __forceinline__ bool next(int i, Unit& u) const { u.e = 0; u.pos0 = 0; u.cnt = 0; return static_next(i, G, c, nM, nN, u.pm, u.pn); }
    __device__ __forceinline__ const char* a_tile(const Unit& u) const { return A + (size_t)u.pm * 256 * K * 2; }
    __device__ __forceinline__ unsigned a_row_off(const Unit&, int r) const { return (unsigned)r * (unsigned)K * 2u; }
    __device__ __forceinline__ const char* b_tile(const Unit& u) const { return B + (size_t)u.pn * 256 * K * 2; }
};
struct QkvSched {
    static constexpr bool GATHER = false;
    const char* A; const char* B; int K, G, c;
    __device__ __forceinline__ bool next(int i, Unit& u) const {
        u.pos0 = 0; u.cnt = 0; const long L = (long)i * G + c; constexpr int n1 = (NLAT / 256) * 24;
        if (L < n1) { u.e = 0; return static_map(L, NLAT / 256, 24, u.pm, u.pn); }
        u.e = 1; return static_map(L - n1, NCTX / 256, 16, u.pm, u.pn);
    }
    __device__ __forceinline__ const char* a_tile(const Unit& u) const { return A + ((size_t)(u.e ? NLAT : 0) + (size_t)u.pm * 256) * K * 2; }
    __device__ __forceinline__ unsigned a_row_off(const Unit&, int r) const { return (unsigned)r * (unsigned)K * 2u; }
    __device__ __forceinline__ const char* b_tile(const Unit& u) const { return B + ((size_t)(u.e ? 2048 : 0) + (size_t)u.pn * 256) * K * 2; }
};
template <bool GATHER_> struct MoeSched {
    static constexpr bool GATHER = GATHER_;
    const char* A; const char* B; size_t estride; const LAS int* pre; const LAS int* cnt; const int* list; int K, G, c;
    __device__ __forceinline__ bool next(int i, Unit& u) const {
        const int MT = pre[16]; if (!static_next(i, G, c, MT, 8, u.pm, u.pn)) return false;
        int e = 0;
#pragma unroll
        for (int j = 1; j < 16; ++j) e += (u.pm >= pre[j]) ? 1 : 0;
        u.e = e; u.pos0 = (u.pm - pre[e]) * 256; u.cnt = cnt[e]; return true;
    }
    __device__ __forceinline__ const char* a_tile(const Unit& u) const { return GATHER ? A : A + (size_t)u.pm * 256 * K * 2; }
    __device__ __forceinline__ unsigned a_row_off(const Unit& u, int r) const {
        if (!GATHER) return (unsigned)r * (unsigned)K * 2u;
        const int pos = u.pos0 + r; const int t2 = pos < u.cnt ? list[(size_t)u.e * NTOK + pos] : 0;
        return (unsigned)(t2 >> 1) * (unsigned)K * 2u;
    }
    __device__ __forceinline__ const char* b_tile(const Unit& u) const { return B + (size_t)u.e * estride + (size_t)u.pn * 256 * K * 2; }
};

template <class Epi, class Sched>
__device__ __forceinline__ void gemm_phase(LAS unsigned char* lds, const int wave_in, const int K, const Sched& S, const Epi& E) {
    const int tid = tid_rebuild(wave_in), wid = wave_in, lane = tid & 63, wr = wid >> 2, wc = wid & 3, fr = lane & 15, fq = lane >> 4;
    const int nt = K / BK;
    constexpr bool GA = Sched::GATHER;
    unsigned voffB[2];
#pragma unroll
    for (int i = 0; i < 2; ++i) { int R, C; stage_rc(tid * 16 + i * 8192, R, C); const int Rb = (R & ~31) + perm32(R & 31); voffB[i] = (unsigned)(Rb * K + C) * 2u; }
#define PG8_AOFF(u, h, i, dst) do { int R_, C_; stage_rc(tid * 16 + (i) * 8192, R_, C_); dst = S.a_row_off(u, (h) * 128 + R_) + (unsigned)C_ * 2u; } while (0)
    const size_t kstep = (size_t)(BK * 2);
    const size_t hstep = (size_t)HALF * K * 2;
    const unsigned ldsw = (unsigned)wid * 1024u;
    const int aoff = lds_byte(wr * 64 + fr, fq * 8), boff = lds_byte(wc * 32 + fr, fq * 8);
#define PG8_SA(b, h) (((b) * 2 + (h)) * HTB)
#define PG8_SB(b, h) ((4 + (b) * 2 + (h)) * HTB)
#define PG8_STAGE(bufoff, gbase, voff) do { _Pragma("unroll") for (int _i = 0; _i < 2; ++_i) \
        __builtin_amdgcn_global_load_lds((const unsigned*)((const char*)(gbase) + (voff)[_i]), (LAS unsigned*)(lds + (bufoff) + ldsw + _i * 8192), 16, 0, 0); } while (0)
#define PG8_LDA(dst, b, h) do { _Pragma("unroll") for (int m = 0; m < 4; ++m) _Pragma("unroll") for (int k = 0; k < 2; ++k) dst[m][k] = *(const LAS bf16x8*)(lds + PG8_SA(b, h) + aoff + m * 2048 + k * 1024); } while (0)
#define PG8_LDB(dst, b, h) do { _Pragma("unroll") for (int n = 0; n < 2; ++n) _Pragma("unroll") for (int k = 0; k < 2; ++k) dst[n][k] = *(const LAS bf16x8*)(lds + PG8_SB(b, h) + boff + n * 2048 + k * 1024); } while (0)
#define PG8_MMA(ai, bj, At, Bt) do { __builtin_amdgcn_s_setprio(1); _Pragma("unroll") for (int m = 0; m < 4; ++m) _Pragma("unroll") for (int n = 0; n < 2; ++n) _Pragma("unroll") for (int k = 0; k < 2; ++k) \
        acc[ai][bj][m][n] = __builtin_amdgcn_mfma_f32_16x16x32_bf16(Bt[n][k], At[m][k], acc[ai][bj][m][n], 0, 0, 0); __builtin_amdgcn_s_setprio(0); } while (0)
#define PG8_WAIT_V(n) asm volatile("s_waitcnt vmcnt(" #n ")" ::: "memory")
#define PG8_WAIT_L(n) asm volatile("s_waitcnt lgkmcnt(" #n ")" ::: "memory")
#define PG8_BAR __builtin_amdgcn_s_barrier()
#define PG8_SCHED __builtin_amdgcn_sched_barrier(0)
    Unit cur, nxt; int ui = 0;
    if (!S.next(0, cur)) return;
    f32x4 acc[2][2][4][2];
#pragma unroll
    for (int a = 0; a < 2; ++a)
#pragma unroll
        for (int b = 0; b < 2; ++b)
#pragma unroll
            for (int m = 0; m < 4; ++m)
#pragma unroll
                for (int n = 0; n < 2; ++n) acc[a][b][m][n] = (f32x4){0.f, 0.f, 0.f, 0.f};
    bf16x8 At[4][2], B0[2][2], B1[2][2];
    unsigned cvo0[2], cvo1[2];
#pragma unroll
    for (int i = 0; i < 2; ++i) { PG8_AOFF(cur, 0, i, cvo0[i]); if (GA) PG8_AOFF(cur, 1, i, cvo1[i]); else cvo1[i] = cvo0[i]; }
    LAS unsigned* toff = (LAS unsigned*)(lds + LX + 5120);
    const size_t ahs = GA ? (size_t)0 : hstep;
    const char* cA = S.a_tile(cur); const char* cB = S.b_tile(cur);
    PG8_STAGE(PG8_SB(0, 0), cB, voffB); PG8_STAGE(PG8_SA(0, 0), cA, cvo0); PG8_STAGE(PG8_SB(0, 1), cB + hstep, voffB); PG8_STAGE(PG8_SA(0, 1), cA + ahs, cvo1);
    if (wr == 1) PG8_BAR;
    PG8_WAIT_V(4); PG8_BAR;
    PG8_STAGE(PG8_SB(1, 0), cB + kstep, voffB); PG8_STAGE(PG8_SA(1, 0), cA + kstep, cvo0); PG8_STAGE(PG8_SB(1, 1), cB + hstep + kstep, voffB);
    PG8_WAIT_V(6); PG8_BAR;
    for (;;) {
        const bool has_next = S.next(ui + 1, nxt);
        const char* nA = has_next ? S.a_tile(nxt) : cA; const char* nB = has_next ? S.b_tile(nxt) : cB;
        if (GA && has_next && tid < 256) toff[((ui + 1) & 1) * 256 + tid] = S.a_row_off(nxt, tid);
        for (int t = 0; t < nt; t += 2) {
            const bool last = (t == nt - 2);
            const char* a1 = cA + (size_t)(t + 1) * kstep;
            const char* a2 = last ? nA : cA + (size_t)(t + 2) * kstep; const char* b2 = last ? nB : cB + (size_t)(t + 2) * kstep;
            const char* a3 = a2 + kstep; const char* b3 = b2 + kstep;
            PG8_LDB(B0, 0, 0); PG8_SCHED; PG8_LDA(At, 0, 0); PG8_STAGE(PG8_SA(1, 1), a1 + ahs, cvo1);
            PG8_WAIT_L(8); PG8_BAR; PG8_WAIT_L(0); PG8_MMA(0, 0, At, B0); PG8_BAR; PG8_SCHED;
            if (GA && last && has_next) {
#pragma unroll
                for (int i = 0; i < 2; ++i) { int R_, C_; stage_rc(tid * 16 + i * 8192, R_, C_); const int tb_ = ((ui + 1) & 1) * 256; cvo0[i] = toff[tb_ + R_] + (unsigned)C_ * 2u; cvo1[i] = toff[tb_ + 128 + R_] + (unsigned)C_ * 2u; } }
            PG8_LDB(B1, 0, 1); PG8_STAGE(PG8_SB(0, 0), b2, voffB);
            PG8_BAR; PG8_WAIT_L(0); PG8_MMA(0, 1, At, B1); PG8_BAR;
            PG8_LDA(At, 0, 1); PG8_STAGE(PG8_SA(0, 0), a2, cvo0);
            PG8_BAR; PG8_WAIT_L(0); PG8_MMA(1, 0, At, B0); PG8_BAR; PG8_SCHED;
            PG8_STAGE(PG8_SB(0, 1), b2 + hstep, voffB);
            PG8_WAIT_V(6); PG8_BAR; PG8_MMA(1, 1, At, B1); PG8_BAR;
            PG8_LDB(B0, 1, 0); PG8_SCHED; PG8_LDA(At, 1, 0); PG8_STAGE(PG8_SA(0, 1), a2 + ahs, cvo1);
            PG8_WAIT_L(8); PG8_BAR; PG8_WAIT_L(0); PG8_MMA(0, 0, At, B0); PG8_BAR; PG8_SCHED;
            PG8_LDB(B1, 1, 1); PG8_STAGE(PG8_SB(1, 0), b3, voffB);
            PG8_BAR; PG8_WAIT_L(0); PG8_MMA(0, 1, At, B1); PG8_BAR;
            PG8_LDA(At, 1, 1); PG8_STAGE(PG8_SA(1, 0), a3, cvo0);
            PG8_BAR; PG8_WAIT_L(0); PG8_MMA(1, 0, At, B0); PG8_BAR; PG8_SCHED;
            PG8_STAGE(PG8_SB(1, 1), b3 + hstep, voffB);
            PG8_WAIT_V(6); PG8_BAR; PG8_MMA(1, 1, At, B1); PG8_BAR;
        }
        int lane_e = lane_id(); asm volatile("" : "+v"(lane_e));
        const int fr_e = lane_e & 15, fq_e = lane_e >> 4;
#pragma unroll
        for (int ai = 0; ai < 2; ++ai)
#pragma unroll
            for (int m = 0; m < 4; ++m) {
                float lo[8], hi[8];
#pragma unroll
                for (int n = 0; n < 2; ++n)
#pragma unroll
                    for (int j = 0; j < 4; ++j) { lo[4 * n + j] = acc[ai][0][m][n][j]; hi[4 * n + j] = acc[ai][1][m][n][j]; }
                E.store8(cur, ai * HALF + wr * 64 + m * 16 + fr_e, wc * 32 + 8 * fq_e, lo, hi);
                if (Epi::FENCE && (m & 1)) asm volatile("" ::: "memory");
            }
        if (!has_next) break;
#pragma unroll
        for (int a = 0; a < 2; ++a)
#pragma unroll
            for (int b = 0; b < 2; ++b)
#pragma unroll
                for (int m = 0; m < 4; ++m)
#pragma unroll
                    for (int n = 0; n < 2; ++n) acc[a][b][m][n] = (f32x4){0.f, 0.f, 0.f, 0.f};
        cur = nxt; cA = nA; cB = nB; ++ui;
    }
    PG8_WAIT_V(0);
    if (wr == 0) PG8_BAR;
    PG8_BAR;
#undef PG8_AOFF
#undef PG8_SA
#undef PG8_SB
#undef PG8_STAGE
#undef PG8_LDA
#undef PG8_LDB
#undef PG8_MMA
#undef PG8_WAIT_V
#undef PG8_WAIT_L
#undef PG8_BAR
#undef PG8_SCHED
}

template <class Epi, class Sched>
__device__ __forceinline__ void gemm_naive(const int K, const Sched& S, const Epi& E) {
    Unit u;
    for (int i = 0; S.next(i, u); ++i) {
        const char* At = S.a_tile(u); const char* Bt = S.b_tile(u);
        for (int item = threadIdx.x; item < 4096; item += 512) {
            const int r = item & 255, c = (item >> 8) * 8;
            const bf16_t* a = (const bf16_t*)(At + S.a_row_off(u, r));
            float lo[8], hi[8];
#pragma unroll
            for (int j = 0; j < 8; ++j) { lo[j] = 0.f; hi[j] = 0.f; }
            for (int k = 0; k < K; k += 8) {
                float av[8]; unpack8(*(const u32x4*)(a + k), av);
#pragma unroll
                for (int j = 0; j < 8; ++j) { float bv[8];
                    unpack8(*(const u32x4*)((const bf16_t*)Bt + (size_t)(c + j) * K + k), bv);
#pragma unroll
                    for (int q = 0; q < 8; ++q) lo[j] += av[q] * bv[q];
                    unpack8(*(const u32x4*)((const bf16_t*)Bt + (size_t)(128 + c + j) * K + k), bv);
#pragma unroll
                    for (int q = 0; q < 8; ++q) hi[j] += av[q] * bv[q]; }
            }
            E.store8(u, r, c, lo, hi);
        }
    }
}
template <class Epi, class Sched>
__device__ __forceinline__ void gemm_run(LAS unsigned char* lds, const int wave_in, const int K, const Sched& S, const Epi& E) {
#if MK_NAIVE
    (void)wave_in; gemm_naive<Epi, Sched>(K, S, E);
#else
    gemm_phase<Epi, Sched>(lds, wave_in, K, S, E);
#endif
}

struct EpiIn0 {
    static constexpr bool FENCE = false;
    bf16_t* P; bf16_t* GB; bf16_t* GY; bf16_t* XB;
    __device__ __forceinline__ void store8(const Unit& u, int r, int c, const float (&lo)[8], const float (&hi)[8]) const {
        const size_t t = (size_t)u.pm * 256 + r;
        if (u.pn < 8) { float v[8];
#pragma unroll
            for (int j = 0; j < 8; ++j) v[j] = lo[j] * hi[j];
            *(u32x4*)(P + t * 1024 + u.pn * 128 + c) = pack8(v); }
        else if (u.pn < 12) { bf16_t* d = GB + t * 1024 + (u.pn - 8) * 256 + c; *(u32x4*)d = pack8(lo); *(u32x4*)(d + 128) = pack8(hi); }
        else if (u.pn < 16) { float a[8], b[8];
#pragma unroll
            for (int j = 0; j < 8; ++j) { a[j] = fgelu_tanh(lo[j]); b[j] = fgelu_tanh(hi[j]); }
            bf16_t* d = GY + t * 1024 + (u.pn - 12) * 256 + c; *(u32x4*)d = pack8(a); *(u32x4*)(d + 128) = pack8(b); }
        else { bf16_t* d = XB + t * 1024 + (u.pn - 16) * 256 + c; *(u32x4*)d = pack8(lo); *(u32x4*)(d + 128) = pack8(hi); }
    }
};
struct EpiRes {
    static constexpr bool FENCE = false;
    const float* base_lat; const float* base_ctx; float* dst_lat; float* dst_ctx; const float* g1;
    __device__ __forceinline__ void store8(const Unit& u, int r, int c, const float (&lo)[8], const float (&hi)[8]) const {
        const int t0 = u.pm * 256, b = modrow_of(t0), col = u.pn * 256 + c;
        const float* bp; float* dp;
        if (t0 < NLAT) { bp = base_lat + (size_t)(t0 + r) * D + col; dp = dst_lat + (size_t)(t0 + r) * D + col; }
        else { bp = base_ctx + (size_t)(t0 - NLAT + r) * D + col; dp = dst_ctx + (size_t)(t0 - NLAT + r) * D + col; }
        const float* gp = g1 + (size_t)b * MODW + col;
#pragma unroll
        for (int q = 0; q < 2; ++q) {
            const f32x4 g = *(const f32x4*)(gp + 4 * q), x = *(const f32x4*)(bp + 4 * q), g2 = *(const f32x4*)(gp + 128 + 4 * q), x2 = *(const f32x4*)(bp + 128 + 4 * q);
            f32x4 o, o2;
#pragma unroll
            for (int j = 0; j < 4; ++j) { o[j] = x[j] + g[j] * lo[4 * q + j]; o2[j] = x2[j] + g2[j] * hi[4 * q + j]; }
            *(f32x4*)(dp + 4 * q) = o; *(f32x4*)(dp + 128 + 4 * q) = o2; }
    }
};
struct EpiGU {
    static constexpr bool FENCE = false;
    bf16_t* hid;
    __device__ __forceinline__ void store8(const Unit& u, int r, int c, const float (&lo)[8], const float (&hi)[8]) const {
        float v[8];
#pragma unroll
        for (int j = 0; j < 8; ++j) v[j] = fsilu(lo[j]) * hi[j];
        *(u32x4*)(hid + ((size_t)u.pm * 256 + r) * FF + u.pn * 128 + c) = pack8(v);
    }
};
struct EpiDN {
    static constexpr bool FENCE = true;
    bf16_t* Y; const int* list; const float* listg;
    __device__ __forceinline__ void store8(const Unit& u, int r, int c, const float (&lo)[8], const float (&hi)[8]) const {
        const int pos = u.pos0 + r; if (pos >= u.cnt) return;
        const int t2 = list[(size_t)u.e * NTOK + pos]; const float g = listg[(size_t)u.e * NTOK + pos];
        float a[8], b[8];
#pragma unroll
        for (int j = 0; j < 8; ++j) { a[j] = g * lo[j]; b[j] = g * hi[j]; }
        bf16_t* d = Y + ((size_t)(t2 & 1) * NTOK + (t2 >> 1)) * D + u.pn * 256 + c;
        *(u32x4*)d = pack8(a); *(u32x4*)(d + 128) = pack8(b);
    }
};
struct EpiQKV {
    static constexpr bool FENCE = true;
    bf16_t* Q; bf16_t* Kb; bf16_t* Vb; const float* ropec; const float* ropes;
    __device__ __forceinline__ void store8(const Unit& u, int r, int c, const float (&lo)[8], const float (&hi)[8]) const {
        const int ctx = u.e, t = u.pm * 256 + r, png = u.pn + 8 * ctx;
        int b, s; size_t kvrow;
        if (ctx) { b = t >> 8; s = t & 255; kvrow = (size_t)b * KVL + s; } else { b = t >> 11; s = t & 2047; kvrow = (size_t)b * KVL + CTXL + s; }
        if (png < 16) {
            const int head = png & 7, m = c >> 6, a = (c >> 5) & 1, j0 = c & 31;
            float ol[8], oh[8];
            if (!ctx) { const int pos = a ? (s & 63) : (s >> 6);
                const f32x4 c0 = *(const f32x4*)(ropec + pos * 32 + j0), c1 = *(const f32x4*)(ropec + pos * 32 + j0 + 4), s0 = *(const f32x4*)(ropes + pos * 32 + j0), s1 = *(const f32x4*)(ropes + pos * 32 + j0 + 4);
#pragma unroll
                for (int j = 0; j < 8; ++j) { const float cs = j < 4 ? c0[j & 3] : c1[j & 3], sn = j < 4 ? s0[j & 3] : s1[j & 3]; ol[j] = lo[j] * cs - hi[j] * sn; oh[j] = hi[j] * cs + lo[j] * sn; } }
            else {
#pragma unroll
                for (int j = 0; j < 8; ++j) { ol[j] = lo[j]; oh[j] = hi[j]; } }
            bf16_t* d = (png < 8 ? Q + (size_t)t * D : Kb + kvrow * D) + head * 256 + m * 128 + a * 64 + j0;
            *(u32x4*)d = pack8(ol); *(u32x4*)(d + 32) = pack8(oh);
        } else { bf16_t* d = Vb + kvrow * D + (png - 16) * 256 + c; *(u32x4*)d = pack8(lo); *(u32x4*)(d + 128) = pack8(hi); }
    }
};
}

__device__ __forceinline__ void scan_phase(const Frame& F, const Params& p) {
    unsigned char* ws = F.ws;
    const bf16_t* P = (const bf16_t*)(ws + WS_R1); const bf16_t* GB = P + (size_t)NTOK * 1024; const bf16_t* GY = GB + (size_t)NTOK * 1024; const bf16_t* XB = GY + (size_t)NTOK * 1024;
    bf16_t* A3 = (bf16_t*)(ws + WS_HB);
    float* HS = (float*)(ws + WS_HID);
    const int tid = F.tid, lane = F.lane, w = F.wave;
    {
        const float* cw = inptr(p, 10);
        for (int it = F.bx * 512 + tid; it < NTOK * 128; it += F.G * 512) {
            const int t = it >> 7, ch = (it & 127) * 8;
            int s, len; if (t < NLAT) { s = t & 2047; len = SEQ; } else { s = (t - NLAT) & 255; len = CTXL; }
            float pm[8], pc[8], pp[8], gb[8], o[8];
            unpack8(*(const u32x4*)(P + (size_t)t * 1024 + ch), pc);
            if (s >= 1) unpack8(*(const u32x4*)(P + (size_t)(t - 1) * 1024 + ch), pm); else {
#pragma unroll
                for (int j = 0; j < 8; ++j) pm[j] = 0.f; }
            if (s + 1 < len) unpack8(*(const u32x4*)(P + (size_t)(t + 1) * 1024 + ch), pp); else {
#pragma unroll
                for (int j = 0; j < 8; ++j) pp[j] = 0.f; }
            unpack8(*(const u32x4*)(GB + (size_t)t * 1024 + ch), gb);
#pragma unroll
            for (int j = 0; j < 8; ++j) o[j] = gb[j] * (cw[ch + j] * pm[j] + cw[1024 + ch + j] * pc[j] + cw[2048 + ch + j] * pp[j]);
            *(u32x4*)(A3 + (size_t)t * D + ch) = pack8(o);
        }
    }
    LAS unsigned char* lds = F.lds;
    LAS bf16_t* Ush = (LAS bf16_t*)lds;
    LAS float* Ash = (LAS float*)(lds + 36864); LAS float* Bsh = (LAS float*)(lds + 69632);
    LAS float* SA = (LAS float*)(lds + 102400); LAS float* SB = (LAS float*)(lds + 104448); LAS float* carry = (LAS float*)(lds + 106496);
    for (int unit = F.bx; unit < 256; unit += F.G) {
        const int b = unit >> 4, hd = (unit >> 1) & 7, half = unit & 1;
        const int cg = (tid & 15) * 8, chg = hd * 128 + cg;
        LAS float* cwl = (LAS float*)(lds + 106752);
        { const float* cbw = inptr(p, 11); const float* cbb = inptr(p, 12);
          __syncthreads();
          for (int i = tid; i < 640; i += 512) cwl[i] = i < 512 ? cbw[(i >> 7) * 1024 + hd * 128 + (i & 127)] : cbb[hd * 128 + (i & 127)];
          __syncthreads(); }
        const int tb = w & 3, cbk = w >> 2, r32 = lane & 31, hi = lane >> 5;
        const int chl = cbk * 32 + r32, chglob = hd * 128 + half * 64 + chl;
        const int sch = tid & 63, chunk = tid >> 6, schglob = hd * 128 + half * 64 + sch;
        for (int dir = 0; dir < 2; ++dir) {
            const bf16_t* gw = (const bf16_t*)(ws + WS_GW) + ((size_t)((dir * 8 + hd) * 2 + half) * 128) * 128;
            bf16x8 Br[8], Bi[8];
#pragma unroll
            for (int ks = 0; ks < 8; ++ks) { Br[ks] = *(const bf16x8*)(gw + (size_t)(cbk * 32 + r32) * 128 + ks * 16 + hi * 8); Bi[ks] = *(const bf16x8*)(gw + (size_t)(64 + cbk * 32 + r32) * 128 + ks * 16 + hi * 8); }
            const float ba = inptr(p, 14)[dir * 1024 + chglob], bi = inptr(p, 16)[dir * 1024 + chglob];
            const float cl = 8.0f * log1pf(expf(-(inptr(p, 17)[dir * 1024 + chglob])));
            if (tid < 64) carry[tid] = 0.f;
            __syncthreads();
            for (int ti = 0; ti < 18; ++ti) {
                int seg_ctx, s0;
                if (ti < 2) { seg_ctx = 1; s0 = dir == 0 ? ti * 128 : (1 - ti) * 128; } else { seg_ctx = 0; s0 = dir == 0 ? (ti - 2) * 128 : (17 - ti) * 128; }
                const int len = seg_ctx ? CTXL : SEQ; const size_t row0 = seg_ctx ? (size_t)NLAT + b * CTXL : (size_t)b * SEQ;
#pragma unroll
                for (int it = 0; it < 4; ++it) {
                    const int tok = (tid >> 4) + 32 * it, s = s0 + tok;
                    float uacc[8];
                    { const f32x4 b0 = *(const LAS f32x4*)(cwl + 512 + cg), b1 = *(const LAS f32x4*)(cwl + 512 + cg + 4);
#pragma unroll
                      for (int j = 0; j < 4; ++j) { uacc[j] = b0[j]; uacc[4 + j] = b1[j]; } }
#pragma unroll
                    for (int q = 0; q < 4; ++q) { const int sq = s + q - 2;
                        if (sq >= 0 && sq < len) { float xv[8]; unpack8(*(const u32x4*)(XB + (row0 + sq) * 1024 + chg), xv);
                            const f32x4 w0 = *(const LAS f32x4*)(cwl + q * 128 + cg), w1 = *(const LAS f32x4*)(cwl + q * 128 + cg + 4);
#pragma unroll
                            for (int j = 0; j < 4; ++j) { uacc[j] += w0[j] * xv[j]; uacc[4 + j] += w1[j] * xv[4 + j]; } } }
                    *(LAS u32x4*)(Ush + tok * 136 + cg) = pack8(uacc);
                }
                __syncthreads();
                f32x16 ar = {}, ai = {};
#pragma unroll
                for (int ks = 0; ks < 8; ++ks) { const bf16x8 af = *(const LAS bf16x8*)(Ush + (tb * 32 + r32) * 136 + ks * 16 + hi * 8);
                    ar = __builtin_amdgcn_mfma_f32_32x32x16_bf16(af, Br[ks], ar, 0, 0, 0); ai = __builtin_amdgcn_mfma_f32_32x32x16_bf16(af, Bi[ks], ai, 0, 0, 0); }
#pragma unroll
                for (int rg = 0; rg < 16; ++rg) { const int tok = tb * 32 + (rg & 3) + 8 * (rg >> 2) + 4 * hi;
                    const float rr = fsigmoid(ar[rg] + ba), ii = fsigmoid(ai[rg] + bi);
                    const float la = -cl * rr, a = __expf(la), x2 = 2.0f * la;
                    const float om = x2 > -0.25f ? -x2 * (1.0f + x2 * (0.5f + x2 * (0.16666667f + x2 * (0.041666668f + x2 * 0.0083333338f)))) : 1.0f - a * a;
                    const float uu = bf2f(Ush[tok * 136 + half * 64 + chl]);
                    Ash[tok * 64 + chl] = a; Bsh[tok * 64 + chl] = sqrtf(om) * ii * uu; }
                __syncthreads();
                {
                    float Aa = 1.f, Hh = 0.f;
#pragma unroll 4
                    for (int i = 0; i < 16; ++i) { const int tok = chunk * 16 + (dir == 0 ? i : 15 - i); const float a = Ash[tok * 64 + sch], bb = Bsh[tok * 64 + sch]; Hh = a * Hh + bb; Aa *= a; }
                    SA[chunk * 64 + sch] = Aa; SB[chunk * 64 + sch] = Hh;
                    __syncthreads();
                    float c = carry[sch];
                    if (dir == 0) { for (int j = 0; j < chunk; ++j) c = SA[j * 64 + sch] * c + SB[j * 64 + sch]; }
                    else { for (int j = 7; j > chunk; --j) c = SA[j * 64 + sch] * c + SB[j * 64 + sch]; }
                    __syncthreads();
                    if (chunk == (dir == 0 ? 7 : 0)) carry[sch] = Aa * c + Hh;
                    float h = c;
#pragma unroll 2
                    for (int i = 0; i < 16; ++i) { const int tok = chunk * 16 + (dir == 0 ? i : 15 - i); const float a = Ash[tok * 64 + sch], bb = Bsh[tok * 64 + sch]; h = a * h + bb;
                        const size_t row = row0 + s0 + tok;
                        if (dir == 0) HS[row * 1024 + schglob] = h;
                        else { const float hf = HS[row * 1024 + schglob]; const float gy = bf2f(GY[row * 1024 + schglob]);
                            A3[row * D + 1024 + schglob] = (bf16_t)(cvt_pk_bf16(gy * (hf + h), 0.f) & 0xffffu); } }
                }
            }
            __syncthreads();
        }
    }
}

namespace att {
constexpr int DH = 128, NW = 8, QBLK = 32, KVBLK = 64, LDQ = 2048, LDK = 2048, LDO = 2048;
constexpr float SCALE = 0.088388347648318440f;
constexpr float THR = 8.f;
#ifndef ATT_SDEPTH
#define ATT_SDEPTH 1
#endif
constexpr int SDEPTH = ATT_SDEPTH;
constexpr int SHM_V = KVBLK * DH * 2, SHM_K = KVBLK * DH * 2;
constexpr int SHM_ATTN = 2 * SHM_V + 2 * SHM_K + NW * 64 * 4 + NW * 32 * 4;
#define KSWZ(row, colB) ((row) * 256 + ((colB) ^ (((row) & 7) << 4)))
#define SBAR() __builtin_amdgcn_sched_barrier(0)
__device__ __forceinline__ int crow(int r, int hi) { return (r & 3) + 8 * (r >> 2) + 4 * hi; }
__device__ __forceinline__ unsigned cvtpk(float lo, float hi) { unsigned r; asm volatile("v_cvt_pk_bf16_f32 %0, %1, %2" : "=v"(r) : "v"(lo), "v"(hi)); return r; }
__device__ __forceinline__ void partialSM(f32x16& p0, f32x16& p1, float& m_reg, float& mn, float& alpha) {
  constexpr float C = SCALE * 1.4426950408889634f;
  float pmax = p0[0]; for (int r = 1; r < 16; ++r) pmax = fmaxf(pmax, p0[r]); for (int r = 0; r < 16; ++r) pmax = fmaxf(pmax, p1[r]);
  { auto rr = __builtin_amdgcn_permlane32_swap(__float_as_uint(pmax), __float_as_uint(pmax), false, false);
    pmax = fmaxf(__uint_as_float(rr[0]), __uint_as_float(rr[1])); }
  if (__builtin_expect(__all(pmax - m_reg <= THR / SCALE), 1)) { mn = m_reg; alpha = 1.f; }
  else { mn = fmaxf(m_reg, pmax); alpha = __builtin_amdgcn_exp2f((m_reg - mn) * C); m_reg = mn; }
  float mnC = -mn * C;
  for (int r = 0; r < 16; ++r) p0[r] = fmaf(p0[r], C, mnC); for (int r = 0; r < 16; ++r) p1[r] = fmaf(p1[r], C, mnC);
  for (int r = 0; r < 16; ++r) p0[r] = __builtin_amdgcn_exp2f(p0[r]);
}
__device__ __forceinline__ void finishSM(f32x16& p0, f32x16& p1, float alpha, float& l_reg, bf16x8& pa0, bf16x8& pa1, bf16x8& pa2, bf16x8& pa3) {
  for (int r = 0; r < 16; ++r) p1[r] = __builtin_amdgcn_exp2f(p1[r]);
  float ps = 0; for (int r = 0; r < 16; ++r) ps += p0[r]; for (int r = 0; r < 16; ++r) ps += p1[r];
  { auto rr = __builtin_amdgcn_permlane32_swap(__float_as_uint(ps), __float_as_uint(ps), false, false);
    ps = __uint_as_float(rr[0]) + __uint_as_float(rr[1]); }
  l_reg = l_reg * alpha + ps;
#define PK4(P, BASE, OUT) do { unsigned a0 = cvtpk(P[BASE + 0], P[BASE + 1]), a1 = cvtpk(P[BASE + 2], P[BASE + 3]);   \
    unsigned b0 = cvtpk(P[BASE + 4], P[BASE + 5]), b1 = cvtpk(P[BASE + 6], P[BASE + 7]);                              \
    auto r0 = __builtin_amdgcn_permlane32_swap(a0, b0, false, false); auto r1 = __builtin_amdgcn_permlane32_swap(a1, b1, false, false); \
    u32x4 w = {r0[0], r1[0], r0[1], r1[1]}; OUT = *reinterpret_cast<bf16x8*>(&w); } while (0)
  PK4(p0, 0, pa0); PK4(p0, 8, pa1); PK4(p1, 0, pa2); PK4(p1, 8, pa3);
#undef PK4
}
__device__ __forceinline__ void qkt(f32x16& p0, f32x16& p1, const bf16_t* Ks, const bf16x8* qr, int r32, int hi) {
  p0 = f32x16{}; p1 = f32x16{};
  for (int d0 = 0; d0 < 8; ++d0) { int cb = (d0 * 16 + hi * 8) * 2;
    bf16x8 b0 = *reinterpret_cast<const bf16x8*>((const char*)Ks + KSWZ(r32, cb));
    bf16x8 b1 = *reinterpret_cast<const bf16x8*>((const char*)Ks + KSWZ(32 + r32, cb));
    p0 = __builtin_amdgcn_mfma_f32_32x32x16_bf16(b0, qr[d0], p0, 0, 0, 0);
    p1 = __builtin_amdgcn_mfma_f32_32x32x16_bf16(b1, qr[d0], p1, 0, 0, 0); }
}
__device__ __forceinline__ int v_st(int k, int c) { const int kk = (k & ~0xC) | ((k & 4) << 1) | ((k & 8) >> 1); return ((kk >> 3) * 4 + (c >> 5)) * 512 + ((kk & 7) * 32 + (c & 31)) * 2; }
__device__ __forceinline__ int v_rd_base(int lane) { return ((lane & 3) << 3) | (((lane >> 2) & 3) << 6) | (((lane >> 4) & 1) << 5) | (((lane >> 5) & 1) << 8); }
constexpr int v_rd_off(int d0, int ks, int half) { return d0 * 512 + ks * 4096 + half * 2048; }
template <int OFF> __device__ __forceinline__ s16x4 tr_read(int vb) {
  s16x4 r; asm volatile("ds_read_b64_tr_b16 %0, %1 offset:%2" : "=&v"(r) : "v"(vb), "i"(OFF) : "memory"); return r;
}
template <int D0> __device__ __forceinline__ void pv_one(f32x16& od, int vb, bf16x8 pa0, bf16x8 pa1, bf16x8 pa2, bf16x8 pa3) {
  const s16x4 l0 = tr_read<v_rd_off(D0, 0, 0)>(vb), h0 = tr_read<v_rd_off(D0, 0, 1)>(vb), l1 = tr_read<v_rd_off(D0, 1, 0)>(vb), h1 = tr_read<v_rd_off(D0, 1, 1)>(vb);
  const s16x4 l2 = tr_read<v_rd_off(D0, 2, 0)>(vb), h2 = tr_read<v_rd_off(D0, 2, 1)>(vb), l3 = tr_read<v_rd_off(D0, 3, 0)>(vb), h3 = tr_read<v_rd_off(D0, 3, 1)>(vb);
  asm volatile("s_waitcnt lgkmcnt(0)" ::: "memory"); SBAR();
#define PK(L, H) (bf16x8){L[0], L[1], L[2], L[3], H[0], H[1], H[2], H[3]}
  od = __builtin_amdgcn_mfma_f32_32x32x16_bf16(pa0, PK(l0, h0), od, 0, 0, 0);
  od = __builtin_amdgcn_mfma_f32_32x32x16_bf16(pa1, PK(l1, h1), od, 0, 0, 0);
  od = __builtin_amdgcn_mfma_f32_32x32x16_bf16(pa2, PK(l2, h2), od, 0, 0, 0);
  od = __builtin_amdgcn_mfma_f32_32x32x16_bf16(pa3, PK(l3, h3), od, 0, 0, 0);
#undef PK
}
__device__ __forceinline__ void pv_d0(f32x16* o, int vb, bf16x8 pa0, bf16x8 pa1, bf16x8 pa2, bf16x8 pa3) {
  pv_one<0>(o[0], vb, pa0, pa1, pa2, pa3); pv_one<1>(o[1], vb, pa0, pa1, pa2, pa3); pv_one<2>(o[2], vb, pa0, pa1, pa2, pa3); pv_one<3>(o[3], vb, pa0, pa1, pa2, pa3);
}
__device__ __forceinline__ void attn_pass(const bf16_t* __restrict__ Qb, const bf16_t* __restrict__ Kh, const bf16_t* __restrict__ Vh, bf16_t* __restrict__ Ob,
                                          float* __restrict__ scr, const int wave_in, const int pass, const float lam, const float onem, const float* __restrict__ subg, int seq, char* lds) {
  const int tid = tid_rebuild(wave_in), wid = wave_in;
  const int lane = tid & 63, r32 = lane & 31, hi = lane >> 5;
  bf16_t* V_lds = (bf16_t*)lds; bf16_t* K_lds = (bf16_t*)(lds + 2 * SHM_V);
  float* wsl = (float*)(lds + 2 * SHM_V + 2 * SHM_K) + wid * 64; float* li_l = wsl; float* al_l = wsl + 32;
  float* rq = (float*)(lds + 2 * SHM_V + 2 * SHM_K + NW * 64 * 4) + wid * 32;
  float m_reg = -1e30f, l_reg = 0; f32x16 o[4] = {}; bf16x8 qr[8];
  const bf16_t* Qw = Qb + (long)(wid * QBLK + r32) * LDQ + hi * 8;
#pragma unroll
  for (int d0 = 0; d0 < 8; ++d0) qr[d0] = *reinterpret_cast<const bf16x8*>(Qw + d0 * 16);
  const int sr = tid >> 4, sc = (tid & 15) * 8, vst0 = v_st(sr, sc), vst1 = v_st(32 + sr, sc);
  const int vb0 = (int)(uintptr_t)V_lds + v_rd_base(lane);
  struct { bf16x8 vs0, vs1, ks0, ks1; } sr_[SDEPTH];
#define SLOAD(i, k0) do { sr_[i].vs0 = *reinterpret_cast<const bf16x8*>(&Vh[(long)((k0) + sr) * LDK + sc]); sr_[i].vs1 = *reinterpret_cast<const bf16x8*>(&Vh[(long)((k0) + 32 + sr) * LDK + sc]); \
    sr_[i].ks0 = *reinterpret_cast<const bf16x8*>(&Kh[(long)((k0) + sr) * LDK + sc]); sr_[i].ks1 = *reinterpret_cast<const bf16x8*>(&Kh[(long)((k0) + 32 + sr) * LDK + sc]); } while (0)
#define SWRITE(b, i) do { *(bf16x8*)((char*)V_lds + (b) * SHM_V + vst0) = sr_[i].vs0;          \
    *(bf16x8*)((char*)V_lds + (b) * SHM_V + vst1) = sr_[i].vs1; int kc = sc * 2;               \
    *(bf16x8*)((char*)K_lds + (b) * SHM_K + KSWZ(sr, kc)) = sr_[i].ks0;                       \
    *(bf16x8*)((char*)K_lds + (b) * SHM_K + KSWZ(32 + sr, kc)) = sr_[i].ks1; } while (0)
#define SWAIT() do { if constexpr (SDEPTH == 2) asm volatile("s_waitcnt vmcnt(4)" ::: "memory"); else asm volatile("s_waitcnt vmcnt(0)" ::: "memory"); } while (0)
#define RESC(a) do { if (__any((a) < 1.f)) { if (hi == 0) al_l[r32] = (a); asm volatile("s_waitcnt lgkmcnt(0)" ::: "memory"); \
    for (int d = 0; d < 4; ++d) for (int r = 0; r < 16; ++r) o[d][r] *= al_l[crow(r, hi)]; } } while (0)
  f32x16 pA0, pA1, pB0, pB1; float mnA, mnB, alA, alB; bf16x8 pa0, pa1, pa2, pa3; const int NT = seq / KVBLK;
  constexpr int SE = 0, SO = SDEPTH - 1;
  SLOAD(SE, 0); asm volatile("s_waitcnt vmcnt(0)" ::: "memory"); SWRITE(0, SE); __syncthreads();
  qkt(pA0, pA1, K_lds, qr, r32, hi); partialSM(pA0, pA1, m_reg, mnA, alA);
  SLOAD(SO, KVBLK); if constexpr (SDEPTH == 2) { if (2 < NT) SLOAD(SE, 2 * KVBLK); }
  SWAIT(); SWRITE(1, SO); __syncthreads();
  for (int j = 1; j + 1 < NT; j += 2) {
    SBAR(); qkt(pB0, pB1, (bf16_t*)((char*)K_lds + SHM_K), qr, r32, hi);
    finishSM(pA0, pA1, alA, l_reg, pa0, pa1, pa2, pa3); SBAR();
    SLOAD(SO, (j + SDEPTH) * KVBLK); SBAR();
    pv_d0(o, vb0, pa0, pa1, pa2, pa3); partialSM(pB0, pB1, m_reg, mnB, alB);
    __syncthreads(); SWAIT(); SWRITE(0, SE);
    RESC(alB); __syncthreads();
    SBAR(); qkt(pA0, pA1, K_lds, qr, r32, hi);
    finishSM(pB0, pB1, alB, l_reg, pa0, pa1, pa2, pa3); SBAR();
    if (SDEPTH == 1 || j + 3 < NT) SLOAD(SE, (j + 1 + SDEPTH) * KVBLK); SBAR();
    pv_d0(o, vb0 + (int)SHM_V, pa0, pa1, pa2, pa3); partialSM(pA0, pA1, m_reg, mnA, alA);
    __syncthreads(); SWAIT(); SWRITE(1, SO);
    RESC(alA); __syncthreads();
  }
  SBAR(); qkt(pB0, pB1, (bf16_t*)((char*)K_lds + SHM_K), qr, r32, hi);
  finishSM(pA0, pA1, alA, l_reg, pa0, pa1, pa2, pa3); SBAR();
  pv_d0(o, vb0, pa0, pa1, pa2, pa3); partialSM(pB0, pB1, m_reg, mnB, alB);
  __syncthreads(); RESC(alB);
  finishSM(pB0, pB1, alB, l_reg, pa0, pa1, pa2, pa3); SBAR();
  pv_d0(o, vb0 + (int)SHM_V, pa0, pa1, pa2, pa3);
  if (hi == 0) li_l[r32] = l_reg; asm volatile("s_waitcnt lgkmcnt(0)" ::: "memory");
  float rli[16];
#pragma unroll
  for (int r = 0; r < 16; ++r) rli[r] = __builtin_amdgcn_rcpf(li_l[crow(r, hi)]);
  typedef __attribute__((address_space(1))) float gf32; typedef __attribute__((address_space(1))) bf16_t gbf16;
  gf32* scr_l = (gf32*)scr; gbf16* Ob_l = (gbf16*)Ob; int lane_e = lane; asm volatile("" : "+s"(scr_l), "+s"(Ob_l), "+v"(lane_e));
  const int r32e = lane_e & 31, hie = lane_e >> 5;
  gf32* S = scr_l + (size_t)wid * 4096 + lane_e + (pass >= 2 ? 32768 : 0);
#define ATT_BASE(ptr, d0) gf32* ptr = S + (d0) * 1024; asm volatile("" : "+v"(ptr))
  if (pass == 0 || pass == 2) {
#pragma unroll
    for (int d0 = 0; d0 < 4; ++d0) { ATT_BASE(dst, d0);
#pragma unroll
      for (int r = 0; r < 16; ++r) dst[r * 64] = o[d0][r] * rli[r]; }
  } else {
    float q[16];
#pragma unroll
    for (int d0 = 0; d0 < 4; ++d0) { ATT_BASE(srcp, d0);
#pragma unroll
      for (int r = 0; r < 16; ++r) { const float c = srcp[r * 64] - lam * o[d0][r] * rli[r]; o[d0][r] = c; q[r] = d0 == 0 ? c * c : q[r] + c * c; }
      asm volatile("" ::: "memory"); }
#pragma unroll
    for (int r = 0; r < 16; ++r) {
#pragma unroll
      for (int off = 1; off <= 16; off <<= 1) q[r] += __shfl_xor(q[r], off); }
    if (pass == 1) {
#pragma unroll
      for (int d0 = 0; d0 < 4; ++d0) { ATT_BASE(dst, d0);
#pragma unroll
        for (int r = 0; r < 16; ++r) dst[r * 64] = o[d0][r]; }
      if (r32e == 0) {
#pragma unroll
        for (int r = 0; r < 16; ++r) rq[hie * 16 + r] = q[r]; }
    } else {
      if (r32e == 0) {
#pragma unroll
        for (int r = 0; r < 16; ++r) rq[hie * 16 + r] = onem * __builtin_amdgcn_rsqf((q[r] + rq[hie * 16 + r]) * (1.0f / 256.0f) + EPS); }
      asm volatile("s_waitcnt lgkmcnt(0)" ::: "memory");
      float g0[4], g1[4];
#pragma unroll
      for (int d0 = 0; d0 < 4; ++d0) { g0[d0] = subg[d0 * 32 + r32e]; g1[d0] = subg[128 + d0 * 32 + r32e]; }
      S = scr_l + (size_t)wid * 4096 + lane_e;
      ATT_BASE(s0a, 0); ATT_BASE(s0b, 1); ATT_BASE(s0c, 2); ATT_BASE(s0d, 3);
#pragma unroll
      for (int r = 0; r < 16; ++r) { const float rs = rq[hie * 16 + r];
        gbf16* orow = Ob_l + (long)(wid * QBLK + crow(r, hie)) * LDO + r32e; asm volatile("" : "+v"(orow) :: "memory");
        const float h0 = s0a[r * 64], h1 = s0b[r * 64], h2 = s0c[r * 64], h3 = s0d[r * 64];
        orow[128 +  0] = (bf16_t)(cvtpk(o[0][r] * rs * g1[0], 0.f) & 0xffffu); orow[128 + 32] = (bf16_t)(cvtpk(o[1][r] * rs * g1[1], 0.f) & 0xffffu);
        orow[128 + 64] = (bf16_t)(cvtpk(o[2][r] * rs * g1[2], 0.f) & 0xffffu); orow[128 + 96] = (bf16_t)(cvtpk(o[3][r] * rs * g1[3], 0.f) & 0xffffu);
        orow[ 0] = (bf16_t)(cvtpk(h0 * rs * g0[0], 0.f) & 0xffffu); orow[32] = (bf16_t)(cvtpk(h1 * rs * g0[1], 0.f) & 0xffffu);
        orow[64] = (bf16_t)(cvtpk(h2 * rs * g0[2], 0.f) & 0xffffu); orow[96] = (bf16_t)(cvtpk(h3 * rs * g0[3], 0.f) & 0xffffu); }
    }
  }
#undef ATT_BASE
#undef SLOAD
#undef SWRITE
#undef SWAIT
#undef RESC
}
}

__device__ __forceinline__ void attn_phase(const Frame& F, const Params& p) {
    unsigned char* ws = F.ws;
    const bf16_t* Q = (const bf16_t*)(ws + WS_HID); const bf16_t* Kb = (const bf16_t*)(ws + WS_R1); const bf16_t* Vb = Kb + (size_t)NB * KVL * D;
    bf16_t* O = (bf16_t*)(ws + WS_HB);
    float* scr = (float*)(ws + WS_ATTSCR) + (size_t)F.bx * 65536;
    const float* q1 = inptr(p, 20); const float* k1 = inptr(p, 21); const float* q2 = inptr(p, 22); const float* k2 = inptr(p, 23); const float* subg = inptr(p, 24);
    float d1 = q1[F.lane] * k1[F.lane] + q1[64 + F.lane] * k1[64 + F.lane];
    float d2 = q2[F.lane] * k2[F.lane] + q2[64 + F.lane] * k2[64 + F.lane];
#pragma unroll
    for (int o = 32; o >= 1; o >>= 1) { d1 += __shfl_xor(d1, o); d2 += __shfl_xor(d2, o); }
    const float lam_init = 0.8f - 0.6f * 0.7408182206817179f;
    const float lam = expf(d1) - expf(d2) + lam_init, onem = 1.0f - lam_init;
    const int vcu = (F.G % 8 == 0) ? (F.bx % 8) * (F.G / 8) + F.bx / 8 : F.bx;
#pragma unroll 1
    for (int U = vcu; U < NB * 8 * 8; U += F.G) {
        const int bh = U >> 3, b = bh >> 3, h = bh & 7, qb = U & 7;
        const bf16_t* Qb = Q + ((size_t)b * SEQ + qb * 256) * D + h * 256;
        const bf16_t* Kh = Kb + (size_t)b * KVL * D + h * 256;
        const bf16_t* Vh = Vb + (size_t)b * KVL * D + h * 256;
        bf16_t* Ob = O + ((size_t)b * SEQ + qb * 256) * D + h * 256;
#pragma unroll 1
        for (int pass = 0; pass < 4; ++pass) {
            const int m = pass & 1, vh = pass >> 1;
            __syncthreads();
            att::attn_pass(Qb + m * 128, Kh + m * 128, Vh + vh * 128, Ob, scr, F.wave, pass, lam, onem, subg, KVL, (char*)F.lds);
        }
    }
    __syncthreads();
}

__device__ __forceinline__ void moe_setup(const Frame& F, int l) {
    LAS int* pre = (LAS int*)(F.lds + LX_PRE); LAS int* cnt = (LAS int*)(F.lds + LX_CNT);
    __syncthreads();
    if (F.tid == 0) {
        const unsigned* cntg = (const unsigned*)(F.ws + WS_CTL) + CW_CNT + l * 64; int acc = 0;
        for (int e = 0; e < 16; ++e) { const int c = (int)__hip_atomic_load(cntg + e, __ATOMIC_RELAXED, __HIP_MEMORY_SCOPE_AGENT); cnt[e] = c; pre[e] = acc; acc += (c + 255) >> 8; }
        pre[16] = acc;
    }
    __syncthreads();
}

__global__ void __launch_bounds__(512, 2) mega_fwd(Params p) {
    extern __shared__ __attribute__((aligned(16))) unsigned char lds_raw[];
    Frame F;
    F.lds = (LAS unsigned char*)lds_raw;
    F.wave = __builtin_amdgcn_readfirstlane(threadIdx.x >> 6); refresh(F);
    F.G = gridDim.x; F.bx = blockIdx.x; F.ws = p.ws; F.out = p.out;
    if (F.tid < 4) ((LAS unsigned*)(F.lds + LX_BAR))[F.tid] = 0u;
    __syncthreads();
    XcdBarrier bar = xcd_barrier_post((unsigned*)(p.ws + WS_CTL) + CW_BAR, (volatile LAS unsigned*)(F.lds + LX_BAR));
    const int lo = p.ph_lo, hi = p.ph_hi, stop = p.stop;
#define PHR(v) ({ int _v = (v); asm volatile("" : "+s"(_v)); _v; })
    unsigned char* ws = p.ws;
    const float* mod = (const float*)(ws + WS_MOD);
    int ph = 0;
#ifndef MK_MASK
#define MK_MASK 0x1ffff
#endif
#define RUN(k) (((MK_MASK >> (k)) & 1) && PHR(lo) <= (k) && (k) < PHR(hi) && ((k) < PHR(stop) || (k) == NPHASE - 1))
#define SEAM(k) do { if ((k) + 1 < PHR(hi)) xcd_barrier(bar); } while (0)

    if (RUN(0)) { refresh(F); p0_prologue(F, p); } if (PHR(lo) <= 0 && 0 < PHR(hi)) SEAM(0);
    if (RUN(1)) { refresh(F); p1_modreduce(F, p); } if (PHR(lo) <= 1 && 1 < PHR(hi)) SEAM(1);
    if (RUN(2)) { refresh(F); row_phase<0>(F, p, 0, 0); } if (PHR(lo) <= 2 && 2 < PHR(hi)) SEAM(2);
    ph = 3;
    if (RUN(3)) { refresh(F);
        pg8::DenseSched S{(const char*)(ws + WS_HB), (const char*)(ws + WS_W1), NTOK / 256, 5120 / 256, 2048, F.G, F.bx};
        bf16_t* g1o = (bf16_t*)(ws + WS_R1);
        pg8::EpiIn0 E{g1o, g1o + (size_t)NTOK * 1024, g1o + (size_t)2 * NTOK * 1024, g1o + (size_t)3 * NTOK * 1024};
        pg8::gemm_run(F.lds, F.wave, 2048, S, E);
    } if (PHR(lo) <= 3 && 3 < PHR(hi)) SEAM(3);
    if (RUN(4)) { refresh(F); scan_phase(F, p); } if (PHR(lo) <= 4 && 4 < PHR(hi)) SEAM(4);
    if (RUN(5)) { refresh(F);
        pg8::DenseSched S{(const char*)(ws + WS_HB), (const char*)(ws + WS_W3), NTOK / 256, 2048 / 256, 2048, F.G, F.bx};
        pg8::EpiRes E{inptr(p, 0), inptr(p, 2), p.out, (float*)(ws + WS_XC), mod + 4096};
        pg8::gemm_run(F.lds, F.wave, 2048, S, E);
    } if (PHR(lo) <= 5 && 5 < PHR(hi)) SEAM(5);
    for (int l = 0; l < 2; ++l) {
        const int base = l == 0 ? 6 : 13;
        if (l == 1) {
            if (RUN(10)) { refresh(F);
                pg8::EpiQKV E{(bf16_t*)(ws + WS_HID), (bf16_t*)(ws + WS_R1), (bf16_t*)(ws + WS_R1) + (size_t)NB * KVL * D, (const float*)(ws + WS_ROPE), (const float*)(ws + WS_ROPE) + 2048};
                pg8::QkvSched S{(const char*)(ws + WS_HB), (const char*)(ws + WS_WQKV), 2048, F.G, F.bx};
                pg8::gemm_run(F.lds, F.wave, 2048, S, E);
            } if (PHR(lo) <= 10 && 10 < PHR(hi)) SEAM(10);
            if (RUN(11)) { refresh(F); attn_phase(F, p); } if (PHR(lo) <= 11 && 11 < PHR(hi)) SEAM(11);
            if (RUN(12)) { refresh(F);
                pg8::DenseSched S{(const char*)(ws + WS_HB), (const char*)(ws + WS_WO), NLAT / 256, 2048 / 256, 2048, F.G, F.bx};
                pg8::EpiRes E{p.out, nullptr, p.out, nullptr, mod + (size_t)17 * MODW + 4096};
                pg8::gemm_run(F.lds, F.wave, 2048, S, E);
            } if (PHR(lo) <= 12 && 12 < PHR(hi)) SEAM(12);
        }
        if (RUN(base)) { refresh(F); row_phase<1>(F, p, l, 0); } if (PHR(lo) <= base && base < PHR(hi)) SEAM(base);
        if (RUN(base + 1)) { refresh(F);
            moe_setup(F, l);
            pg8::MoeSched<true> S{(const char*)(ws + WS_HB), (const char*)(ws + WS_WGU) + (size_t)l * 16 * 2048 * 2048 * 2, (size_t)2048 * 2048 * 2,
                                  (const LAS int*)(F.lds + LX_PRE), (const LAS int*)(F.lds + LX_CNT), (const int*)(ws + WS_LIST), 2048, F.G, F.bx};
            pg8::EpiGU E{(bf16_t*)(ws + WS_HID)};
            pg8::gemm_run(F.lds, F.wave, 2048, S, E);
        } if (PHR(lo) <= base + 1 && base + 1 < PHR(hi)) SEAM(base + 1);
        if (RUN(base + 2)) { refresh(F);
            moe_setup(F, l);
            pg8::MoeSched<false> S{(const char*)(ws + WS_HID), (const char*)(ws + WS_WD) + (size_t)l * 16 * 2048 * 1024 * 2, (size_t)2048 * 1024 * 2,
                                   (const LAS int*)(F.lds + LX_PRE), (const LAS int*)(F.lds + LX_CNT), (const int*)(ws + WS_LIST), 1024, F.G, F.bx};
            pg8::EpiDN E{(bf16_t*)(ws + WS_R1), (const int*)(ws + WS_LIST), (const float*)(ws + WS_LISTG)};
            pg8::gemm_run(F.lds, F.wave, 1024, S, E);
        } if (PHR(lo) <= base + 2 && base + 2 < PHR(hi)) SEAM(base + 2);
        if (l == 0) { if (RUN(9)) { refresh(F); row_phase<2>(F, p, 0, 0); } if (PHR(lo) <= 9 && 9 < PHR(hi)) SEAM(9); }
        else { if (RUN(16)) { refresh(F); row_phase<3>(F, p, 1, p.fin_mode); } }
    }
    (void)ph;
#undef RUN
#undef SEAM
}

extern "C" void kernel_launch(void* const* d_in, const int* in_sizes, int n_in, void* d_out, int out_size, void* d_ws, size_t ws_size, hipStream_t stream) {
    static int grid = 0;
    if (grid == 0) {
        if (n_in != 31 || in_sizes[0] != NLAT * D || out_size != NLAT * D || ws_size < WS_END) {
            fprintf(stderr, "kernel_launch: shape/workspace mismatch: n_in %d in0 %d out %d ws %zu (need %zu)\n", n_in, n_in > 0 ? in_sizes[0] : -1, out_size, ws_size, (size_t)WS_END); grid = -1; return; }
        int dev = 0, cus = 0, per_cu = 0;
        if (hipGetDevice(&dev) != hipSuccess || hipDeviceGetAttribute(&cus, hipDeviceAttributeMultiprocessorCount, dev) != hipSuccess) { grid = -1; return; }
        if (hipFuncSetAttribute((const void*)mega_fwd, hipFuncAttributeMaxDynamicSharedMemorySize, LDS_BYTES) != hipSuccess) { fprintf(stderr, "kernel_launch: hipFuncSetAttribute failed\n"); grid = -1; return; }
        if (hipOccupancyMaxActiveBlocksPerMultiprocessor(&per_cu, (const void*)mega_fwd, 512, LDS_BYTES) != hipSuccess || per_cu < 1)
            fprintf(stderr, "kernel_launch: occupancy query reports %d blocks per CU\n", per_cu);
        (void)hipGetLastError();
        grid = cus;
    }
    if (grid < 0) return;
    (void)hipMemsetAsync((char*)d_ws + WS_CTL, 0, CTL_BYTES, stream);
    Params p{};
    for (int i = 0; i < 31; ++i) p.in[i] = (const float*)d_in[i];
    p.out = (float*)d_out; p.ws = (unsigned char*)d_ws;
    p.stop = MK_STOP;
    p.fin_mode = (MK_STOP >= NPHASE - 1) ? 0 : (MK_STOP <= 5 ? 2 : 1);
#if MK_LAUNCHES
    for (int ph = 0; ph < NPHASE; ++ph) {
        if (!(ph < MK_STOP || ph == NPHASE - 1)) continue;
        p.ph_lo = ph; p.ph_hi = ph + 1;
        hipLaunchKernelGGL(mega_fwd, dim3(grid), dim3(512), LDS_BYTES, stream, p);
    }
#else
    p.ph_lo = 0; p.ph_hi = NPHASE;
    hipLaunchKernelGGL(mega_fwd, dim3(grid), dim3(512), LDS_BYTES, stream, p);
#endif
    const hipError_t le = hipPeekAtLastError();
    if (le != hipSuccess) fprintf(stderr, "kernel_launch: launch failed: %s\n", hipGetErrorName(le));
}
```

```cpp
#include <hip/hip_runtime.h>
#include <cstdio>
#include <cstdint>

#ifndef MK_LAUNCHES
#define MK_LAUNCHES 0
#endif
#ifndef MK_STOP
#define MK_STOP 99
#endif
#ifndef MK_REPEAT
#define MK_REPEAT 0
#endif
#ifndef MK_NAIVE
#define MK_NAIVE 0
#endif

#define LAS __attribute__((address_space(3)))
typedef unsigned short bf16_t;
typedef short bf16x8 __attribute__((ext_vector_type(8)));
typedef short s16x4 __attribute__((ext_vector_type(4)));
typedef float f32x4 __attribute__((ext_vector_type(4)));
typedef float f32x16 __attribute__((ext_vector_type(16)));
typedef unsigned u32x4 __attribute__((ext_vector_type(4)));
typedef unsigned u32x2 __attribute__((ext_vector_type(2)));

constexpr int D = 2048, NB = 16, SEQ = 2048, CTXL = 256;
constexpr int NLAT = NB * SEQ, NCTX = NB * CTXL, NTOK = NLAT + NCTX;
constexpr int NE = 16, FF = 1024, KVL = CTXL + SEQ;
constexpr int MODW = 6 * D;
constexpr float EPS = 1e-6f;
constexpr int NPHASE = 17;

constexpr size_t al256(size_t x) { return (x + 255) & ~(size_t)255; }
constexpr size_t WS_CTL = 0, CTL_BYTES = 65536;
constexpr int CW_BAR = 0, CW_CNT = 4096;
constexpr size_t WS_MOD = WS_CTL + CTL_BYTES;
constexpr size_t WS_ROPE = WS_MOD + al256((size_t)2 * 17 * MODW * 4);
constexpr size_t WS_GW = WS_ROPE + 16384;
constexpr size_t WS_W1 = WS_GW + (size_t)2 * 8 * 2 * 128 * 128 * 2;
constexpr size_t WS_W3 = WS_W1 + (size_t)5120 * 2048 * 2;
constexpr size_t WS_WQKV = WS_W3 + (size_t)2048 * 2048 * 2;
constexpr size_t WS_WO = WS_WQKV + (size_t)6144 * 2048 * 2;
constexpr size_t WS_WGU = WS_WO + (size_t)2048 * 2048 * 2;
constexpr size_t WS_WD = WS_WGU + (size_t)32 * 2048 * 2048 * 2;
constexpr size_t WS_XR = WS_WD + (size_t)32 * 2048 * 1024 * 2;
constexpr size_t WS_HB = WS_XR + (size_t)NTOK * D * 2;
constexpr size_t WS_R1 = WS_HB + (size_t)NTOK * D * 2;
constexpr size_t R1_BYTES = (size_t)2 * NTOK * D * 2;
constexpr size_t WS_HID = WS_R1 + R1_BYTES;
constexpr size_t HID_ROWS = 77824, HID_BYTES = HID_ROWS * FF * 2;
constexpr size_t WS_LIST = WS_HID + HID_BYTES;
constexpr size_t WS_LISTG = WS_LIST + (size_t)NE * NTOK * 4;
constexpr size_t WS_END = WS_LISTG + (size_t)NE * NTOK * 4;
constexpr size_t WS_ATTSCR = WS_WGU;
static_assert((size_t)NTOK * 1024 * 4 <= HID_BYTES && (size_t)NLAT * D * 2 <= HID_BYTES && (size_t)2 * 16 * 17 * MODW * 4 <= HID_BYTES, "HID aliases");
static_assert((size_t)256 * 65536 * 4 <= (size_t)16 * 2048 * 2048 * 2, "attention scratch fits in layer-0 expert weights");

constexpr int STAGE_BYTES = 131072;
constexpr int LX = 147456;
constexpr int LX_BAR = LX + 0;
constexpr int LX_PRE = LX + 64;
constexpr int LX_CNT = LX + 192;
constexpr int LX_LCNT = LX + 256;
constexpr int LX_LBASE = LX + 320;
constexpr int LX_REC = LX + 512;
constexpr int LX_RECG = LX + 2048;
constexpr int LX_MISC = LX + 4096;
constexpr int LDS_BYTES = LX + 8192;
constexpr int ROWCH = 192;

struct Params { const float* in[31]; float* out; unsigned char* ws; int ph_lo, ph_hi; int fin_mode, stop; };

__device__ __forceinline__ const float* inptr(const Params& p, int i) { asm volatile("" : "+s"(i)); return p.in[i]; }
__device__ __forceinline__ unsigned cvt_pk_bf16(float lo, float hi) { unsigned r; asm("v_cvt_pk_bf16_f32 %0, %1, %2" : "=v"(r) : "v"(lo), "v"(hi)); return r; }
__device__ __forceinline__ float bflo(unsigned w) { return __uint_as_float(w << 16); }
__device__ __forceinline__ float bfhi(unsigned w) { return __uint_as_float(w & 0xffff0000u); }
__device__ __forceinline__ float bf2f(bf16_t b) { return __uint_as_float(((unsigned)b) << 16); }
__device__ __forceinline__ float fsigmoid(float x) { return __builtin_amdgcn_rcpf(1.0f + __expf(-x)); }
__device__ __forceinline__ float fsilu(float x) { return x * fsigmoid(x); }
__device__ __forceinline__ float fgelu_tanh(float x) { const float z = 1.5957691216057308f * (x + 0.044715f * x * x * x); return x * fsigmoid(z); }
__device__ __forceinline__ u32x4 pack8(const float (&v)[8]) { u32x4 w; w.x = cvt_pk_bf16(v[0], v[1]); w.y = cvt_pk_bf16(v[2], v[3]); w.z = cvt_pk_bf16(v[4], v[5]); w.w = cvt_pk_bf16(v[6], v[7]); return w; }
__device__ __forceinline__ void unpack8(const u32x4 w, float (&v)[8]) { v[0] = bflo(w.x); v[1] = bfhi(w.x); v[2] = bflo(w.y); v[3] = bfhi(w.y); v[4] = bflo(w.z); v[5] = bfhi(w.z); v[6] = bflo(w.w); v[7] = bfhi(w.w); }

#define XB_TMO      128
#define XB_XCNT(j)  (256  + 64 * (j))
#define XB_XSUB(j)  (1280 + 64 * (j))
#define XB_XGEN(j)  (2304 + 64 * (j))
#define XB_TOP      3328
#define XB_TOPGEN   3392
#define XCD_BAR_WORDS 3456
#define XB_SPIN_CAP (1u << 18)
__device__ __forceinline__ unsigned xb_ld(unsigned* p)              { return __hip_atomic_load(p, __ATOMIC_RELAXED, __HIP_MEMORY_SCOPE_AGENT); }
__device__ __forceinline__ unsigned xb_add(unsigned* p, unsigned v) { return __hip_atomic_fetch_add(p, v, __ATOMIC_RELAXED, __HIP_MEMORY_SCOPE_AGENT); }
__device__ __forceinline__ unsigned xb_xcc_id() { return (unsigned)__builtin_amdgcn_s_getreg((3 << 11) | 20) & 0xFu; }
#define XB_SPIN(cond, bar) do { unsigned _sp = 0; while (cond) { __builtin_amdgcn_s_sleep(1); \
    if ((++_sp & 255u) == 0u) { if (xb_ld(&(bar)[XB_TMO])) break; if (_sp > XB_SPIN_CAP) { atomicAdd(&(bar)[XB_TMO], 1u); break; } } } } while (0)
struct XcdBarrier { unsigned* bar; unsigned x; volatile LAS unsigned* st; };
__device__ __forceinline__ XcdBarrier xcd_barrier_post(unsigned* bar, volatile LAS unsigned* st) {
    XcdBarrier b; b.bar = bar; b.x = xb_xcc_id(); b.st = st;
    if (threadIdx.x == 0) (void)xb_add(&bar[XB_XCNT(b.x)], 1u);
    return b;
}
__device__ __forceinline__ void xcd_barrier_complete(unsigned* bar, unsigned x, unsigned& nloc, unsigned& nx) {
    const unsigned G = gridDim.x * gridDim.y * gridDim.z;
    unsigned sum, cnt, mine, sp = 0u;
    for (;;) {
        sum = 0u; cnt = 0u; mine = 0u;
#pragma unroll
        for (unsigned j = 0; j < 16; ++j) { const unsigned c = xb_ld(&bar[XB_XCNT(j)]); sum += c; cnt += (c > 0u) ? 1u : 0u; mine = (j == x) ? c : mine; }
        if (sum == G) break;
        __builtin_amdgcn_s_sleep(1);
        if ((++sp & 255u) == 0u) { if (xb_ld(&bar[XB_TMO])) break; if (sp > XB_SPIN_CAP) { atomicAdd(&bar[XB_TMO], 1u); break; } }
    }
    nloc = mine > 0u ? mine : 1u; nx = cnt > 0u ? cnt : 1u;
}
__device__ __forceinline__ void xcd_barrier(const XcdBarrier& b) {
    asm volatile("s_waitcnt vmcnt(0)" ::: "memory");
    __syncthreads();
    if (threadIdx.x == 0) {
        unsigned* bar = b.bar;
        __builtin_amdgcn_s_waitcnt(0);
        unsigned nloc = b.st[0], nx = b.st[1];
        if (nloc == 0u) { xcd_barrier_complete(bar, b.x, nloc, nx); b.st[0] = nloc; b.st[1] = nx; }
        const unsigned old = xb_add(&bar[XB_XSUB(b.x)], 1u);
        const unsigned gen = old / nloc;
        if (old + 1u == (gen + 1u) * nloc) {
            __builtin_amdgcn_fence(__ATOMIC_RELEASE, "agent");
            asm volatile("s_waitcnt vmcnt(0)" ::: "memory");
            const unsigned og = xb_add(&bar[XB_TOP], 1u);
            const unsigned tg = og / nx;
            if (og + 1u == (tg + 1u) * nx) xb_add(&bar[XB_TOPGEN], 1u);
            else XB_SPIN(xb_ld(&bar[XB_TOPGEN]) == tg, bar);
            __builtin_amdgcn_fence(__ATOMIC_ACQUIRE, "agent");
            xb_add(&bar[XB_XGEN(b.x)], 1u);
            asm volatile("s_waitcnt vmcnt(0)" ::: "memory");
        } else {
            XB_SPIN(xb_ld(&bar[XB_XGEN(b.x)]) == gen, bar);
            __builtin_amdgcn_fence(__ATOMIC_ACQUIRE, "agent");
            asm volatile("s_waitcnt vmcnt(0)" ::: "memory");
        }
    }
    __syncthreads();
}

struct Frame {
    LAS unsigned char* lds;
    int tid, lane, wave, G, bx;
    unsigned char* ws;
    float* out;
};
__device__ __forceinline__ int lane_id() { return (int)__builtin_amdgcn_mbcnt_hi(~0u, __builtin_amdgcn_mbcnt_lo(~0u, 0u)); }
__device__ __forceinline__ int tid_rebuild(int wave) { int t = wave * 64 + lane_id(); asm volatile("" : "+v"(t)); return t; }
__device__ __forceinline__ void refresh(Frame& F) { const int t = tid_rebuild(F.wave); F.tid = t; F.lane = t & 63; }
__device__ __forceinline__ int modrow_of(int t) { return t < NLAT ? (t >> 11) : 16; }

constexpr int XT_W1 = 20 * 32, XT_W3 = 8 * 32, XT_WQKV = 24 * 32, XT_WO = 8 * 32, XT_WGU = 32 * 8 * 32, XT_WD = 32 * 8 * 16;
constexpr int XT_TOTAL = XT_W1 + XT_W3 + XT_WQKV + XT_WO + XT_WGU + XT_WD;
constexpr int ADA_UNITS = 2 * 16 * 24;
constexpr int P0_UNITS = XT_TOTAL + ADA_UNITS + 1 + 16;

__device__ __forceinline__ void xpose_tile(const Frame& F, const float* srcg  , int ld, bf16_t* dst, int K, int rb, int kb) {
    LAS unsigned* T = (LAS unsigned*)F.lds;
    const int l = F.lane, w = F.wave, kq = l >> 3, c4 = (l & 7) * 4;
    const float* s = srcg + (size_t)(kb * 64 + 2 * kq) * ld + c4;
    f32x4 v0[4], v1[4];
#pragma unroll
    for (int it = 0; it < 4; ++it) { v0[it] = *(const f32x4*)(s + (size_t)(16 * it) * ld); v1[it] = *(const f32x4*)(s + (size_t)(16 * it + 1) * ld); }
#pragma unroll
    for (int it = 0; it < 4; ++it)
#pragma unroll
        for (int j = 0; j < 4; ++j) T[(w * 32 + c4 + j) * 36 + 8 * it + kq] = cvt_pk_bf16(v0[it][j], v1[it][j]);
    __syncthreads();
#pragma unroll
    for (int it = 0; it < 4; ++it) { const int q = F.tid + 512 * it, row = q >> 3, piece = q & 7;
        const u32x4 v = *(const LAS u32x4*)(T + row * 36 + piece * 4);
        *(u32x4*)(dst + (size_t)(rb * 256 + row) * K + kb * 64 + piece * 8) = v; }
    __syncthreads();
}

__device__ __forceinline__ void p0_prologue(const Frame& F, const Params& p) {
    unsigned char* ws = F.ws;
    for (int u = F.bx; u < P0_UNITS; u += F.G) {
        if (u < XT_TOTAL) {
            int T = u; const int gi = F.wave;
            const float* src; int ld, col0, K, rb, kb; bf16_t* dst;
            if (T < XT_W1) { rb = T >> 5; kb = T & 31; K = 2048; ld = 5120; src = inptr(p, 9); dst = (bf16_t*)(ws + WS_W1);
                col0 = rb < 8 ? (gi < 4 ? 1024 + rb * 128 + gi * 32 : 2048 + rb * 128 + (gi - 4) * 32) : rb < 12 ? (rb - 8) * 256 + gi * 32 : rb < 16 ? 3072 + (rb - 12) * 256 + gi * 32 : 4096 + (rb - 16) * 256 + gi * 32; }
            else if ((T -= XT_W1) < XT_W3) { rb = T >> 5; kb = T & 31; K = 2048; ld = 2048; src = inptr(p, 18); dst = (bf16_t*)(ws + WS_W3); col0 = rb * 256 + gi * 32; }
            else if ((T -= XT_W3) < XT_WQKV) { rb = T >> 5; kb = T & 31; K = 2048; ld = 6144; src = inptr(p, 19); dst = (bf16_t*)(ws + WS_WQKV);
                if (rb < 16) { const int part = rb >> 3, head = rb & 7, g4 = gi & 3, m = g4 >> 1, a = g4 & 1; col0 = part * 2048 + head * 256 + m * 128 + a * 64 + (gi >= 4 ? 32 : 0); }
                else col0 = 4096 + (rb - 16) * 256 + gi * 32; }
            else if ((T -= XT_WQKV) < XT_WO) { rb = T >> 5; kb = T & 31; K = 2048; ld = 2048; src = inptr(p, 25); dst = (bf16_t*)(ws + WS_WO); col0 = rb * 256 + gi * 32; }
            else if ((T -= XT_WO) < XT_WGU) { const int le = T >> 8; rb = (T >> 5) & 7; kb = T & 31; K = 2048; ld = 1024;
                src = (gi < 4 ? inptr(p, 28) : inptr(p, 29)) + (size_t)le * 2048 * 1024; col0 = rb * 128 + (gi & 3) * 32; dst = (bf16_t*)(ws + WS_WGU) + (size_t)le * 2048 * 2048; }
            else { T -= XT_WGU; const int le = T >> 7; rb = (T >> 4) & 7; kb = T & 15; K = 1024; ld = 2048;
                src = inptr(p, 30) + (size_t)le * 1024 * 2048; col0 = rb * 256 + gi * 32; dst = (bf16_t*)(ws + WS_WD) + (size_t)le * 2048 * 1024; }
            xpose_tile(F, src + col0, ld, dst, K, rb, kb);
        } else if (u < XT_TOTAL + ADA_UNITS) {
            const int a = u - XT_TOTAL, l = a / 384, rem = a % 384, kc = rem / 24, cb = rem % 24;
            LAS float* sl = (LAS float*)F.lds;
            const float* cin = inptr(p, 1); const float* cctx = inptr(p, 3);
            for (int i = F.tid; i < 17 * 128; i += 512) { const int r = i >> 7, k = i & 127; const float cv = r < 16 ? cin[r * D + kc * 128 + k] : cctx[kc * 128 + k]; sl[i] = cv / (1.0f + expf(-cv)); }
            __syncthreads();
            const int col = cb * 512 + F.tid;
            const float* wp = inptr(p, 4) + ((size_t)l * D + kc * 128) * MODW + col;
            float acc[17];
#pragma unroll
            for (int r = 0; r < 17; ++r) acc[r] = 0.f;
            for (int k0 = 0; k0 < 128; k0 += 8) {
                float wv[8];
#pragma unroll
                for (int j = 0; j < 8; ++j) wv[j] = wp[(size_t)(k0 + j) * MODW];
#pragma unroll
                for (int r = 0; r < 17; ++r) { const f32x4 s0 = *(const LAS f32x4*)(sl + r * 128 + k0), s1 = *(const LAS f32x4*)(sl + r * 128 + k0 + 4);
                    acc[r] += s0[0] * wv[0] + s0[1] * wv[1] + s0[2] * wv[2] + s0[3] * wv[3] + s1[0] * wv[4] + s1[1] * wv[5] + s1[2] * wv[6] + s1[3] * wv[7]; }
            }
            float* part = (float*)(ws + WS_HID) + ((size_t)(l * 16 + kc) * 17) * MODW + col;
#pragma unroll
            for (int r = 0; r < 17; ++r) part[(size_t)r * MODW] = acc[r];
            __syncthreads();
        } else if (u == XT_TOTAL + ADA_UNITS) {
            float* rc = (float*)(ws + WS_ROPE); float* rs = rc + 2048;
            for (int i = F.tid; i < 2048; i += 512) { const int pos = i >> 5, j = i & 31;
                const float inv = exp2f(-(float)(2 * j) * (13.287712379549449f / 64.0f)); const float ang = (float)pos * inv;
                rc[i] = cosf(ang); rs[i] = sinf(ang); }
        } else {
            const int q = u - (XT_TOTAL + ADA_UNITS + 1), d = q >> 3, h = q & 7;
            bf16_t* gw = (bf16_t*)(ws + WS_GW) + (size_t)(d * 8 + h) * 2 * 128 * 128;
            const float* wa = inptr(p, 13) + (size_t)(d * 8 + h) * 128 * 128; const float* wi = inptr(p, 15) + (size_t)(d * 8 + h) * 128 * 128;
            for (int i = F.tid; i < 128 * 128; i += 512) { const int k = i >> 7, j = i & 127, half = j >> 6, o = j & 63;
                gw[(size_t)(half * 128 + o) * 128 + k] = (bf16_t)(cvt_pk_bf16(wa[i], 0.f) & 0xffffu);
                gw[(size_t)(half * 128 + 64 + o) * 128 + k] = (bf16_t)(cvt_pk_bf16(wi[i], 0.f) & 0xffffu); }
        }
    }
}

__device__ __forceinline__ void p1_modreduce(const Frame& F, const Params& p) {
    const float* part = (const float*)(F.ws + WS_HID); float* mod = (float*)(F.ws + WS_MOD);
    const int n4 = 2 * 17 * MODW / 4; const float* adab = inptr(p, 5);
    for (int i = F.bx * 512 + F.tid; i < n4; i += F.G * 512) {
        const int e = i * 4, l = e / (17 * MODW), rr = (e / MODW) % 17, n = e % MODW;
        f32x4 s = *(const f32x4*)(adab + (size_t)l * MODW + n);
#pragma unroll
        for (int kc = 0; kc < 16; ++kc) s += *(const f32x4*)(part + ((size_t)(l * 16 + kc) * 17 + rr) * MODW + n);
        *(f32x4*)(mod + e) = s;
    }
}

struct RowRegs { f32x4 x[8]; u32x2 y0[8], y1[8]; };
template <int MODE>
__device__ __forceinline__ void row_load(RowRegs& R, const int t, const int lane, const int fin_mode, const float* xin0, const float* xin2, const bf16_t* XR, const bf16_t* Y0, const bf16_t* Y1) {
    if (MODE == 0 || (MODE == 3 && fin_mode == 2)) {
        const float* src = t < NLAT ? xin0 + (size_t)t * D : xin2 + (size_t)(t - NLAT) * D;
#pragma unroll
        for (int j = 0; j < 8; ++j) R.x[j] = *(const f32x4*)(src + 256 * j + 4 * lane);
    } else {
#pragma unroll
        for (int j = 0; j < 8; ++j) { const u32x2 a = *(const u32x2*)(XR + (size_t)t * D + 256 * j + 4 * lane); R.x[j] = (f32x4){bflo(a.x), bfhi(a.x), bflo(a.y), bfhi(a.y)}; }
    }
    if (MODE == 2 || (MODE == 3 && fin_mode == 0)) {
#pragma unroll
        for (int j = 0; j < 8; ++j) { R.y0[j] = *(const u32x2*)(Y0 + (size_t)t * D + 256 * j + 4 * lane); R.y1[j] = *(const u32x2*)(Y1 + (size_t)t * D + 256 * j + 4 * lane); }
    }
}
template <int MODE>
__device__ __forceinline__ void row_phase(const Frame& F, const Params& p, const int l, const int fin_mode) {
    unsigned char* ws = F.ws;
    const float* mod = (const float*)(ws + WS_MOD);
    bf16_t* HB = (bf16_t*)(ws + WS_HB); bf16_t* XR = (bf16_t*)(ws + WS_XR);
    const bf16_t* Y0 = (const bf16_t*)(ws + WS_R1); const bf16_t* Y1 = Y0 + (size_t)NTOK * D;
    const int nrows = (MODE == 3 || (MODE == 1 && l == 1)) ? NLAT : NTOK;
    const int chunk = (nrows + F.G - 1) / F.G, r_begin = F.bx * chunk, r_end = min(nrows, r_begin + chunk);
    const int lane = F.lane, w = F.wave;
    LAS float* wl = (LAS float*)F.lds;
    LAS float* cA = (LAS float*)(F.lds + 131072); LAS float* cB = cA + 2048;
    LAS int* lcnt = (LAS int*)(F.lds + LX_LCNT); LAS int* lbase = (LAS int*)(F.lds + LX_LBASE);
    LAS int* rec = (LAS int*)(F.lds + LX_REC); LAS float* recg = (LAS float*)(F.lds + LX_RECG);
    LAS float* rbl = (LAS float*)(F.lds + LX_MISC);
    if (MODE == 1) {
        const float* rw = inptr(p, 26);
        for (int i = F.tid; i < 2048 * 16; i += 512) { const int k = i >> 4, e = i & 15; wl[e * 2048 + k] = rw[i]; }
        if (F.tid < 16) { lcnt[F.tid] = 0; rbl[F.tid] = inptr(p, 27)[F.tid]; }
    }
    const float* gain = MODE == 0 ? inptr(p, 6) : MODE == 1 ? inptr(p, 7) + (size_t)l * D : MODE == 2 ? inptr(p, 6) + D : inptr(p, 8);
    const int sh_off = (MODE == 1) ? 6144 : 0, sc_off = (MODE == 1) ? 8192 : 2048;
    const int lmod = (MODE == 2) ? 1 : l;
    const float* xin0 = inptr(p, 0); const float* xin2 = inptr(p, 2);
    for (int rs = r_begin; rs < r_end; rs += ROWCH) {
        const int re = min(r_end, rs + ROWCH);
        for (int sb = rs; sb < re;) {
            const int b = modrow_of(sb);
            const int bend = b < 16 ? (b + 1) * SEQ : NTOK, se = min(re, bend);
            __syncthreads();
            for (int c4 = F.tid; c4 < 512; c4 += 512) {
                const int col = c4 * 4; const f32x4 g = *(const f32x4*)(gain + col);
                if (MODE == 3) { *(LAS f32x4*)(cA + col) = g; }
                else { const f32x4 sc = *(const f32x4*)(mod + ((size_t)lmod * 17 + b) * MODW + sc_off + col), sh = *(const f32x4*)(mod + ((size_t)lmod * 17 + b) * MODW + sh_off + col);
                    *(LAS f32x4*)(cA + col) = g * (1.0f + sc); *(LAS f32x4*)(cB + col) = sh; }
                if (MODE == 2 || MODE == 3) *(LAS f32x4*)(wl + col) = *(const f32x4*)(mod + ((size_t)l * 17 + b) * MODW + 10240 + col);
            }
            __syncthreads();
            RowRegs cur, nxt;
            int t = sb + w;
            if (t < se) row_load<MODE>(cur, t, lane, fin_mode, xin0, xin2, XR, Y0, Y1);
            for (; t < se; t += 8) {
                const int tn = t + 8;
                if (tn < se) row_load<MODE>(nxt, tn, lane, fin_mode, xin0, xin2, XR, Y0, Y1);
                f32x4 v[8];
#pragma unroll
                for (int j = 0; j < 8; ++j) v[j] = cur.x[j];
                if (MODE == 2 || (MODE == 3 && fin_mode == 0)) {
#pragma unroll
                    for (int j = 0; j < 8; ++j) { const int col = 256 * j + 4 * lane; const f32x4 g = *(const LAS f32x4*)(wl + col); const u32x2 a = cur.y0[j], c = cur.y1[j];
                        v[j][0] += g[0] * (bflo(a.x) + bflo(c.x)); v[j][1] += g[1] * (bfhi(a.x) + bfhi(c.x));
                        v[j][2] += g[2] * (bflo(a.y) + bflo(c.y)); v[j][3] += g[3] * (bfhi(a.y) + bfhi(c.y)); }
                    if (MODE == 2) {
#pragma unroll
                        for (int j = 0; j < 8; ++j) { u32x2 o; o.x = cvt_pk_bf16(v[j][0], v[j][1]); o.y = cvt_pk_bf16(v[j][2], v[j][3]); *(u32x2*)(XR + (size_t)t * D + 256 * j + 4 * lane) = o;
                            v[j] = (f32x4){bflo(o.x), bfhi(o.x), bflo(o.y), bfhi(o.y)}; }
                    }
                }
                float ss = 0.f;
#pragma unroll
                for (int j = 0; j < 8; ++j) ss += v[j][0] * v[j][0] + v[j][1] * v[j][1] + v[j][2] * v[j][2] + v[j][3] * v[j][3];
#pragma unroll
                for (int o = 32; o >= 1; o >>= 1) ss += __shfl_xor(ss, o);
                const float rstd = 1.0f / sqrtf(ss * (1.0f / 2048.0f) + EPS);
                if (MODE == 3) {
                    float* dst = F.out + (size_t)t * D;
#pragma unroll
                    for (int j = 0; j < 8; ++j) { const f32x4 g = *(const LAS f32x4*)(cA + 256 * j + 4 * lane); *(f32x4*)(dst + 256 * j + 4 * lane) = v[j] * rstd * g; }
                } else {
#pragma unroll
                    for (int j = 0; j < 8; ++j) { const int col = 256 * j + 4 * lane;
                        const f32x4 ca = *(const LAS f32x4*)(cA + col), cb = *(const LAS f32x4*)(cB + col);
                        v[j] = v[j] * rstd * ca + cb;
                        u32x2 o; o.x = cvt_pk_bf16(v[j][0], v[j][1]); o.y = cvt_pk_bf16(v[j][2], v[j][3]);
                        *(u32x2*)(HB + (size_t)t * D + col) = o; }
                    if (MODE == 1) {
                        float pe[16];
#pragma unroll
                        for (int e = 0; e < 16; ++e) { float s = 0.f;
#pragma unroll
                            for (int j = 0; j < 8; ++j) { const f32x4 wv = *(const LAS f32x4*)(wl + e * 2048 + 256 * j + 4 * lane); s += v[j][0] * wv[0] + v[j][1] * wv[1] + v[j][2] * wv[2] + v[j][3] * wv[3]; }
                            pe[e] = s; }
#pragma unroll
                        for (int e = 0; e < 16; ++e) {
#pragma unroll
                            for (int o = 32; o >= 1; o >>= 1) pe[e] += __shfl_xor(pe[e], o); }
                        float scv[16], sel[16];
#pragma unroll
                        for (int e = 0; e < 16; ++e) { scv[e] = 1.0f / (1.0f + expf(-pe[e])); sel[e] = scv[e] + rbl[e]; }
                        float best = -3.0e38f, bs1 = 0.f, bs2 = 0.f; int be1 = 0, be2 = 1;
#pragma unroll
                        for (int g = 0; g < 4; ++g) {
                            const float a0 = sel[4 * g], a1 = sel[4 * g + 1], a2 = sel[4 * g + 2], a3 = sel[4 * g + 3];
                            const float c0 = scv[4 * g], c1 = scv[4 * g + 1], c2 = scv[4 * g + 2], c3 = scv[4 * g + 3];
                            int i1 = 0; float m1 = a0, s1 = c0; if (a1 > m1) { m1 = a1; i1 = 1; s1 = c1; } if (a2 > m1) { m1 = a2; i1 = 2; s1 = c2; } if (a3 > m1) { m1 = a3; i1 = 3; s1 = c3; }
                            int i2 = -1; float m2 = -3.0e38f, s2 = 0.f;
                            if (i1 != 0 && a0 > m2) { m2 = a0; i2 = 0; s2 = c0; } if (i1 != 1 && a1 > m2) { m2 = a1; i2 = 1; s2 = c1; } if (i1 != 2 && a2 > m2) { m2 = a2; i2 = 2; s2 = c2; } if (i1 != 3 && a3 > m2) { m2 = a3; i2 = 3; s2 = c3; }
                            const float gs = m1 + m2;
                            if (gs > best) { best = gs; be1 = 4 * g + i1; be2 = 4 * g + i2; bs1 = s1; bs2 = s2; }
                        }
                        if (lane == 0) { const float inv = 1.0f / (bs1 + bs2); const int rl = t - rs;
                            const int p1 = __hip_atomic_fetch_add(lcnt + be1, 1, __ATOMIC_RELAXED, __HIP_MEMORY_SCOPE_WORKGROUP), p2 = __hip_atomic_fetch_add(lcnt + be2, 1, __ATOMIC_RELAXED, __HIP_MEMORY_SCOPE_WORKGROUP);
                            rec[rl * 2] = (be1 << 16) | p1; rec[rl * 2 + 1] = (be2 << 16) | p2; recg[rl * 2] = bs1 * inv; recg[rl * 2 + 1] = bs2 * inv; }
                    }
                }
                if (tn < se) {
#pragma unroll
                    for (int j = 0; j < 8; ++j) { cur.x[j] = nxt.x[j]; cur.y0[j] = nxt.y0[j]; cur.y1[j] = nxt.y1[j]; } }
            }
            sb = se;
        }
        if (MODE == 1) {
            __syncthreads();
            unsigned* cntg = (unsigned*)(ws + WS_CTL) + CW_CNT + l * 64;
            if (F.tid < 16) lbase[F.tid] = (int)__hip_atomic_fetch_add(cntg + F.tid, (unsigned)lcnt[F.tid], __ATOMIC_RELAXED, __HIP_MEMORY_SCOPE_AGENT);
            __syncthreads();
            int* list = (int*)(ws + WS_LIST); float* listg = (float*)(ws + WS_LISTG);
            const int nrec = (re - rs) * 2;
            for (int i = F.tid; i < nrec; i += 512) { const int rr = rec[i], e = rr >> 16, pos = lbase[e] + (rr & 0xffff); const int t = rs + (i >> 1);
                list[(size_t)e * NTOK + pos] = t * 2 + (i & 1); listg[(size_t)e * NTOK + pos] = recg[i]; }
            __syncthreads();
            if (F.tid < 16) lcnt[F.tid] = 0;
            __syncthreads();
        }
    }
}

namespace pg8 {
constexpr int BM = 256, BK = 64, HALF = 128, HTB = HALF * BK * 2, NXCD = 8, WGM = 8;
__host__ __device__ __forceinline__ int lds_byte(int r, int c) { const int st = (r >> 4) * 2 + (c >> 5), rr = r & 15, cc = c & 31, ob = rr * 64 + cc * 2; return st * 1024 + (ob ^ (((ob >> 9) & 1) << 5)); }
__host__ __device__ __forceinline__ void stage_rc(int b, int& R, int& C) { const int st = b / 1024, sb = b % 1024, swz = sb ^ (((sb >> 9) & 1) << 5); R = (st >> 1) * 16 + swz / 64; C = (st & 1) * 32 + (swz % 64) / 2; }
__host__ __device__ __forceinline__ int perm32(int rho) { const int n = rho >> 4, i = rho & 15; return 8 * (i >> 2) + 4 * n + (i & 3); }

struct Unit { int pm, pn, e, pos0, cnt; };

__device__ __forceinline__ bool static_map(long L, int nM, int nN, int& pm, int& pn) {
    const int nwg = nM * nN; if (L >= nwg) return false;
    int wgid = (int)L; { const int q = nwg / NXCD, r = nwg % NXCD, xcd = wgid % NXCD, off = wgid / NXCD; wgid = (xcd < r ? xcd * (q + 1) : r * (q + 1) + (xcd - r) * q) + off; }
    const int nig = WGM * nN, gid = wgid / nig, fm = gid * WGM, gsz = (nM - fm) < WGM ? (nM - fm) : WGM;
    pm = fm + ((wgid % nig) % gsz); pn = (wgid % nig) / gsz; return true;
}
__device__ __forceinline__ bool static_next(int i, int G, int c, int nM, int nN, int& pm, int& pn) { return static_map((long)i * G + c, nM, nN, pm, pn); }
struct DenseSched {
    static constexpr bool GATHER = false;
    const char* A; const char* B; int nM, nN, K, G, c;
    __device__ __forceinline__ bool next(int i, Unit& u) const { u.e = 0; u.pos0 = 0; u.cnt = 0; return static_next(i, G, c, nM, nN, u.pm, u.pn); }
    __device__ __forceinline__ const char* a_tile(const Unit& u) const { return A + (size_t)u.pm * 256 * K * 2; }
    __device__ __forceinline__ unsigned a_row_off(const Unit&, int r) const { return (unsigned)r * (unsigned)K * 2u; }
    __device__ __forceinline__ const char* b_tile(const Unit& u) const { return B + (size_t)u.pn * 256 * K * 2; }
};
struct QkvSched {
    static constexpr bool GATHER = false;
    const char* A; const char* B; int K, G, c;
    __device__ __forceinline__ bool next(int i, Unit& u) const {
        u.pos0 = 0; u.cnt = 0; const long L = (long)i * G + c; constexpr int n1 = (NLAT / 256) * 24;
        if (L < n1) { u.e = 0; return static_map(L, NLAT / 256, 24, u.pm, u.pn); }
        u.e = 1; return static_map(L - n1, NCTX / 256, 16, u.pm, u.pn);
    }
    __device__ __forceinline__ const char* a_tile(const Unit& u) const { return A + ((size_t)(u.e ? NLAT : 0) + (size_t)u.pm * 256) * K * 2; }
    __device__ __forceinline__ unsigned a_row_off(const Unit&, int r) const { return (unsigned)r * (unsigned)K * 2u; }
    __device__ __forceinline__ const char* b_tile(const Unit& u) const { return B + ((size_t)(u.e ? 2048 : 0) + (size_t)u.pn * 256) * K * 2; }
};
template <bool GATHER_> struct MoeSched {
    static constexpr bool GATHER = GATHER_;
    const char* A; const char* B; size_t estride; const LAS int* pre; const LAS int* cnt; const int* list; int K, G, c;
    __device__ __forceinline__ bool next(int i, Unit& u) const {
        const int MT = pre[16]; if (!static_next(i, G, c, MT, 8, u.pm, u.pn)) return false;
        int e = 0;
#pragma unroll
        for (int j = 1; j < 16; ++j) e += (u.pm >= pre[j]) ? 1 : 0;
        u.e = e; u.pos0 = (u.pm - pre[e]) * 256; u.cnt = cnt[e]; return true;
    }
    __device__ __forceinline__ const char* a_tile(const Unit& u) const { return GATHER ? A : A + (size_t)u.pm * 256 * K * 2; }
    __device__ __forceinline__ unsigned a_row_off(const Unit& u, int r) const {
        if (!GATHER) return (unsigned)r * (unsigned)K * 2u;
        const int pos = u.pos0 + r; const int t2 = pos < u.cnt ? list[(size_t)u.e * NTOK + pos] : 0;
        return (unsigned)(t2 >> 1) * (unsigned)K * 2u;
    }
    __device__ __forceinline__ const char* b_tile(const Unit& u) const { return B + (size_t)u.e * estride + (size_t)u.pn * 256 * K * 2; }
};

template <class Epi, class Sched>
__device__ __forceinline__ void gemm_phase(LAS unsigned char* lds, const int wave_in, const int K, const Sched& S, const Epi& E) {
    const int tid = tid_rebuild(wave_in), wid = wave_in, lane = tid & 63, wr = wid >> 2, wc = wid & 3, fr = lane & 15, fq = lane >> 4;
    const int nt = K / BK;
    constexpr bool GA = Sched::GATHER;
    unsigned voffB[2];
#pragma unroll
    for (int i = 0; i < 2; ++i) { int R, C; stage_rc(tid * 16 + i * 8192, R, C); const int Rb = (R & ~31) + perm32(R & 31); voffB[i] = (unsigned)(Rb * K + C) * 2u; }
#define PG8_AOFF(u, h, i, dst) do { int R_, C_; stage_rc(tid * 16 + (i) * 8192, R_, C_); dst = S.a_row_off(u, (h) * 128 + R_) + (unsigned)C_ * 2u; } while (0)
    const size_t kstep = (size_t)(BK * 2);
    const size_t hstep = (size_t)HALF * K * 2;
    const unsigned ldsw = (unsigned)wid * 1024u;
    const int aoff = lds_byte(wr * 64 + fr, fq * 8), boff = lds_byte(wc * 32 + fr, fq * 8);
#define PG8_SA(b, h) (((b) * 2 + (h)) * HTB)
#define PG8_SB(b, h) ((4 + (b) * 2 + (h)) * HTB)
#define PG8_STAGE(bufoff, gbase, voff) do { _Pragma("unroll") for (int _i = 0; _i < 2; ++_i) \
        __builtin_amdgcn_global_load_lds((const unsigned*)((const char*)(gbase) + (voff)[_i]), (LAS unsigned*)(lds + (bufoff) + ldsw + _i * 8192), 16, 0, 0); } while (0)
#define PG8_LDA(dst, b, h) do { _Pragma("unroll") for (int m = 0; m < 4; ++m) _Pragma("unroll") for (int k = 0; k < 2; ++k) dst[m][k] = *(const LAS bf16x8*)(lds + PG8_SA(b, h) + aoff + m * 2048 + k * 1024); } while (0)
#define PG8_LDB(dst, b, h) do { _Pragma("unroll") for (int n = 0; n < 2; ++n) _Pragma("unroll") for (int k = 0; k < 2; ++k) dst[n][k] = *(const LAS bf16x8*)(lds + PG8_SB(b, h) + boff + n * 2048 + k * 1024); } while (0)
#define PG8_MMA(ai, bj, At, Bt) do { __builtin_amdgcn_s_setprio(1); _Pragma("unroll") for (int m = 0; m < 4; ++m) _Pragma("unroll") for (int n = 0; n < 2; ++n) _Pragma("unroll") for (int k = 0; k < 2; ++k) \
        acc[ai][bj][m][n] = __builtin_amdgcn_mfma_f32_16x16x32_bf16(Bt[n][k], At[m][k], acc[ai][bj][m][n], 0, 0, 0); __builtin_amdgcn_s_setprio(0); } while (0)
#define PG8_WAIT_V(n) asm volatile("s_waitcnt vmcnt(" #n ")" ::: "memory")
#define PG8_WAIT_L(n) asm volatile("s_waitcnt lgkmcnt(" #n ")" ::: "memory")
#define PG8_BAR __builtin_amdgcn_s_barrier()
#define PG8_SCHED __builtin_amdgcn_sched_barrier(0)
    Unit cur, nxt; int ui = 0;
    if (!S.next(0, cur)) return;
    f32x4 acc[2][2][4][2];
#pragma unroll
    for (int a = 0; a < 2; ++a)
#pragma unroll
        for (int b = 0; b < 2; ++b)
#pragma unroll
            for (int m = 0; m < 4; ++m)
#pragma unroll
                for (int n = 0; n < 2; ++n) acc[a][b][m][n] = (f32x4){0.f, 0.f, 0.f, 0.f};
    bf16x8 At[4][2], B0[2][2], B1[2][2];
    unsigned cvo0[2], cvo1[2];
#pragma unroll
    for (int i = 0; i < 2; ++i) { PG8_AOFF(cur, 0, i, cvo0[i]); if (GA) PG8_AOFF(cur, 1, i, cvo1[i]); else cvo1[i] = cvo0[i]; }
    LAS unsigned* toff = (LAS unsigned*)(lds + LX + 5120);
    const size_t ahs = GA ? (size_t)0 : hstep;
    const char* cA = S.a_tile(cur); const char* cB = S.b_tile(cur);
    PG8_STAGE(PG8_SB(0, 0), cB, voffB); PG8_STAGE(PG8_SA(0, 0), cA, cvo0); PG8_STAGE(PG8_SB(0, 1), cB + hstep, voffB); PG8_STAGE(PG8_SA(0, 1), cA + ahs, cvo1);
    if (wr == 1) PG8_BAR;
    PG8_WAIT_V(4); PG8_BAR;
    PG8_STAGE(PG8_SB(1, 0), cB + kstep, voffB); PG8_STAGE(PG8_SA(1, 0), cA + kstep, cvo0); PG8_STAGE(PG8_SB(1, 1), cB + hstep + kstep, voffB);
    PG8_WAIT_V(6); PG8_BAR;
    for (;;) {
        const bool has_next = S.next(ui + 1, nxt);
        const char* nA = has_next ? S.a_tile(nxt) : cA; const char* nB = has_next ? S.b_tile(nxt) : cB;
        if (GA && has_next && tid < 256) toff[((ui + 1) & 1) * 256 + tid] = S.a_row_off(nxt, tid);
        for (int t = 0; t < nt; t += 2) {
            const bool last = (t == nt - 2);
            const char* a1 = cA + (size_t)(t + 1) * kstep;
            const char* a2 = last ? nA : cA + (size_t)(t + 2) * kstep; const char* b2 = last ? nB : cB + (size_t)(t + 2) * kstep;
            const char* a3 = a2 + kstep; const char* b3 = b2 + kstep;
            PG8_LDB(B0, 0, 0); PG8_SCHED; PG8_LDA(At, 0, 0); PG8_STAGE(PG8_SA(1, 1), a1 + ahs, cvo1);
            PG8_WAIT_L(8); PG8_BAR; PG8_WAIT_L(0); PG8_MMA(0, 0, At, B0); PG8_BAR; PG8_SCHED;
            if (GA && last && has_next) {
#pragma unroll
                for (int i = 0; i < 2; ++i) { int R_, C_; stage_rc(tid * 16 + i * 8192, R_, C_); const int tb_ = ((ui + 1) & 1) * 256; cvo0[i] = toff[tb_ + R_] + (unsigned)C_ * 2u; cvo1[i] = toff[tb_ + 128 + R_] + (unsigned)C_ * 2u; } }
            PG8_LDB(B1, 0, 1); PG8_STAGE(PG8_SB(0, 0), b2, voffB);
            PG8_BAR; PG8_WAIT_L(0); PG8_MMA(0, 1, At, B1); PG8_BAR;
            PG8_LDA(At, 0, 1); PG8_STAGE(PG8_SA(0, 0), a2, cvo0);
            PG8_BAR; PG8_WAIT_L(0); PG8_MMA(1, 0, At, B0); PG8_BAR; PG8_SCHED;
            PG8_STAGE(PG8_SB(0, 1), b2 + hstep, voffB);
            PG8_WAIT_V(6); PG8_BAR; PG8_MMA(1, 1, At, B1); PG8_BAR;
            PG8_LDB(B0, 1, 0); PG8_SCHED; PG8_LDA(At, 1, 0); PG8_STAGE(PG8_SA(0, 1), a2 + ahs, cvo1);
            PG8_WAIT_L(8); PG8_BAR; PG8_WAIT_L(0); PG8_MMA(0, 0, At, B0); PG8_BAR; PG8_SCHED;
            PG8_LDB(B1, 1, 1); PG8_STAGE(PG8_SB(1, 0), b3, voffB);
            PG8_BAR; PG8_WAIT_L(0); PG8_MMA(0, 1, At, B1); PG8_BAR;
            PG8_LDA(At, 1, 1); PG8_STAGE(PG8_SA(1, 0), a3, cvo0);
            PG8_BAR; PG8_WAIT_L(0); PG8_MMA(1, 0, At, B0); PG8_BAR; PG8_SCHED;
            PG8_STAGE(PG8_SB(1, 1), b3 + hstep, voffB);
            PG8_WAIT_V(6); PG8_BAR; PG8_MMA(1, 1, At, B1); PG8_BAR;
        }
        int lane_e = lane_id(); asm volatile("" : "+v"(lane_e));
        const int fr_e = lane_e & 15, fq_e = lane_e >> 4;
#pragma unroll
        for (int ai = 0; ai < 2; ++ai)
#pragma unroll
            for (int m = 0; m < 4; ++m) {
                float lo[8], hi[8];
#pragma unroll
                for (int n = 0; n < 2; ++n)
#pragma unroll
                    for (int j = 0; j < 4; ++j) { lo[4 * n + j] = acc[ai][0][m][n][j]; hi[4 * n + j] = acc[ai][1][m][n][j]; }
                E.store8(cur, ai * HALF + wr * 64 + m * 16 + fr_e, wc * 32 + 8 * fq_e, lo, hi);
                if (Epi::FENCE && (m & 1)) asm volatile("" ::: "memory");
            }
        if (!has_next) break;
#pragma unroll
        for (int a = 0; a < 2; ++a)
#pragma unroll
            for (int b = 0; b < 2; ++b)
#pragma unroll
                for (int m = 0; m < 4; ++m)
#pragma unroll
                    for (int n = 0; n < 2; ++n) acc[a][b][m][n] = (f32x4){0.f, 0.f, 0.f, 0.f};
        cur = nxt; cA = nA; cB = nB; ++ui;
    }
    PG8_WAIT_V(0);
    if (wr == 0) PG8_BAR;
    PG8_BAR;
#undef PG8_AOFF
#undef PG8_SA
#undef PG8_SB
#undef PG8_STAGE
#undef PG8_LDA
#undef PG8_LDB
#undef PG8_MMA
#undef PG8_WAIT_V
#undef PG8_WAIT_L
#undef PG8_BAR
#undef PG8_SCHED
}

template <class Epi, class Sched>
__device__ __forceinline__ void gemm_naive(const int K, const Sched& S, const Epi& E) {
    Unit u;
    for (int i = 0; S.next(i, u); ++i) {
        const char* At = S.a_tile(u); const char* Bt = S.b_tile(u);
        for (int item = threadIdx.x; item < 4096; item += 512) {
            const int r = item & 255, c = (item >> 8) * 8;
            const bf16_t* a = (const bf16_t*)(At + S.a_row_off(u, r));
            float lo[8], hi[8];
#pragma unroll
            for (int j = 0; j < 8; ++j) { lo[j] = 0.f; hi[j] = 0.f; }
            for (int k = 0; k < K; k += 8) {
                float av[8]; unpack8(*(const u32x4*)(a + k), av);
#pragma unroll
                for (int j = 0; j < 8; ++j) { float bv[8];
                    unpack8(*(const u32x4*)((const bf16_t*)Bt + (size_t)(c + j) * K + k), bv);
#pragma unroll
                    for (int q = 0; q < 8; ++q) lo[j] += av[q] * bv[q];
                    unpack8(*(const u32x4*)((const bf16_t*)Bt + (size_t)(128 + c + j) * K + k), bv);
#pragma unroll
                    for (int q = 0; q < 8; ++q) hi[j] += av[q] * bv[q]; }
            }
            E.store8(u, r, c, lo, hi);
        }
    }
}
template <class Epi, class Sched>
__device__ __forceinline__ void gemm_run(LAS unsigned char* lds, const int wave_in, const int K, const Sched& S, const Epi& E) {
#if MK_NAIVE
    (void)wave_in; gemm_naive<Epi, Sched>(K, S, E);
#else
    gemm_phase<Epi, Sched>(lds, wave_in, K, S, E);
#endif
}

struct EpiIn0 {
    static constexpr bool FENCE = false;
    bf16_t* P; bf16_t* GB; bf16_t* GY; bf16_t* XB;
    __device__ __forceinline__ void store8(const Unit& u, int r, int c, const float (&lo)[8], const float (&hi)[8]) const {
        const size_t t = (size_t)u.pm * 256 + r;
        if (u.pn < 8) { float v[8];
#pragma unroll
            for (int j = 0; j < 8; ++j) v[j] = lo[j] * hi[j];
            *(u32x4*)(P + t * 1024 + u.pn * 128 + c) = pack8(v); }
        else if (u.pn < 12) { bf16_t* d = GB + t * 1024 + (u.pn - 8) * 256 + c; *(u32x4*)d = pack8(lo); *(u32x4*)(d + 128) = pack8(hi); }
        else if (u.pn < 16) { float a[8], b[8];
#pragma unroll
            for (int j = 0; j < 8; ++j) { a[j] = fgelu_tanh(lo[j]); b[j] = fgelu_tanh(hi[j]); }
            bf16_t* d = GY + t * 1024 + (u.pn - 12) * 256 + c; *(u32x4*)d = pack8(a); *(u32x4*)(d + 128) = pack8(b); }
        else { bf16_t* d = XB + t * 1024 + (u.pn - 16) * 256 + c; *(u32x4*)d = pack8(lo); *(u32x4*)(d + 128) = pack8(hi); }
    }
};
template <bool F32BASE> struct EpiRes {
    static constexpr bool FENCE = false;
    const float* base_lat; const float* base_ctx; bf16_t* XR; const float* g1;
    __device__ __forceinline__ void store8(const Unit& u, int r, int c, const float (&lo)[8], const float (&hi)[8]) const {
        const int t0 = u.pm * 256, b = modrow_of(t0), col = u.pn * 256 + c;
        float xl[8], xh[8];
        bf16_t* dp = XR + (size_t)(t0 + r) * D + col;
        if (F32BASE) { const float* bp = t0 < NLAT ? base_lat + (size_t)(t0 + r) * D + col : base_ctx + (size_t)(t0 - NLAT + r) * D + col;
#pragma unroll
            for (int q = 0; q < 2; ++q) { const f32x4 x = *(const f32x4*)(bp + 4 * q), x2 = *(const f32x4*)(bp + 128 + 4 * q);
#pragma unroll
                for (int j = 0; j < 4; ++j) { xl[4 * q + j] = x[j]; xh[4 * q + j] = x2[j]; } } }
        else { unpack8(*(const u32x4*)dp, xl); unpack8(*(const u32x4*)(dp + 128), xh); }
        const float* gp = g1 + (size_t)b * MODW + col;
#pragma unroll
        for (int q = 0; q < 2; ++q) { const f32x4 g = *(const f32x4*)(gp + 4 * q), g2 = *(const f32x4*)(gp + 128 + 4 * q);
#pragma unroll
            for (int j = 0; j < 4; ++j) { xl[4 * q + j] += g[j] * lo[4 * q + j]; xh[4 * q + j] += g2[j] * hi[4 * q + j]; } }
        *(u32x4*)dp = pack8(xl); *(u32x4*)(dp + 128) = pack8(xh);
    }
};
struct EpiGU {
    static constexpr bool FENCE = false;
    bf16_t* hid;
    __device__ __forceinline__ void store8(const Unit& u, int r, int c, const float (&lo)[8], const float (&hi)[8]) const {
        float v[8];
#pragma unroll
        for (int j = 0; j < 8; ++j) v[j] = fsilu(lo[j]) * hi[j];
        *(u32x4*)(hid + ((size_t)u.pm * 256 + r) * FF + u.pn * 128 + c) = pack8(v);
    }
};
struct EpiDN {
    static constexpr bool FENCE = true;
    bf16_t* Y; const int* list; const float* listg;
    __device__ __forceinline__ void store8(const Unit& u, int r, int c, const float (&lo)[8], const float (&hi)[8]) const {
        const int pos = u.pos0 + r; if (pos >= u.cnt) return;
        const int t2 = list[(size_t)u.e * NTOK + pos]; const float g = listg[(size_t)u.e * NTOK + pos];
        float a[8], b[8];
#pragma unroll
        for (int j = 0; j < 8; ++j) { a[j] = g * lo[j]; b[j] = g * hi[j]; }
        bf16_t* d = Y + ((size_t)(t2 & 1) * NTOK + (t2 >> 1)) * D + u.pn * 256 + c;
        *(u32x4*)d = pack8(a); *(u32x4*)(d + 128) = pack8(b);
    }
};
struct EpiQKV {
    static constexpr bool FENCE = true;
    bf16_t* Q; bf16_t* Kb; bf16_t* Vb; const float* ropec; const float* ropes;
    __device__ __forceinline__ void store8(const Unit& u, int r, int c, const float (&lo)[8], const float (&hi)[8]) const {
        const int ctx = u.e, t = u.pm * 256 + r, png = u.pn + 8 * ctx;
        int b, s; size_t kvrow;
        if (ctx) { b = t >> 8; s = t & 255; kvrow = (size_t)b * KVL + s; } else { b = t >> 11; s = t & 2047; kvrow = (size_t)b * KVL + CTXL + s; }
        if (png < 16) {
            const int head = png & 7, m = c >> 6, a = (c >> 5) & 1, j0 = c & 31;
            float ol[8], oh[8];
            if (!ctx) { const int pos = a ? (s & 63) : (s >> 6);
                const f32x4 c0 = *(const f32x4*)(ropec + pos * 32 + j0), c1 = *(const f32x4*)(ropec + pos * 32 + j0 + 4), s0 = *(const f32x4*)(ropes + pos * 32 + j0), s1 = *(const f32x4*)(ropes + pos * 32 + j0 + 4);
#pragma unroll
                for (int j = 0; j < 8; ++j) { const float cs = j < 4 ? c0[j & 3] : c1[j & 3], sn = j < 4 ? s0[j & 3] : s1[j & 3]; ol[j] = lo[j] * cs - hi[j] * sn; oh[j] = hi[j] * cs + lo[j] * sn; } }
            else {
#pragma unroll
                for (int j = 0; j < 8; ++j) { ol[j] = lo[j]; oh[j] = hi[j]; } }
            bf16_t* d = (png < 8 ? Q + (size_t)t * D : Kb + kvrow * D) + head * 256 + m * 128 + a * 64 + j0;
            *(u32x4*)d = pack8(ol); *(u32x4*)(d + 32) = pack8(oh);
        } else { bf16_t* d = Vb + kvrow * D + (png - 16) * 256 + c; *(u32x4*)d = pack8(lo); *(u32x4*)(d + 128) = pack8(hi); }
    }
};
}

__device__ __forceinline__ void scan_phase(const Frame& F, const Params& p) {
    unsigned char* ws = F.ws;
    const bf16_t* P = (const bf16_t*)(ws + WS_R1); const bf16_t* GB = P + (size_t)NTOK * 1024; const bf16_t* GY = GB + (size_t)NTOK * 1024; const bf16_t* XB = GY + (size_t)NTOK * 1024;
    bf16_t* A3 = (bf16_t*)(ws + WS_HB);
    float* HS = (float*)(ws + WS_HID);
    const int tid = F.tid, lane = F.lane, w = F.wave;
    {
        const float* cw = inptr(p, 10);
        for (int it = F.bx * 512 + tid; it < NTOK * 128; it += F.G * 512) {
            const int t = it >> 7, ch = (it & 127) * 8;
            int s, len; if (t < NLAT) { s = t & 2047; len = SEQ; } else { s = (t - NLAT) & 255; len = CTXL; }
            float pm[8], pc[8], pp[8], gb[8], o[8];
            unpack8(*(const u32x4*)(P + (size_t)t * 1024 + ch), pc);
            if (s >= 1) unpack8(*(const u32x4*)(P + (size_t)(t - 1) * 1024 + ch), pm); else {
#pragma unroll
                for (int j = 0; j < 8; ++j) pm[j] = 0.f; }
            if (s + 1 < len) unpack8(*(const u32x4*)(P + (size_t)(t + 1) * 1024 + ch), pp); else {
#pragma unroll
                for (int j = 0; j < 8; ++j) pp[j] = 0.f; }
            unpack8(*(const u32x4*)(GB + (size_t)t * 1024 + ch), gb);
#pragma unroll
            for (int j = 0; j < 8; ++j) o[j] = gb[j] * (cw[ch + j] * pm[j] + cw[1024 + ch + j] * pc[j] + cw[2048 + ch + j] * pp[j]);
            *(u32x4*)(A3 + (size_t)t * D + ch) = pack8(o);
        }
    }
    LAS unsigned char* lds = F.lds;
    LAS bf16_t* Ush = (LAS bf16_t*)lds;
    LAS bf16_t* Gsh = (LAS bf16_t*)(lds + 34816);
    LAS float* Ash = (LAS float*)(lds + 69632); LAS float* Bsh = (LAS float*)(lds + 102400);
    LAS float* SA = (LAS float*)(lds + 135168); LAS float* SB = (LAS float*)(lds + 137216); LAS float* carry = (LAS float*)(lds + 139264);
    for (int unit = F.bx; unit < 256; unit += F.G) {
        const int b = unit >> 4, hd = (unit >> 1) & 7, half = unit & 1;
        const int cg = (tid & 15) * 8, chg = hd * 128 + cg;
        LAS float* cwl = (LAS float*)(lds + 139520);
        { const float* cbw = inptr(p, 11); const float* cbb = inptr(p, 12);
          __syncthreads();
          for (int i = tid; i < 640; i += 512) cwl[i] = i < 512 ? cbw[(i >> 7) * 1024 + hd * 128 + (i & 127)] : cbb[hd * 128 + (i & 127)];
          __syncthreads(); }
        const int tb = w & 3, cbk = w >> 2, r32 = lane & 31, hi = lane >> 5;
        const int chl = cbk * 32 + r32, chglob = hd * 128 + half * 64 + chl;
        const int sch = tid & 63, chunk = tid >> 6, schglob = hd * 128 + half * 64 + sch;
        for (int dir = 0; dir < 2; ++dir) {
            const bf16_t* gw = (const bf16_t*)(ws + WS_GW) + ((size_t)((dir * 8 + hd) * 2 + half) * 128) * 128;
            __syncthreads();
#pragma unroll
            for (int it = 0; it < 4; ++it) { const int q = tid + 512 * it, row = q >> 4, pc = q & 15; *(LAS u32x4*)(Gsh + row * 136 + pc * 8) = *(const u32x4*)(gw + (size_t)row * 128 + pc * 8); }
            const float ba = inptr(p, 14)[dir * 1024 + chglob], bi = inptr(p, 16)[dir * 1024 + chglob];
            const float cl = 8.0f * log1pf(expf(-(inptr(p, 17)[dir * 1024 + chglob])));
            if (tid < 64) carry[tid] = 0.f;
            __syncthreads();
            for (int ti = 0; ti < 18; ++ti) {
                int seg_ctx, s0;
                if (ti < 2) { seg_ctx = 1; s0 = dir == 0 ? ti * 128 : (1 - ti) * 128; } else { seg_ctx = 0; s0 = dir == 0 ? (ti - 2) * 128 : (17 - ti) * 128; }
                const int len = seg_ctx ? CTXL : SEQ; const size_t row0 = seg_ctx ? (size_t)NLAT + b * CTXL : (size_t)b * SEQ;
#pragma unroll
                for (int it = 0; it < 4; ++it) {
                    const int tok = (tid >> 4) + 32 * it, s = s0 + tok;
                    float uacc[8];
                    { const f32x4 b0 = *(const LAS f32x4*)(cwl + 512 + cg), b1 = *(const LAS f32x4*)(cwl + 512 + cg + 4);
#pragma unroll
                      for (int j = 0; j < 4; ++j) { uacc[j] = b0[j]; uacc[4 + j] = b1[j]; } }
#pragma unroll
                    for (int q = 0; q < 4; ++q) { const int sq = s + q - 2;
                        if (sq >= 0 && sq < len) { float xv[8]; unpack8(*(const u32x4*)(XB + (row0 + sq) * 1024 + chg), xv);
                            const f32x4 w0 = *(const LAS f32x4*)(cwl + q * 128 + cg), w1 = *(const LAS f32x4*)(cwl + q * 128 + cg + 4);
#pragma unroll
                            for (int j = 0; j < 4; ++j) { uacc[j] += w0[j] * xv[j]; uacc[4 + j] += w1[j] * xv[4 + j]; } } }
                    *(LAS u32x4*)(Ush + tok * 136 + cg) = pack8(uacc);
                }
                __syncthreads();
                f32x16 ar = {}, ai = {};
#pragma unroll
                for (int ks = 0; ks < 8; ++ks) { const bf16x8 af = *(const LAS bf16x8*)(Ush + (tb * 32 + r32) * 136 + ks * 16 + hi * 8);
                    const bf16x8 br = *(const LAS bf16x8*)(Gsh + (cbk * 32 + r32) * 136 + ks * 16 + hi * 8), bi8 = *(const LAS bf16x8*)(Gsh + (64 + cbk * 32 + r32) * 136 + ks * 16 + hi * 8);
                    ar = __builtin_amdgcn_mfma_f32_32x32x16_bf16(af, br, ar, 0, 0, 0); ai = __builtin_amdgcn_mfma_f32_32x32x16_bf16(af, bi8, ai, 0, 0, 0); }
#pragma unroll
                for (int rg = 0; rg < 16; ++rg) { const int tok = tb * 32 + (rg & 3) + 8 * (rg >> 2) + 4 * hi;
                    const float rr = fsigmoid(ar[rg] + ba), ii = fsigmoid(ai[rg] + bi);
                    const float la = -cl * rr, a = __expf(la), x2 = 2.0f * la;
                    const float om = x2 > -0.25f ? -x2 * (1.0f + x2 * (0.5f + x2 * (0.16666667f + x2 * (0.041666668f + x2 * 0.0083333338f)))) : 1.0f - a * a;
                    const float uu = bf2f(Ush[tok * 136 + half * 64 + chl]);
                    Ash[tok * 64 + chl] = a; Bsh[tok * 64 + chl] = sqrtf(om) * ii * uu; }
                __syncthreads();
                {
                    const int tile_id = seg_ctx ? (s0 >> 7) : 2 + (s0 >> 7);
                    float* hsp = HS + (((size_t)unit * 18 + tile_id) * 512 + tid) * 16;
                    const size_t rowc = row0 + s0 + chunk * 16;
                    f32x4 hf4[4]; unsigned short gyv[16];
                    if (dir == 1) {
#pragma unroll
                        for (int q = 0; q < 4; ++q) hf4[q] = *(const f32x4*)(hsp + 4 * q);
#pragma unroll
                        for (int i = 0; i < 16; ++i) gyv[i] = GY[(rowc + i) * 1024 + schglob];
                    }
                    float av[16], bv[16];
#pragma unroll
                    for (int i = 0; i < 16; ++i) { av[i] = Ash[(chunk * 16 + i) * 64 + sch]; bv[i] = Bsh[(chunk * 16 + i) * 64 + sch]; }
                    float Aa = 1.f, Hh = 0.f;
                    if (dir == 0) {
#pragma unroll
                        for (int i = 0; i < 16; ++i) { Hh = av[i] * Hh + bv[i]; Aa *= av[i]; } }
                    else {
#pragma unroll
                        for (int i = 15; i >= 0; --i) { Hh = av[i] * Hh + bv[i]; Aa *= av[i]; } }
                    SA[chunk * 64 + sch] = Aa; SB[chunk * 64 + sch] = Hh;
                    __syncthreads();
                    float c = carry[sch];
                    if (dir == 0) { for (int j = 0; j < chunk; ++j) c = SA[j * 64 + sch] * c + SB[j * 64 + sch]; }
                    else { for (int j = 7; j > chunk; --j) c = SA[j * 64 + sch] * c + SB[j * 64 + sch]; }
                    __syncthreads();
                    if (chunk == (dir == 0 ? 7 : 0)) carry[sch] = Aa * c + Hh;
                    float h = c;
                    if (dir == 0) {
                        float hv[16];
#pragma unroll
                        for (int i = 0; i < 16; ++i) { h = av[i] * h + bv[i]; hv[i] = h; }
#pragma unroll
                        for (int q = 0; q < 4; ++q) *(f32x4*)(hsp + 4 * q) = (f32x4){hv[4 * q], hv[4 * q + 1], hv[4 * q + 2], hv[4 * q + 3]};
                    } else {
#pragma unroll
                        for (int i = 15; i >= 0; --i) { h = av[i] * h + bv[i];
                            A3[(rowc + i) * D + 1024 + schglob] = (bf16_t)(cvt_pk_bf16(bf2f(gyv[i]) * (hf4[i >> 2][i & 3] + h), 0.f) & 0xffffu); }
                    }
                }
            }
            __syncthreads();
        }
    }
}

namespace att {
constexpr int DH = 128, NW = 8, QBLK = 32, KVBLK = 64, LDQ = 2048, LDK = 2048, LDO = 2048;
constexpr float SCALE = 0.088388347648318440f;
constexpr float THR = 8.f;
#ifndef ATT_SDEPTH
#define ATT_SDEPTH 1
#endif
constexpr int SDEPTH = ATT_SDEPTH;
constexpr int SHM_V = KVBLK * DH * 2, SHM_K = KVBLK * DH * 2;
constexpr int SHM_ATTN = 2 * SHM_V + 2 * SHM_K + NW * 64 * 4 + NW * 32 * 4;
#define KSWZ(row, colB) ((row) * 256 + ((colB) ^ (((row) & 7) << 4)))
#define SBAR() __builtin_amdgcn_sched_barrier(0)
__device__ __forceinline__ int crow(int r, int hi) { return (r & 3) + 8 * (r >> 2) + 4 * hi; }
__device__ __forceinline__ unsigned cvtpk(float lo, float hi) { unsigned r; asm volatile("v_cvt_pk_bf16_f32 %0, %1, %2" : "=v"(r) : "v"(lo), "v"(hi)); return r; }
__device__ __forceinline__ void partialSM(f32x16& p0, f32x16& p1, float& m_reg, float& mn, float& alpha) {
  constexpr float C = SCALE * 1.4426950408889634f;
  float pmax = p0[0]; for (int r = 1; r < 16; ++r) pmax = fmaxf(pmax, p0[r]); for (int r = 0; r < 16; ++r) pmax = fmaxf(pmax, p1[r]);
  { auto rr = __builtin_amdgcn_permlane32_swap(__float_as_uint(pmax), __float_as_uint(pmax), false, false);
    pmax = fmaxf(__uint_as_float(rr[0]), __uint_as_float(rr[1])); }
  if (__builtin_expect(__all(pmax - m_reg <= THR / SCALE), 1)) { mn = m_reg; alpha = 1.f; }
  else { mn = fmaxf(m_reg, pmax); alpha = __builtin_amdgcn_exp2f((m_reg - mn) * C); m_reg = mn; }
  float mnC = -mn * C;
  for (int r = 0; r < 16; ++r) p0[r] = fmaf(p0[r], C, mnC); for (int r = 0; r < 16; ++r) p1[r] = fmaf(p1[r], C, mnC);
  for (int r = 0; r < 16; ++r) p0[r] = __builtin_amdgcn_exp2f(p0[r]);
}
__device__ __forceinline__ void finishSM(f32x16& p0, f32x16& p1, float alpha, float& l_reg, bf16x8& pa0, bf16x8& pa1, bf16x8& pa2, bf16x8& pa3) {
  for (int r = 0; r < 16; ++r) p1[r] = __builtin_amdgcn_exp2f(p1[r]);
  float ps = 0; for (int r = 0; r < 16; ++r) ps += p0[r]; for (int r = 0; r < 16; ++r) ps += p1[r];
  { auto rr = __builtin_amdgcn_permlane32_swap(__float_as_uint(ps), __float_as_uint(ps), false, false);
    ps = __uint_as_float(rr[0]) + __uint_as_float(rr[1]); }
  l_reg = l_reg * alpha + ps;
#define PK4(P, BASE, OUT) do { unsigned a0 = cvtpk(P[BASE + 0], P[BASE + 1]), a1 = cvtpk(P[BASE + 2], P[BASE + 3]);   \
    unsigned b0 = cvtpk(P[BASE + 4], P[BASE + 5]), b1 = cvtpk(P[BASE + 6], P[BASE + 7]);                              \
    auto r0 = __builtin_amdgcn_permlane32_swap(a0, b0, false, false); auto r1 = __builtin_amdgcn_permlane32_swap(a1, b1, false, false); \
    u32x4 w = {r0[0], r1[0], r0[1], r1[1]}; OUT = *reinterpret_cast<bf16x8*>(&w); } while (0)
  PK4(p0, 0, pa0); PK4(p0, 8, pa1); PK4(p1, 0, pa2); PK4(p1, 8, pa3);
#undef PK4
}
__device__ __forceinline__ void qkt(f32x16& p0, f32x16& p1, const bf16_t* Ks, const bf16x8* qr, int r32, int hi) {
  p0 = f32x16{}; p1 = f32x16{};
  for (int d0 = 0; d0 < 8; ++d0) { int cb = (d0 * 16 + hi * 8) * 2;
    bf16x8 b0 = *reinterpret_cast<const bf16x8*>((const char*)Ks + KSWZ(r32, cb));
    bf16x8 b1 = *reinterpret_cast<const bf16x8*>((const char*)Ks + KSWZ(32 + r32, cb));
    p0 = __builtin_amdgcn_mfma_f32_32x32x16_bf16(b0, qr[d0], p0, 0, 0, 0);
    p1 = __builtin_amdgcn_mfma_f32_32x32x16_bf16(b1, qr[d0], p1, 0, 0, 0); }
}
__device__ __forceinline__ int v_st(int k, int c) { const int kk = (k & ~0xC) | ((k & 4) << 1) | ((k & 8) >> 1); return ((kk >> 3) * 4 + (c >> 5)) * 512 + ((kk & 7) * 32 + (c & 31)) * 2; }
__device__ __forceinline__ int v_rd_base(int lane) { return ((lane & 3) << 3) | (((lane >> 2) & 3) << 6) | (((lane >> 4) & 1) << 5) | (((lane >> 5) & 1) << 8); }
constexpr int v_rd_off(int d0, int ks, int half) { return d0 * 512 + ks * 4096 + half * 2048; }
template <int OFF> __device__ __forceinline__ s16x4 tr_read(int vb) {
  s16x4 r; asm volatile("ds_read_b64_tr_b16 %0, %1 offset:%2" : "=&v"(r) : "v"(vb), "i"(OFF) : "memory"); return r;
}
template <int D0> __device__ __forceinline__ void pv_one(f32x16& od, int vb, bf16x8 pa0, bf16x8 pa1, bf16x8 pa2, bf16x8 pa3) {
  const s16x4 l0 = tr_read<v_rd_off(D0, 0, 0)>(vb), h0 = tr_read<v_rd_off(D0, 0, 1)>(vb), l1 = tr_read<v_rd_off(D0, 1, 0)>(vb), h1 = tr_read<v_rd_off(D0, 1, 1)>(vb);
  const s16x4 l2 = tr_read<v_rd_off(D0, 2, 0)>(vb), h2 = tr_read<v_rd_off(D0, 2, 1)>(vb), l3 = tr_read<v_rd_off(D0, 3, 0)>(vb), h3 = tr_read<v_rd_off(D0, 3, 1)>(vb);
  asm volatile("s_waitcnt lgkmcnt(0)" ::: "memory"); SBAR();
#define PK(L, H) (bf16x8){L[0], L[1], L[2], L[3], H[0], H[1], H[2], H[3]}
  od = __builtin_amdgcn_mfma_f32_32x32x16_bf16(pa0, PK(l0, h0), od, 0, 0, 0);
  od = __builtin_amdgcn_mfma_f32_32x32x16_bf16(pa1, PK(l1, h1), od, 0, 0, 0);
  od = __builtin_amdgcn_mfma_f32_32x32x16_bf16(pa2, PK(l2, h2), od, 0, 0, 0);
  od = __builtin_amdgcn_mfma_f32_32x32x16_bf16(pa3, PK(l3, h3), od, 0, 0, 0);
#undef PK
}
__device__ __forceinline__ void pv_d0(f32x16* o, int vb, bf16x8 pa0, bf16x8 pa1, bf16x8 pa2, bf16x8 pa3) {
  pv_one<0>(o[0], vb, pa0, pa1, pa2, pa3); pv_one<1>(o[1], vb, pa0, pa1, pa2, pa3); pv_one<2>(o[2], vb, pa0, pa1, pa2, pa3); pv_one<3>(o[3], vb, pa0, pa1, pa2, pa3);
}
__device__ __forceinline__ void attn_pass(const bf16_t* __restrict__ Qb, const bf16_t* __restrict__ Kh, const bf16_t* __restrict__ Vh, bf16_t* __restrict__ Ob,
                                          float* __restrict__ scr, const int wave_in, const int pass, const float lam, const float onem, const float* __restrict__ subg, int seq, char* lds) {
  const int tid = tid_rebuild(wave_in), wid = wave_in;
  const int lane = tid & 63, r32 = lane & 31, hi = lane >> 5;
  bf16_t* V_lds = (bf16_t*)lds; bf16_t* K_lds = (bf16_t*)(lds + 2 * SHM_V);
  float* wsl = (float*)(lds + 2 * SHM_V + 2 * SHM_K) + wid * 64; float* li_l = wsl; float* al_l = wsl + 32;
  float* rq = (float*)(lds + 2 * SHM_V + 2 * SHM_K + NW * 64 * 4) + wid * 32;
  float m_reg = -1e30f, l_reg = 0; f32x16 o[4] = {}; bf16x8 qr[8];
  const bf16_t* Qw = Qb + (long)(wid * QBLK + r32) * LDQ + hi * 8;
#pragma unroll
  for (int d0 = 0; d0 < 8; ++d0) qr[d0] = *reinterpret_cast<const bf16x8*>(Qw + d0 * 16);
  const int sr = tid >> 4, sc = (tid & 15) * 8, vst0 = v_st(sr, sc), vst1 = v_st(32 + sr, sc);
  const int vb0 = (int)(uintptr_t)V_lds + v_rd_base(lane);
  struct { bf16x8 vs0, vs1, ks0, ks1; } sr_[SDEPTH];
#define SLOAD(i, k0) do { sr_[i].vs0 = *reinterpret_cast<const bf16x8*>(&Vh[(long)((k0) + sr) * LDK + sc]); sr_[i].vs1 = *reinterpret_cast<const bf16x8*>(&Vh[(long)((k0) + 32 + sr) * LDK + sc]); \
    sr_[i].ks0 = *reinterpret_cast<const bf16x8*>(&Kh[(long)((k0) + sr) * LDK + sc]); sr_[i].ks1 = *reinterpret_cast<const bf16x8*>(&Kh[(long)((k0) + 32 + sr) * LDK + sc]); } while (0)
#define SWRITE(b, i) do { *(bf16x8*)((char*)V_lds + (b) * SHM_V + vst0) = sr_[i].vs0;          \
    *(bf16x8*)((char*)V_lds + (b) * SHM_V + vst1) = sr_[i].vs1; int kc = sc * 2;               \
    *(bf16x8*)((char*)K_lds + (b) * SHM_K + KSWZ(sr, kc)) = sr_[i].ks0;                       \
    *(bf16x8*)((char*)K_lds + (b) * SHM_K + KSWZ(32 + sr, kc)) = sr_[i].ks1; } while (0)
#define SWAIT() do { if constexpr (SDEPTH == 2) asm volatile("s_waitcnt vmcnt(4)" ::: "memory"); else asm volatile("s_waitcnt vmcnt(0)" ::: "memory"); } while (0)
#define RESC(a) do { if (__any((a) < 1.f)) { if (hi == 0) al_l[r32] = (a); asm volatile("s_waitcnt lgkmcnt(0)" ::: "memory"); \
    for (int d = 0; d < 4; ++d) for (int r = 0; r < 16; ++r) o[d][r] *= al_l[crow(r, hi)]; } } while (0)
  f32x16 pA0, pA1, pB0, pB1; float mnA, mnB, alA, alB; bf16x8 pa0, pa1, pa2, pa3; const int NT = seq / KVBLK;
  constexpr int SE = 0, SO = SDEPTH - 1;
  SLOAD(SE, 0); asm volatile("s_waitcnt vmcnt(0)" ::: "memory"); SWRITE(0, SE); __syncthreads();
  qkt(pA0, pA1, K_lds, qr, r32, hi); partialSM(pA0, pA1, m_reg, mnA, alA);
  SLOAD(SO, KVBLK); if constexpr (SDEPTH == 2) { if (2 < NT) SLOAD(SE, 2 * KVBLK); }
  SWAIT(); SWRITE(1, SO); __syncthreads();
  for (int j = 1; j + 1 < NT; j += 2) {
    SBAR(); qkt(pB0, pB1, (bf16_t*)((char*)K_lds + SHM_K), qr, r32, hi);
    finishSM(pA0, pA1, alA, l_reg, pa0, pa1, pa2, pa3); SBAR();
    SLOAD(SO, (j + SDEPTH) * KVBLK); SBAR();
    pv_d0(o, vb0, pa0, pa1, pa2, pa3); partialSM(pB0, pB1, m_reg, mnB, alB);
    __syncthreads(); SWAIT(); SWRITE(0, SE);
    RESC(alB); __syncthreads();
    SBAR(); qkt(pA0, pA1, K_lds, qr, r32, hi);
    finishSM(pB0, pB1, alB, l_reg, pa0, pa1, pa2, pa3); SBAR();
    if (SDEPTH == 1 || j + 3 < NT) SLOAD(SE, (j + 1 + SDEPTH) * KVBLK); SBAR();
    pv_d0(o, vb0 + (int)SHM_V, pa0, pa1, pa2, pa3); partialSM(pA0, pA1, m_reg, mnA, alA);
    __syncthreads(); SWAIT(); SWRITE(1, SO);
    RESC(alA); __syncthreads();
  }
  SBAR(); qkt(pB0, pB1, (bf16_t*)((char*)K_lds + SHM_K), qr, r32, hi);
  finishSM(pA0, pA1, alA, l_reg, pa0, pa1, pa2, pa3); SBAR();
  pv_d0(o, vb0, pa0, pa1, pa2, pa3); partialSM(pB0, pB1, m_reg, mnB, alB);
  __syncthreads(); RESC(alB);
  finishSM(pB0, pB1, alB, l_reg, pa0, pa1, pa2, pa3); SBAR();
  pv_d0(o, vb0 + (int)SHM_V, pa0, pa1, pa2, pa3);
  if (hi == 0) li_l[r32] = l_reg; asm volatile("s_waitcnt lgkmcnt(0)" ::: "memory");
  float rli[16];
#pragma unroll
  for (int r = 0; r < 16; ++r) rli[r] = __builtin_amdgcn_rcpf(li_l[crow(r, hi)]);
  typedef __attribute__((address_space(1))) float gf32; typedef __attribute__((address_space(1))) bf16_t gbf16;
  gf32* scr_l = (gf32*)scr; gbf16* Ob_l = (gbf16*)Ob; int lane_e = lane; asm volatile("" : "+s"(scr_l), "+s"(Ob_l), "+v"(lane_e));
  const int r32e = lane_e & 31, hie = lane_e >> 5;
  gf32* S = scr_l + (size_t)wid * 4096 + lane_e + (pass >= 2 ? 32768 : 0);
#define ATT_BASE(ptr, d0) gf32* ptr = S + (d0) * 1024; asm volatile("" : "+v"(ptr))
  if (pass == 0 || pass == 2) {
#pragma unroll
    for (int d0 = 0; d0 < 4; ++d0) { ATT_BASE(dst, d0);
#pragma unroll
      for (int r = 0; r < 16; ++r) dst[r * 64] = o[d0][r] * rli[r]; }
  } else {
    float q[16];
#pragma unroll
    for (int d0 = 0; d0 < 4; ++d0) { ATT_BASE(srcp, d0);
#pragma unroll
      for (int r = 0; r < 16; ++r) { const float c = srcp[r * 64] - lam * o[d0][r] * rli[r]; o[d0][r] = c; q[r] = d0 == 0 ? c * c : q[r] + c * c; }
      asm volatile("" ::: "memory"); }
#pragma unroll
    for (int r = 0; r < 16; ++r) {
#pragma unroll
      for (int off = 1; off <= 16; off <<= 1) q[r] += __shfl_xor(q[r], off); }
    if (pass == 1) {
#pragma unroll
      for (int d0 = 0; d0 < 4; ++d0) { ATT_BASE(dst, d0);
#pragma unroll
        for (int r = 0; r < 16; ++r) dst[r * 64] = o[d0][r]; }
      if (r32e == 0) {
#pragma unroll
        for (int r = 0; r < 16; ++r) rq[hie * 16 + r] = q[r]; }
    } else {
      if (r32e == 0) {
#pragma unroll
        for (int r = 0; r < 16; ++r) rq[hie * 16 + r] = onem * __builtin_amdgcn_rsqf((q[r] + rq[hie * 16 + r]) * (1.0f / 256.0f) + EPS); }
      asm volatile("s_waitcnt lgkmcnt(0)" ::: "memory");
      float g0[4], g1[4];
#pragma unroll
      for (int d0 = 0; d0 < 4; ++d0) { g0[d0] = subg[d0 * 32 + r32e]; g1[d0] = subg[128 + d0 * 32 + r32e]; }
      S = scr_l + (size_t)wid * 4096 + lane_e;
      ATT_BASE(s0a, 0); ATT_BASE(s0b, 1); ATT_BASE(s0c, 2); ATT_BASE(s0d, 3);
#pragma unroll
      for (int r = 0; r < 16; ++r) { const float rs = rq[hie * 16 + r];
        gbf16* orow = Ob_l + (long)(wid * QBLK + crow(r, hie)) * LDO + r32e; asm volatile("" : "+v"(orow) :: "memory");
        const float h0 = s0a[r * 64], h1 = s0b[r * 64], h2 = s0c[r * 64], h3 = s0d[r * 64];
        orow[128 +  0] = (bf16_t)(cvtpk(o[0][r] * rs * g1[0], 0.f) & 0xffffu); orow[128 + 32] = (bf16_t)(cvtpk(o[1][r] * rs * g1[1], 0.f) & 0xffffu);
        orow[128 + 64] = (bf16_t)(cvtpk(o[2][r] * rs * g1[2], 0.f) & 0xffffu); orow[128 + 96] = (bf16_t)(cvtpk(o[3][r] * rs * g1[3], 0.f) & 0xffffu);
        orow[ 0] = (bf16_t)(cvtpk(h0 * rs * g0[0], 0.f) & 0xffffu); orow[32] = (bf16_t)(cvtpk(h1 * rs * g0[1], 0.f) & 0xffffu);
        orow[64] = (bf16_t)(cvtpk(h2 * rs * g0[2], 0.f) & 0xffffu); orow[96] = (bf16_t)(cvtpk(h3 * rs * g0[3], 0.f) & 0xffffu); }
    }
  }
#undef ATT_BASE
#undef SLOAD
#undef SWRITE
#undef SWAIT
#undef RESC
}
}

__device__ __forceinline__ void attn_phase(const Frame& F, const Params& p) {
    unsigned char* ws = F.ws;
    const bf16_t* Q = (const bf16_t*)(ws + WS_HID); const bf16_t* Kb = (const bf16_t*)(ws + WS_R1); const bf16_t* Vb = Kb + (size_t)NB * KVL * D;
    bf16_t* O = (bf16_t*)(ws + WS_HB);
    float* scr = (float*)(ws + WS_ATTSCR) + (size_t)F.bx * 65536;
    const float* q1 = inptr(p, 20); const float* k1 = inptr(p, 21); const float* q2 = inptr(p, 22); const float* k2 = inptr(p, 23); const float* subg = inptr(p, 24);
    float d1 = q1[F.lane] * k1[F.lane] + q1[64 + F.lane] * k1[64 + F.lane];
    float d2 = q2[F.lane] * k2[F.lane] + q2[64 + F.lane] * k2[64 + F.lane];
#pragma unroll
    for (int o = 32; o >= 1; o >>= 1) { d1 += __shfl_xor(d1, o); d2 += __shfl_xor(d2, o); }
    const float lam_init = 0.8f - 0.6f * 0.7408182206817179f;
    const float lam = expf(d1) - expf(d2) + lam_init, onem = 1.0f - lam_init;
    const int vcu = (F.G % 8 == 0) ? (F.bx % 8) * (F.G / 8) + F.bx / 8 : F.bx;
#pragma unroll 1
    for (int U = vcu; U < NB * 8 * 8; U += F.G) {
        const int bh = U >> 3, b = bh >> 3, h = bh & 7, qb = U & 7;
        const bf16_t* Qb = Q + ((size_t)b * SEQ + qb * 256) * D + h * 256;
        const bf16_t* Kh = Kb + (size_t)b * KVL * D + h * 256;
        const bf16_t* Vh = Vb + (size_t)b * KVL * D + h * 256;
        bf16_t* Ob = O + ((size_t)b * SEQ + qb * 256) * D + h * 256;
#pragma unroll 1
        for (int pass = 0; pass < 4; ++pass) {
            const int m = pass & 1, vh = pass >> 1;
            __syncthreads();
            att::attn_pass(Qb + m * 128, Kh + m * 128, Vh + vh * 128, Ob, scr, F.wave, pass, lam, onem, subg, KVL, (char*)F.lds);
        }
    }
    __syncthreads();
}

__device__ __forceinline__ void moe_setup(const Frame& F, int l) {
    LAS int* pre = (LAS int*)(F.lds + LX_PRE); LAS int* cnt = (LAS int*)(F.lds + LX_CNT);
    __syncthreads();
    if (F.tid == 0) {
        const unsigned* cntg = (const unsigned*)(F.ws + WS_CTL) + CW_CNT + l * 64; int acc = 0;
        for (int e = 0; e < 16; ++e) { const int c = (int)__hip_atomic_load(cntg + e, __ATOMIC_RELAXED, __HIP_MEMORY_SCOPE_AGENT); cnt[e] = c; pre[e] = acc; acc += (c + 255) >> 8; }
        pre[16] = acc;
    }
    __syncthreads();
}

__global__ void __launch_bounds__(512, 2) mega_fwd(Params p) {
    extern __shared__ __attribute__((aligned(16))) unsigned char lds_raw[];
    Frame F;
    F.lds = (LAS unsigned char*)lds_raw;
    F.wave = __builtin_amdgcn_readfirstlane(threadIdx.x >> 6); refresh(F);
    F.G = gridDim.x; F.bx = blockIdx.x; F.ws = p.ws; F.out = p.out;
    if (F.tid < 4) ((LAS unsigned*)(F.lds + LX_BAR))[F.tid] = 0u;
    __syncthreads();
    XcdBarrier bar = xcd_barrier_post((unsigned*)(p.ws + WS_CTL) + CW_BAR, (volatile LAS unsigned*)(F.lds + LX_BAR));
    const int lo = p.ph_lo, hi = p.ph_hi, stop = p.stop;
#define PHR(v) ({ int _v = (v); asm volatile("" : "+s"(_v)); _v; })
    unsigned char* ws = p.ws;
    const float* mod = (const float*)(ws + WS_MOD);
    int ph = 0;
#ifndef MK_MASK
#define MK_MASK 0x1ffff
#endif
#define RUN(k) (((MK_MASK >> (k)) & 1) && PHR(lo) <= (k) && (k) < PHR(hi) && ((k) < PHR(stop) || (k) == NPHASE - 1))
#define REP(k) for (int rep_ = 0; rep_ <= ((MK_REPEAT >> (k)) & 1); ++rep_)
#define SEAM(k) do { if ((k) + 1 < PHR(hi)) xcd_barrier(bar); } while (0)

    if (RUN(0)) { refresh(F); REP(0) p0_prologue(F, p); } if (PHR(lo) <= 0 && 0 < PHR(hi)) SEAM(0);
    if (RUN(1)) { refresh(F); p1_modreduce(F, p);
#ifdef MK_XBAR
        for (int xb_ = 0; xb_ < MK_XBAR; ++xb_) xcd_barrier(bar);
#endif
    } if (PHR(lo) <= 1 && 1 < PHR(hi)) SEAM(1);
    if (RUN(2)) { refresh(F); REP(2) row_phase<0>(F, p, 0, 0); } if (PHR(lo) <= 2 && 2 < PHR(hi)) SEAM(2);
    ph = 3;
    if (RUN(3)) { refresh(F);
        pg8::DenseSched S{(const char*)(ws + WS_HB), (const char*)(ws + WS_W1), NTOK / 256, 5120 / 256, 2048, F.G, F.bx};
        bf16_t* g1o = (bf16_t*)(ws + WS_R1);
        pg8::EpiIn0 E{g1o, g1o + (size_t)NTOK * 1024, g1o + (size_t)2 * NTOK * 1024, g1o + (size_t)3 * NTOK * 1024};
        REP(3) pg8::gemm_run(F.lds, F.wave, 2048, S, E);
    } if (PHR(lo) <= 3 && 3 < PHR(hi)) SEAM(3);
    if (RUN(4)) { refresh(F); REP(4) scan_phase(F, p); } if (PHR(lo) <= 4 && 4 < PHR(hi)) SEAM(4);
    if (RUN(5)) { refresh(F);
        pg8::DenseSched S{(const char*)(ws + WS_HB), (const char*)(ws + WS_W3), NTOK / 256, 2048 / 256, 2048, F.G, F.bx};
        pg8::EpiRes<true> E{inptr(p, 0), inptr(p, 2), (bf16_t*)(ws + WS_XR), mod + 4096};
        REP(5) pg8::gemm_run(F.lds, F.wave, 2048, S, E);
    } if (PHR(lo) <= 5 && 5 < PHR(hi)) SEAM(5);
    for (int l = 0; l < 2; ++l) {
        const int base = l == 0 ? 6 : 13;
        if (l == 1) {
            if (RUN(10)) { refresh(F);
                pg8::EpiQKV E{(bf16_t*)(ws + WS_HID), (bf16_t*)(ws + WS_R1), (bf16_t*)(ws + WS_R1) + (size_t)NB * KVL * D, (const float*)(ws + WS_ROPE), (const float*)(ws + WS_ROPE) + 2048};
                pg8::QkvSched S{(const char*)(ws + WS_HB), (const char*)(ws + WS_WQKV), 2048, F.G, F.bx};
                REP(10) pg8::gemm_run(F.lds, F.wave, 2048, S, E);
            } if (PHR(lo) <= 10 && 10 < PHR(hi)) SEAM(10);
            if (RUN(11)) { refresh(F); REP(11) attn_phase(F, p); } if (PHR(lo) <= 11 && 11 < PHR(hi)) SEAM(11);
            if (RUN(12)) { refresh(F);
                pg8::DenseSched S{(const char*)(ws + WS_HB), (const char*)(ws + WS_WO), NLAT / 256, 2048 / 256, 2048, F.G, F.bx};
                pg8::EpiRes<false> E{nullptr, nullptr, (bf16_t*)(ws + WS_XR), mod + (size_t)17 * MODW + 4096};
                pg8::gemm_run(F.lds, F.wave, 2048, S, E);
            } if (PHR(lo) <= 12 && 12 < PHR(hi)) SEAM(12);
        }
        if (RUN(base)) { refresh(F); row_phase<1>(F, p, l, 0); } if (PHR(lo) <= base && base < PHR(hi)) SEAM(base);
        if (RUN(base + 1)) { refresh(F);
            moe_setup(F, l);
            pg8::MoeSched<true> S{(const char*)(ws + WS_HB), (const char*)(ws + WS_WGU) + (size_t)l * 16 * 2048 * 2048 * 2, (size_t)2048 * 2048 * 2,
                                  (const LAS int*)(F.lds + LX_PRE), (const LAS int*)(F.lds + LX_CNT), (const int*)(ws + WS_LIST), 2048, F.G, F.bx};
            pg8::EpiGU E{(bf16_t*)(ws + WS_HID)};
            REP(7) pg8::gemm_run(F.lds, F.wave, 2048, S, E);
        } if (PHR(lo) <= base + 1 && base + 1 < PHR(hi)) SEAM(base + 1);
        if (RUN(base + 2)) { refresh(F);
            moe_setup(F, l);
            pg8::MoeSched<false> S{(const char*)(ws + WS_HID), (const char*)(ws + WS_WD) + (size_t)l * 16 * 2048 * 1024 * 2, (size_t)2048 * 1024 * 2,
                                   (const LAS int*)(F.lds + LX_PRE), (const LAS int*)(F.lds + LX_CNT), (const int*)(ws + WS_LIST), 1024, F.G, F.bx};
            pg8::EpiDN E{(bf16_t*)(ws + WS_R1), (const int*)(ws + WS_LIST), (const float*)(ws + WS_LISTG)};
            REP(8) pg8::gemm_run(F.lds, F.wave, 1024, S, E);
        } if (PHR(lo) <= base + 2 && base + 2 < PHR(hi)) SEAM(base + 2);
        if (l == 0) { if (RUN(9)) { refresh(F); row_phase<2>(F, p, 0, 0); } if (PHR(lo) <= 9 && 9 < PHR(hi)) SEAM(9); }
        else { if (RUN(16)) { refresh(F); row_phase<3>(F, p, 1, p.fin_mode); } }
    }
    (void)ph;
#undef RUN
#undef SEAM
}

extern "C" void kernel_launch(void* const* d_in, const int* in_sizes, int n_in, void* d_out, int out_size, void* d_ws, size_t ws_size, hipStream_t stream) {
    static int grid = 0;
    if (grid == 0) {
        if (n_in != 31 || in_sizes[0] != NLAT * D || out_size != NLAT * D || ws_size < WS_END) {
            fprintf(stderr, "kernel_launch: shape/workspace mismatch: n_in %d in0 %d out %d ws %zu (need %zu)\n", n_in, n_in > 0 ? in_sizes[0] : -1, out_size, ws_size, (size_t)WS_END); grid = -1; return; }
        int dev = 0, cus = 0, per_cu = 0;
        if (hipGetDevice(&dev) != hipSuccess || hipDeviceGetAttribute(&cus, hipDeviceAttributeMultiprocessorCount, dev) != hipSuccess) { grid = -1; return; }
        if (hipFuncSetAttribute((const void*)mega_fwd, hipFuncAttributeMaxDynamicSharedMemorySize, LDS_BYTES) != hipSuccess) { fprintf(stderr, "kernel_launch: hipFuncSetAttribute failed\n"); grid = -1; return; }
        if (hipOccupancyMaxActiveBlocksPerMultiprocessor(&per_cu, (const void*)mega_fwd, 512, LDS_BYTES) != hipSuccess || per_cu < 1)
            fprintf(stderr, "kernel_launch: occupancy query reports %d blocks per CU\n", per_cu);
        (void)hipGetLastError();
        grid = cus;
    }
    if (grid < 0) return;
    (void)hipMemsetAsync((char*)d_ws + WS_CTL, 0, CTL_BYTES, stream);
    Params p{};
    for (int i = 0; i < 31; ++i) p.in[i] = (const float*)d_in[i];
    p.out = (float*)d_out; p.ws = (unsigned char*)d_ws;
    p.stop = MK_STOP;
    p.fin_mode = (MK_STOP >= NPHASE - 1) ? 0 : (MK_STOP <= 5 ? 2 : 1);
#if MK_LAUNCHES
    for (int ph = 0; ph < NPHASE; ++ph) {
        if (!(ph < MK_STOP || ph == NPHASE - 1)) continue;
        p.ph_lo = ph; p.ph_hi = ph + 1;
        hipLaunchKernelGGL(mega_fwd, dim3(grid), dim3(512), LDS_BYTES, stream, p);
    }
#else
    p.ph_lo = 0; p.ph_hi = NPHASE;
    hipLaunchKernelGGL(mega_fwd, dim3(grid), dim3(512), LDS_BYTES, stream, p);
#endif
    const hipError_t le = hipPeekAtLastError();
    if (le != hipSuccess) fprintf(stderr, "kernel_launch: launch failed: %s\n", hipGetErrorName(le));
}
```

```cpp
#include <hip/hip_runtime.h>
#include <cstdio>
#include <cstdint>

#ifndef F8_G1
#define F8_G1 0
#endif
#ifndef I8_G1
#define I8_G1 1
#endif
#ifndef F8_G3
#define F8_G3 0
#endif
#ifndef F8_QKV
#define F8_QKV 1
#endif
#ifndef F8_WO
#define F8_WO 1
#endif
#ifndef F8_QK
#define F8_QK 1
#endif
#ifndef F8_PV
#define F8_PV 1
#endif
#ifndef F8_Y
#define F8_Y 1
#endif
#ifndef MK_8PHASE
#define MK_8PHASE 0
#endif
#ifndef MK_TAILFILL
#define MK_TAILFILL 1
#endif
#ifndef MK_LAUNCHES
#define MK_LAUNCHES 0
#endif
#ifndef MK_STOP
#define MK_STOP 99
#endif
#ifndef MK_REPEAT
#define MK_REPEAT 0
#endif
#ifndef MK_STAGGER
#define MK_STAGGER 0
#endif
#ifndef MK_P0PIPE
#define MK_P0PIPE 0
#endif
#ifndef MK_ATT2
#define MK_ATT2 1
#endif
#ifndef MK_NAIVE
#define MK_NAIVE 0
#endif

#define LAS __attribute__((address_space(3)))
typedef unsigned short bf16_t;
typedef short bf16x8 __attribute__((ext_vector_type(8)));
typedef short s16x4 __attribute__((ext_vector_type(4)));
typedef float f32x4 __attribute__((ext_vector_type(4)));
typedef float f32x2 __attribute__((ext_vector_type(2)));
typedef float f32x16 __attribute__((ext_vector_type(16)));
typedef unsigned u32x4 __attribute__((ext_vector_type(4)));
typedef unsigned u32x2 __attribute__((ext_vector_type(2)));

constexpr int D = 2048, NB = 16, SEQ = 2048, CTXL = 256;
constexpr int NLAT = NB * SEQ, NCTX = NB * CTXL, NTOK = NLAT + NCTX;
constexpr int NE = 16, FF = 1024, KVL = CTXL + SEQ;
constexpr int MODW = 6 * D;
constexpr float EPS = 1e-6f;
constexpr int NPHASE = 17;

constexpr size_t al256(size_t x) { return (x + 255) & ~(size_t)255; }
constexpr size_t WS_CTL = 0, CTL_BYTES = 65536;
constexpr int CW_BAR = 0, CW_CNT = 4096, CW_FILL = 6144, CW_DONE = 6160;
constexpr size_t WS_MOD = WS_CTL + CTL_BYTES;
constexpr size_t WS_ROPE = WS_MOD + al256((size_t)2 * 17 * MODW * 4);
constexpr size_t WS_GW = WS_ROPE + 16384;
constexpr size_t WS_W1 = WS_GW + (size_t)2 * 8 * 2 * 128 * 128 * 2;
constexpr size_t WS_W3 = WS_W1 + (size_t)5120 * 2048 * 2;
constexpr size_t WS_WQKV = WS_W3 + (size_t)2048 * 2048 * 2;
constexpr size_t WS_WO = WS_WQKV + (size_t)6144 * 2048 * 2;
constexpr size_t WS_WGU = WS_WO + (size_t)2048 * 2048 * 2;
constexpr size_t WS_WD = WS_WGU + (size_t)32 * 2048 * 2048 * 2;
constexpr size_t WS_XR = WS_WD + (size_t)32 * 2048 * 1024 * 2;
constexpr size_t WS_HB = WS_XR + (size_t)NTOK * D * 2;
constexpr size_t WS_R1 = WS_HB + (size_t)NTOK * D * 2;
constexpr size_t R1_BYTES = (size_t)2 * NTOK * D * 2;
constexpr size_t WS_HID = WS_R1 + R1_BYTES;
constexpr size_t HID_ROWS = 77824, HID_BYTES = HID_ROWS * FF * 2;
constexpr size_t WS_LIST = WS_HID + HID_BYTES;
constexpr size_t WS_LISTG = WS_LIST + (size_t)NE * NTOK * 4;
constexpr size_t WS_ASC = WS_LISTG + (size_t)NE * NTOK * 4;
constexpr size_t WS_END = WS_ASC + (size_t)NTOK * 4;
constexpr size_t WS_ATTSCR = WS_WGU;
static_assert((size_t)NTOK * 1024 * 4 <= HID_BYTES && (size_t)NLAT * D * 2 <= HID_BYTES && (size_t)2 * 16 * 17 * MODW * 4 <= HID_BYTES, "HID aliases");
static_assert((size_t)256 * 65536 * 4 <= (size_t)16 * 2048 * 2048 * 2, "attention scratch fits in layer-0 expert weights");

constexpr int STAGE_BYTES = 131072;
constexpr int LX = 147456;
constexpr int LX_BAR = LX + 0;
constexpr int LX_PRE = LX + 64;
constexpr int LX_CNT = LX + 192;
constexpr int LX_LCNT = LX + 256;
constexpr int LX_LBASE = LX + 320;
constexpr int LX_REC = LX + 512;
constexpr int LX_RECG = LX + 2048;
constexpr int LX_MISC = LX + 4096;
constexpr int LDS_BYTES = LX + 8192;
constexpr int ROWCH = 192;

struct Params { const float* in[31]; float* out; unsigned char* ws; int ph_lo, ph_hi; int fin_mode, stop; };

__device__ __forceinline__ const float* inptr(const Params& p, int i) { asm volatile("" : "+s"(i)); return p.in[i]; }
__device__ __forceinline__ unsigned cvt_pk_bf16(float lo, float hi) { unsigned r; asm("v_cvt_pk_bf16_f32 %0, %1, %2" : "=v"(r) : "v"(lo), "v"(hi)); return r; }
__device__ __forceinline__ float bflo(unsigned w) { return __uint_as_float(w << 16); }
__device__ __forceinline__ float bfhi(unsigned w) { return __uint_as_float(w & 0xffff0000u); }
__device__ __forceinline__ float bf2f(bf16_t b) { return __uint_as_float(((unsigned)b) << 16); }
__device__ __forceinline__ float fsigmoid(float x) { return __builtin_amdgcn_rcpf(1.0f + __expf(-x)); }
__device__ __forceinline__ float fsilu(float x) { return x * fsigmoid(x); }
__device__ __forceinline__ float fgelu_tanh(float x) { const float z = 1.5957691216057308f * (x + 0.044715f * x * x * x); return x * fsigmoid(z); }
__device__ __forceinline__ float clamp8(float x) { return __builtin_fminf(__builtin_fmaxf(x, -448.0f), 448.0f); }
__device__ __forceinline__ unsigned pack_fp8x1(float a) { return (unsigned)__builtin_amdgcn_cvt_pk_fp8_f32(a, 0.f, 0, false) & 0xffu; }
__device__ __forceinline__ unsigned pack_i8x4(float a, float b, float c, float d) {
    const int qa = (int)__builtin_rintf(__builtin_fminf(__builtin_fmaxf(a, -127.f), 127.f)), qb = (int)__builtin_rintf(__builtin_fminf(__builtin_fmaxf(b, -127.f), 127.f));
    const int qc = (int)__builtin_rintf(__builtin_fminf(__builtin_fmaxf(c, -127.f), 127.f)), qd = (int)__builtin_rintf(__builtin_fminf(__builtin_fmaxf(d, -127.f), 127.f));
    return (unsigned)(qa & 255) | ((unsigned)(qb & 255) << 8) | ((unsigned)(qc & 255) << 16) | ((unsigned)qd << 24);
}
__device__ __forceinline__ unsigned pack_fp8x4(float a, float b, float c, float d) { int w = __builtin_amdgcn_cvt_pk_fp8_f32(a, b, 0, false); w = __builtin_amdgcn_cvt_pk_fp8_f32(c, d, w, true); return (unsigned)w; }
__device__ __forceinline__ u32x4 pack8(const float (&v)[8]) { u32x4 w; w.x = cvt_pk_bf16(v[0], v[1]); w.y = cvt_pk_bf16(v[2], v[3]); w.z = cvt_pk_bf16(v[4], v[5]); w.w = cvt_pk_bf16(v[6], v[7]); return w; }
__device__ __forceinline__ void unpack8(const u32x4 w, float (&v)[8]) { v[0] = bflo(w.x); v[1] = bfhi(w.x); v[2] = bflo(w.y); v[3] = bfhi(w.y); v[4] = bflo(w.z); v[5] = bfhi(w.z); v[6] = bflo(w.w); v[7] = bfhi(w.w); }

#define XB_TMO      128
#define XB_XCNT(j)  (256  + 64 * (j))
#define XB_XSUB(j)  (1280 + 64 * (j))
#define XB_XGEN(j)  (2304 + 64 * (j))
#define XB_TOP      3328
#define XB_TOPGEN   3392
#define XCD_BAR_WORDS 3456
#define XB_SPIN_CAP (1u << 18)
__device__ __forceinline__ unsigned xb_ld(unsigned* p)              { return __hip_atomic_load(p, __ATOMIC_RELAXED, __HIP_MEMORY_SCOPE_AGENT); }
__device__ __forceinline__ unsigned xb_add(unsigned* p, unsigned v) { return __hip_atomic_fetch_add(p, v, __ATOMIC_RELAXED, __HIP_MEMORY_SCOPE_AGENT); }
__device__ __forceinline__ unsigned xb_xcc_id() { return (unsigned)__builtin_amdgcn_s_getreg((3 << 11) | 20) & 0xFu; }
#define XB_SPIN(cond, bar) do { unsigned _sp = 0; while (cond) { __builtin_amdgcn_s_sleep(1); \
    if ((++_sp & 255u) == 0u) { if (xb_ld(&(bar)[XB_TMO])) break; if (_sp > XB_SPIN_CAP) { atomicAdd(&(bar)[XB_TMO], 1u); break; } } } } while (0)
struct XcdBarrier { unsigned* bar; unsigned x; volatile LAS unsigned* st; };
__device__ __forceinline__ XcdBarrier xcd_barrier_post(unsigned* bar, volatile LAS unsigned* st) {
    XcdBarrier b; b.bar = bar; b.x = xb_xcc_id(); b.st = st;
    if (threadIdx.x == 0) (void)xb_add(&bar[XB_XCNT(b.x)], 1u);
    return b;
}
__device__ __forceinline__ void xcd_barrier_complete(unsigned* bar, unsigned x, unsigned& nloc, unsigned& nx) {
    const unsigned G = gridDim.x * gridDim.y * gridDim.z;
    unsigned sum, cnt, mine, sp = 0u;
    for (;;) {
        sum = 0u; cnt = 0u; mine = 0u;
#pragma unroll
        for (unsigned j = 0; j < 16; ++j) { const unsigned c = xb_ld(&bar[XB_XCNT(j)]); sum += c; cnt += (c > 0u) ? 1u : 0u; mine = (j == x) ? c : mine; }
        if (sum == G) break;
        __builtin_amdgcn_s_sleep(1);
        if ((++sp & 255u) == 0u) { if (xb_ld(&bar[XB_TMO])) break; if (sp > XB_SPIN_CAP) { atomicAdd(&bar[XB_TMO], 1u); break; } }
    }
    nloc = mine > 0u ? mine : 1u; nx = cnt > 0u ? cnt : 1u;
}
__device__ __forceinline__ void xcd_barrier(const XcdBarrier& b) {
    asm volatile("s_waitcnt vmcnt(0)" ::: "memory");
    __syncthreads();
    if (threadIdx.x == 0) {
        unsigned* bar = b.bar;
        __builtin_amdgcn_s_waitcnt(0);
        unsigned nloc = b.st[0], nx = b.st[1];
        if (nloc == 0u) { xcd_barrier_complete(bar, b.x, nloc, nx); b.st[0] = nloc; b.st[1] = nx; }
        const unsigned old = xb_add(&bar[XB_XSUB(b.x)], 1u);
        const unsigned gen = old / nloc;
        if (old + 1u == (gen + 1u) * nloc) {
            __builtin_amdgcn_fence(__ATOMIC_RELEASE, "agent");
            asm volatile("s_waitcnt vmcnt(0)" ::: "memory");
            const unsigned og = xb_add(&bar[XB_TOP], 1u);
            const unsigned tg = og / nx;
            if (og + 1u == (tg + 1u) * nx) xb_add(&bar[XB_TOPGEN], 1u);
            else XB_SPIN(xb_ld(&bar[XB_TOPGEN]) == tg, bar);
            __builtin_amdgcn_fence(__ATOMIC_ACQUIRE, "agent");
            xb_add(&bar[XB_XGEN(b.x)], 1u);
            asm volatile("s_waitcnt vmcnt(0)" ::: "memory");
        } else {
            XB_SPIN(xb_ld(&bar[XB_XGEN(b.x)]) == gen, bar);
            __builtin_amdgcn_fence(__ATOMIC_ACQUIRE, "agent");
            asm volatile("s_waitcnt vmcnt(0)" ::: "memory");
        }
    }
    __syncthreads();
}

struct Frame {
    LAS unsigned char* lds;
    int tid, lane, wave, G, bx;
    unsigned char* ws;
    float* out;
};
__device__ __forceinline__ int lane_id() { int l; asm volatile("v_mbcnt_lo_u32_b32 %0, -1, 0\n\tv_mbcnt_hi_u32_b32 %0, -1, %0" : "=v"(l)); return l; }
__device__ __forceinline__ float shfl_xor_l(float v, int off, int lane_l) { return __uint_as_float((unsigned)__builtin_amdgcn_ds_bpermute((lane_l ^ off) << 2, (int)__float_as_uint(v))); }
template <int CTRL> __device__ __forceinline__ float dpp_mov_f(float v) { return __int_as_float(__builtin_amdgcn_update_dpp(0, __float_as_int(v), CTRL, 0xf, 0xf, false)); }
__device__ __forceinline__ float wave_allsum(float v) {
    v += dpp_mov_f<0x128>(v); v += dpp_mov_f<0x124>(v); v += dpp_mov_f<0x122>(v); v += dpp_mov_f<0x121>(v);
    v += __int_as_float(__builtin_amdgcn_ds_swizzle(__float_as_int(v), 0x401F));
    const auto r = __builtin_amdgcn_permlane32_swap(__float_as_uint(v), __float_as_uint(v), false, false);
    return __uint_as_float(r[0]) + __uint_as_float(r[1]);
}
__device__ __forceinline__ float wave_allmax(float v) {
    v = fmaxf(v, dpp_mov_f<0x128>(v)); v = fmaxf(v, dpp_mov_f<0x124>(v)); v = fmaxf(v, dpp_mov_f<0x122>(v)); v = fmaxf(v, dpp_mov_f<0x121>(v));
    v = fmaxf(v, __int_as_float(__builtin_amdgcn_ds_swizzle(__float_as_int(v), 0x401F)));
    const auto r = __builtin_amdgcn_permlane32_swap(__float_as_uint(v), __float_as_uint(v), false, false);
    return fmaxf(__uint_as_float(r[0]), __uint_as_float(r[1]));
}
__device__ __forceinline__ int tid_rebuild(int wave) { int t = wave * 64 + lane_id(); asm volatile("" : "+v"(t)); return t; }
__device__ __forceinline__ void refresh(Frame& F) { const int t = tid_rebuild(F.wave); F.tid = t; F.lane = t & 63; }
__device__ __forceinline__ int modrow_of(int t) { return t < NLAT ? (t >> 11) : 16; }

constexpr int XT_W1 = (F8_G1 || I8_G1) ? 0 : 20 * 32, XT_W3 = F8_G3 ? 0 : 8 * 32, XT_WQKV = F8_QKV ? 0 : 24 * 32, XT_WO = F8_WO ? 0 : 8 * 32;
constexpr int XT_BF = XT_W1 + XT_W3 + XT_WQKV + XT_WO;
constexpr int XT8_W1 = (F8_G1 || I8_G1) ? 20 * 16 : 0, XT8_W3 = F8_G3 ? 8 * 16 : 0, XT8_WQKV = F8_QKV ? 24 * 16 : 0, XT8_WO = F8_WO ? 8 * 16 : 0;
constexpr int XT8_WGU = 32 * 8 * 16, XT8_WD = 32 * 8 * 8, XT8_TOTAL = XT8_W1 + XT8_W3 + XT8_WQKV + XT8_WO + XT8_WGU + XT8_WD;
constexpr float Y8_SCALE = 16.0f;
constexpr float A8_SCALE = 8.0f;
constexpr int XT8_DENSE = XT8_W1 + XT8_W3 + XT8_WQKV + XT8_WO;
constexpr int XT_TOTAL = XT_BF + XT8_TOTAL;
constexpr float GU_GATE_K = 1.4426950408889634f, GU_UP_K = 4.0f / 1.4426950408889634f;
constexpr float W1Q = 127.0f / 0.09375f, W1DQ = 0.09375f / 127.0f;
constexpr float W8_SCALE = 64.0f;
constexpr float H8_SCALE = 4.0f;
constexpr size_t WGU_LSTRIDE = (size_t)16 * 2048 * 2048 * 2, WD_LSTRIDE = (size_t)16 * 2048 * 1024 * 2;
constexpr int ADA_UNITS = 0;
constexpr int P0_UNITS = XT_TOTAL + ADA_UNITS + 1 + 16;

struct XTile { const float* src; bf16_t* dst; int ld, K, rb, kb; };
__device__ __forceinline__ int col0_w1(const int rb, const int gi) {
    return rb < 8 ? (gi < 4 ? 1024 + rb * 128 + gi * 32 : 2048 + rb * 128 + (gi - 4) * 32) : rb < 12 ? (rb - 8) * 256 + gi * 32 : rb < 16 ? 3072 + (rb - 12) * 256 + gi * 32 : 4096 + (rb - 16) * 256 + gi * 32; }
__device__ __forceinline__ int col0_wqkv(const int rb, const int gi) {
    if (rb < 16) { const int part = rb >> 3, head = rb & 7, g4 = gi & 3, m = g4 >> 1, a = g4 & 1; return part * 2048 + head * 256 + m * 128 + a * 64 + (gi >= 4 ? 32 : 0); }
    return 4096 + (rb - 16) * 256 + gi * 32; }
__device__ __forceinline__ XTile xt_decode(int T, const int gi, const Params& p, unsigned char* ws) {
    XTile x; int col0;
    if (T < XT_W1) { x.rb = T >> 5; x.kb = T & 31; x.K = 2048; x.ld = 5120; x.src = inptr(p, 9); x.dst = (bf16_t*)(ws + WS_W1); col0 = col0_w1(x.rb, gi); }
    else if ((T -= XT_W1) < XT_W3) { x.rb = T >> 5; x.kb = T & 31; x.K = 2048; x.ld = 2048; x.src = inptr(p, 18); x.dst = (bf16_t*)(ws + WS_W3); col0 = x.rb * 256 + gi * 32; }
    else if ((T -= XT_W3) < XT_WQKV) { x.rb = T >> 5; x.kb = T & 31; x.K = 2048; x.ld = 6144; x.src = inptr(p, 19); x.dst = (bf16_t*)(ws + WS_WQKV); col0 = col0_wqkv(x.rb, gi); }
    else { T -= XT_WQKV; x.rb = T >> 5; x.kb = T & 31; x.K = 2048; x.ld = 2048; x.src = inptr(p, 25); x.dst = (bf16_t*)(ws + WS_WO); col0 = x.rb * 256 + gi * 32; }
    x.src += col0; return x;
}
struct XRegs { f32x4 v0[4], v1[4]; };
__device__ __forceinline__ void xt_load(XRegs& R, const XTile& x, const int lane) {
    const int kq = lane >> 3, c4 = (lane & 7) * 4;
    const float* s = x.src + (size_t)(x.kb * 64 + 2 * kq) * x.ld + c4;
#pragma unroll
    for (int it = 0; it < 4; ++it) { R.v0[it] = *(const f32x4*)(s + (size_t)(16 * it) * x.ld); R.v1[it] = *(const f32x4*)(s + (size_t)(16 * it + 1) * x.ld); }
}
__device__ __forceinline__ void xt_store(const Frame& F, const XRegs& R, const XTile& x) {
    LAS unsigned* T = (LAS unsigned*)F.lds;
    const int l = F.lane, w = F.wave, kq = l >> 3, c4 = (l & 7) * 4;
#pragma unroll
    for (int it = 0; it < 4; ++it)
#pragma unroll
        for (int j = 0; j < 4; ++j) T[(w * 32 + c4 + j) * 36 + 8 * it + kq] = cvt_pk_bf16(R.v0[it][j], R.v1[it][j]);
    __syncthreads();
#pragma unroll
    for (int it = 0; it < 4; ++it) { const int q = F.tid + 512 * it, row = q >> 3, piece = q & 7;
        const u32x4 v = *(const LAS u32x4*)(T + row * 36 + piece * 4);
        *(u32x4*)(x.dst + (size_t)(x.rb * 256 + row) * x.K + x.kb * 64 + piece * 8) = v; }
    __syncthreads();
}

struct XTile8 { const float* src; unsigned char* dst; int ld, K, rb, kb, pair, i8; float scale; };
__device__ __forceinline__ XTile8 xt8_decode(int T, const int gi, const Params& p, unsigned char* ws) {
    XTile8 x; int col0; x.pair = 0; x.i8 = 0; x.scale = W8_SCALE;
    if (T < XT8_W1) { x.rb = T >> 4; x.kb = T & 15; x.K = 2048; x.ld = 5120; x.src = inptr(p, 9); x.dst = ws + WS_W1; col0 = col0_w1(x.rb, gi); if (I8_G1) { x.i8 = 1; x.scale = W1Q; } }
    else if ((T -= XT8_W1) < XT8_W3) { x.rb = T >> 4; x.kb = T & 15; x.K = 2048; x.ld = 2048; x.src = inptr(p, 18); x.dst = ws + WS_W3; col0 = x.rb * 256 + gi * 32; }
    else if ((T -= XT8_W3) < XT8_WQKV) { x.rb = T >> 4; x.kb = T & 15; x.K = 2048; x.ld = 6144; x.src = inptr(p, 19); x.dst = ws + WS_WQKV; col0 = col0_wqkv(x.rb, gi); }
    else if ((T -= XT8_WQKV) < XT8_WO) { x.rb = T >> 4; x.kb = T & 15; x.K = 2048; x.ld = 2048; x.src = inptr(p, 25); x.dst = ws + WS_WO; col0 = x.rb * 256 + gi * 32; }
    else if ((T -= XT8_WO) < XT8_WGU) { const int le = T >> 7; x.rb = (T >> 4) & 7; x.kb = T & 15; x.K = 2048; x.ld = 1024;
        x.src = (gi < 4 ? inptr(p, 28) : inptr(p, 29)) + (size_t)le * 2048 * 1024; col0 = x.rb * 128 + (gi & 3) * 32;
        x.scale = gi < 4 ? W8_SCALE * GU_GATE_K : W8_SCALE * GU_UP_K;
        x.dst = ws + WS_WGU + (size_t)(le >> 4) * WGU_LSTRIDE + (size_t)(le & 15) * 2048 * 2048; }
    else { T -= XT8_WGU; const int le = T >> 6; x.rb = (T >> 3) & 7; x.kb = T & 7; x.K = 1024; x.ld = 2048;
        x.src = inptr(p, 30) + (size_t)le * 1024 * 2048;
        if (F8_Y) { x.pair = 1; col0 = x.rb * 256 + (gi & 3) * 64 + (gi >> 2) * 8; }
        else col0 = x.rb * 256 + gi * 32;
        x.dst = ws + WS_WD + (size_t)(le >> 4) * WD_LSTRIDE + (size_t)(le & 15) * 2048 * 1024; }
    x.src += col0; return x;
}
struct XRegs8 { f32x4 v[4][4]; };
__device__ __forceinline__ void xt8_load(XRegs8& R, const XTile8& x, const int lane) {
    const int kq = lane >> 3, c4 = (lane & 7) * 4;
    const float* s = x.src + (size_t)(x.kb * 128 + 4 * kq) * x.ld + (x.pair ? 16 * (c4 >> 3) + (c4 & 7) : c4);
#pragma unroll
    for (int it = 0; it < 4; ++it)
#pragma unroll
        for (int j = 0; j < 4; ++j) R.v[it][j] = *(const f32x4*)(s + (size_t)(32 * it + j) * x.ld);
}
__device__ __forceinline__ void xt8_store(const Frame& F, const XRegs8& R, const XTile8& x) {
    LAS unsigned* T = (LAS unsigned*)F.lds;
    const int l = F.lane, w = F.wave, kq = l >> 3, c4 = (l & 7) * 4;
#pragma unroll
    for (int it = 0; it < 4; ++it)
#pragma unroll
        for (int c = 0; c < 4; ++c) T[(w * 32 + c4 + c) * 36 + 8 * it + kq] = x.i8 ? pack_i8x4(x.scale * R.v[it][0][c], x.scale * R.v[it][1][c], x.scale * R.v[it][2][c], x.scale * R.v[it][3][c])
                                                                          : pack_fp8x4(x.scale * R.v[it][0][c], x.scale * R.v[it][1][c], x.scale * R.v[it][2][c], x.scale * R.v[it][3][c]);
    __syncthreads();
#pragma unroll
    for (int it = 0; it < 4; ++it) { const int q = F.tid + 512 * it, row = q >> 3, piece = q & 7;
        const u32x4 v = *(const LAS u32x4*)(T + row * 36 + piece * 4);
        *(u32x4*)(x.dst + (size_t)(x.rb * 256 + row) * x.K + x.kb * 128 + piece * 16) = v; }
    __syncthreads();
}

__device__ __forceinline__ void p0_prologue(const Frame& F, const Params& p) {
    unsigned char* ws = F.ws;
    {
        for (int u = F.bx; u < XT_BF; u += F.G) { XRegs cur; const XTile xc = xt_decode(u, F.wave, p, ws); xt_load(cur, xc, F.lane); xt_store(F, cur, xc); }
        for (int u = F.bx; u < (MK_TAILFILL ? XT8_DENSE : XT8_TOTAL); u += F.G) { XRegs8 cur; const XTile8 xc = xt8_decode(u, F.wave, p, ws); xt8_load(cur, xc, F.lane); xt8_store(F, cur, xc); }
    }
    {
        LAS float* sS = (LAS float*)F.lds;
        const float* cin = inptr(p, 1); const float* cctx = inptr(p, 3); const float* adaw = inptr(p, 4); const float* adab = inptr(p, 5);
        float* mod = (float*)(ws + WS_MOD);
        for (int cbk = F.bx; cbk < 256; cbk += F.G) {
            __syncthreads();
            for (int i = F.tid; i < 17 * 2048; i += 512) { const int r = i >> 11, k = i & 2047; const float cv = r < 16 ? cin[r * D + k] : cctx[k]; sS[i] = cv / (1.0f + expf(-cv)); }
            __syncthreads();
            const int colg = cbk * 96, l = colg / MODW, n0 = colg % MODW;
            const int c = F.tid % 24, kl = F.tid / 24;
            f32x4 acc[17];
#pragma unroll
            for (int r = 0; r < 17; ++r) acc[r] = (f32x4){0.f, 0.f, 0.f, 0.f};
            if (kl < 21) {
                const float* wp = adaw + ((size_t)l * D) * MODW + n0 + c * 4;
#pragma unroll 1
                for (int k0 = kl; k0 < 2048; k0 += 21 * 8) {
                    f32x4 wv[8];
#pragma unroll
                    for (int j = 0; j < 8; ++j) { const int k = k0 + 21 * j; wv[j] = k < 2048 ? *(const f32x4*)(wp + (size_t)k * MODW) : (f32x4){0.f, 0.f, 0.f, 0.f}; }
#pragma unroll
                    for (int j = 0; j < 8; ++j) { const int k = min(k0 + 21 * j, 2047);
#pragma unroll
                        for (int r = 0; r < 17; ++r) acc[r] += sS[r * 2048 + k] * wv[j]; }
                }
            }
            __syncthreads();
            if (kl < 21) {
#pragma unroll
                for (int r = 0; r < 17; ++r) *(LAS f32x4*)(sS + (kl * 17 + r) * 96 + c * 4) = acc[r];
            }
            __syncthreads();
            for (int o = F.tid; o < 17 * 96; o += 512) { const int r = o / 96, cc = o % 96; float sum = adab[(size_t)l * MODW + n0 + cc];
#pragma unroll
                for (int q = 0; q < 21; ++q) sum += sS[(q * 17 + r) * 96 + cc];
                mod[((size_t)l * 17 + r) * MODW + n0 + cc] = sum; }
        }
        __syncthreads();
    }
    const int first = XT_TOTAL + ((F.bx - XT_TOTAL % F.G) % F.G + F.G) % F.G;
    for (int u = first; u < P0_UNITS; u += F.G) {
        if (false) {
        } else if (u == XT_TOTAL + ADA_UNITS) {
            float* rc = (float*)(ws + WS_ROPE); float* rs = rc + 2048;
            for (int i = F.tid; i < 2048; i += 512) { const int pos = i >> 5, j = i & 31;
                const float inv = exp2f(-(float)(2 * j) * (13.287712379549449f / 64.0f)); const float ang = (float)pos * inv;
                rc[i] = cosf(ang); rs[i] = sinf(ang); }
        } else {
            const int q = u - (XT_TOTAL + ADA_UNITS + 1), d = q >> 3, h = q & 7;
            bf16_t* gw = (bf16_t*)(ws + WS_GW) + (size_t)(d * 8 + h) * 2 * 128 * 128;
            const float* wa = inptr(p, 13) + (size_t)(d * 8 + h) * 128 * 128; const float* wi = inptr(p, 15) + (size_t)(d * 8 + h) * 128 * 128;
            for (int i = F.tid; i < 128 * 128; i += 512) { const int k = i >> 7, j = i & 127, half = j >> 6, o = j & 63;
                gw[(size_t)(half * 128 + o) * 128 + k] = (bf16_t)(cvt_pk_bf16(wa[i], 0.f) & 0xffffu);
                gw[(size_t)(half * 128 + 64 + o) * 128 + k] = (bf16_t)(cvt_pk_bf16(wi[i], 0.f) & 0xffffu); }
        }
    }
}

__device__ __forceinline__ void moe_tile(const Frame& F, const Params& p, const int layer, const int i) {
    const int T = XT8_DENSE + (i < 2048 ? layer * 2048 + i : XT8_WGU + layer * 1024 + (i - 2048));
    XRegs8 cur; const XTile8 xc = xt8_decode(T, F.wave, p, F.ws); xt8_load(cur, xc, F.lane); xt8_store(F, cur, xc);
}
__device__ __forceinline__ void tail_fill(const Frame& F, const Params& p, const int layer, const int done_slot, const bool exhaust) {
    unsigned* ctl = (unsigned*)(F.ws + WS_CTL);
    LAS int* slot = (LAS int*)(F.lds + LX_MISC + 512);
    __syncthreads();
    if (F.tid == 0 && !exhaust) __hip_atomic_fetch_add(ctl + CW_DONE + done_slot, 1u, __ATOMIC_RELAXED, __HIP_MEMORY_SCOPE_AGENT);
#pragma unroll 1
    for (;;) {
        if (F.tid == 0) { int t = -1;
            const bool go = exhaust || __hip_atomic_load(ctl + CW_DONE + done_slot, __ATOMIC_RELAXED, __HIP_MEMORY_SCOPE_AGENT) < (unsigned)F.G;
            if (go) { const unsigned c = __hip_atomic_fetch_add(ctl + CW_FILL + layer, 1u, __ATOMIC_RELAXED, __HIP_MEMORY_SCOPE_AGENT); if (c < 3072u) t = (int)c; }
            *slot = t; }
        __syncthreads();
        const int t = *slot;
        if (t < 0) break;
        moe_tile(F, p, layer, t);
    }
    __syncthreads();
}

__device__ __forceinline__ void p1_modreduce(const Frame& F, const Params& p) {
    const float* part = (const float*)(F.ws + WS_HID); float* mod = (float*)(F.ws + WS_MOD);
    const int n4 = 2 * 17 * MODW / 4; const float* adab = inptr(p, 5);
    for (int i = F.bx * 512 + F.tid; i < n4; i += F.G * 512) {
        const int e = i * 4, l = e / (17 * MODW), rr = (e / MODW) % 17, n = e % MODW;
        f32x4 s = *(const f32x4*)(adab + (size_t)l * MODW + n);
#pragma unroll
        for (int kc = 0; kc < 16; ++kc) s += *(const f32x4*)(part + ((size_t)(l * 16 + kc) * 17 + rr) * MODW + n);
        *(f32x4*)(mod + e) = s;
    }
}

struct RowRegs { f32x4 x[8]; u32x2 y0[8], y1[8]; };
template <int MODE>
__device__ __forceinline__ void row_load(RowRegs& R, const int t, const int lane, const int fin_mode, const float* xin0, const float* xin2, const bf16_t* XR, const bf16_t* Y0, const bf16_t* Y1) {
    if (MODE == 0 || (MODE == 3 && fin_mode == 2)) {
        const float* src = t < NLAT ? xin0 + (size_t)t * D : xin2 + (size_t)(t - NLAT) * D;
#pragma unroll
        for (int j = 0; j < 8; ++j) R.x[j] = *(const f32x4*)(src + 256 * j + 4 * lane);
    } else {
#pragma unroll
        for (int j = 0; j < 8; ++j) { const u32x2 a = *(const u32x2*)(XR + (size_t)t * D + 256 * j + 4 * lane); R.x[j] = (f32x4){bflo(a.x), bfhi(a.x), bflo(a.y), bfhi(a.y)}; }
    }
    if (MODE == 2 || (MODE == 3 && fin_mode == 0)) {
#pragma unroll
        for (int j = 0; j < 8; ++j) {
#if F8_Y
            R.y0[j].x = *(const unsigned*)((const unsigned char*)Y0 + (size_t)t * D + 256 * j + 4 * lane); R.y1[j].x = *(const unsigned*)((const unsigned char*)Y0 + ((size_t)NTOK + t) * D + 256 * j + 4 * lane);
#else
            R.y0[j] = *(const u32x2*)(Y0 + (size_t)t * D + 256 * j + 4 * lane); R.y1[j] = *(const u32x2*)(Y1 + (size_t)t * D + 256 * j + 4 * lane);
#endif
        }
    }
}
__device__ __forceinline__ void router_logits2(const LAS float* wl, const int lane, const f32x4 (&va)[8], const f32x4 (&vb)[8], float (&pa)[16], float (&pb)[16]) {
#pragma unroll
    for (int e = 0; e < 16; ++e) { f32x2 sa = {0.f, 0.f}, sb = {0.f, 0.f};
#pragma unroll
        for (int j = 0; j < 8; ++j) { const f32x4 wv = *(const LAS f32x4*)(wl + e * 2048 + 256 * j + 4 * lane);
            const f32x2 w01 = {wv[0], wv[1]}, w23 = {wv[2], wv[3]};
            sa += (f32x2){va[j][0], va[j][1]} * w01; sa += (f32x2){va[j][2], va[j][3]} * w23;
            sb += (f32x2){vb[j][0], vb[j][1]} * w01; sb += (f32x2){vb[j][2], vb[j][3]} * w23; }
        pa[e] = wave_allsum(sa[0] + sa[1]); pb[e] = wave_allsum(sb[0] + sb[1]); }
}
__device__ __forceinline__ void router_pick(const float (&pe)[16], const LAS float* rbl, LAS int* lcnt, LAS int* rec, LAS float* recg, const int rl, const bool file) {
    float scv[16], sel[16];
#pragma unroll
    for (int e = 0; e < 16; ++e) { scv[e] = __builtin_amdgcn_rcpf(1.0f + __expf(-pe[e])); sel[e] = scv[e] + rbl[e]; }
    float best = -3.0e38f, bs1 = 0.f, bs2 = 0.f; int be1 = 0, be2 = 1;
#pragma unroll
    for (int g = 0; g < 4; ++g) {
        const float a0 = sel[4 * g], a1 = sel[4 * g + 1], a2 = sel[4 * g + 2], a3 = sel[4 * g + 3];
        const float c0 = scv[4 * g], c1 = scv[4 * g + 1], c2 = scv[4 * g + 2], c3 = scv[4 * g + 3];
        int i1 = 0; float m1 = a0, s1 = c0; if (a1 > m1) { m1 = a1; i1 = 1; s1 = c1; } if (a2 > m1) { m1 = a2; i1 = 2; s1 = c2; } if (a3 > m1) { m1 = a3; i1 = 3; s1 = c3; }
        int i2 = -1; float m2 = -3.0e38f, s2 = 0.f;
        if (i1 != 0 && a0 > m2) { m2 = a0; i2 = 0; s2 = c0; } if (i1 != 1 && a1 > m2) { m2 = a1; i2 = 1; s2 = c1; } if (i1 != 2 && a2 > m2) { m2 = a2; i2 = 2; s2 = c2; } if (i1 != 3 && a3 > m2) { m2 = a3; i2 = 3; s2 = c3; }
        const float gs = m1 + m2;
        if (gs > best) { best = gs; be1 = 4 * g + i1; be2 = 4 * g + i2; bs1 = s1; bs2 = s2; }
    }
    if (file) { const float inv = 1.0f / (bs1 + bs2);
        const int p1 = __hip_atomic_fetch_add(lcnt + be1, 1, __ATOMIC_RELAXED, __HIP_MEMORY_SCOPE_WORKGROUP), p2 = __hip_atomic_fetch_add(lcnt + be2, 1, __ATOMIC_RELAXED, __HIP_MEMORY_SCOPE_WORKGROUP);
        rec[rl * 2] = (be1 << 16) | p1; rec[rl * 2 + 1] = (be2 << 16) | p2; recg[rl * 2] = bs1 * inv; recg[rl * 2 + 1] = bs2 * inv; }
}
__device__ __forceinline__ void ffn_norm_row(const RowRegs& R, const int t, const int lane, const LAS float* cA, const LAS float* cB, unsigned char* HB8, f32x4 (&v)[8]) {
    float ss = 0.f;
#pragma unroll
    for (int j = 0; j < 8; ++j) { v[j] = R.x[j]; ss += v[j][0] * v[j][0] + v[j][1] * v[j][1] + v[j][2] * v[j][2] + v[j][3] * v[j][3]; }
    ss = wave_allsum(ss);
    const float rstd = 1.0f / sqrtf(ss * (1.0f / 2048.0f) + EPS);
#pragma unroll
    for (int j = 0; j < 8; ++j) { const int col = 256 * j + 4 * lane;
        const f32x4 ca = *(const LAS f32x4*)(cA + col), cb = *(const LAS f32x4*)(cB + col);
        v[j] = v[j] * rstd * ca + cb;
        *(unsigned*)(HB8 + (size_t)t * D + col) = pack_fp8x4(clamp8(v[j][0]), clamp8(v[j][1]), clamp8(v[j][2]), clamp8(v[j][3])); }
}
template <int MODE>
__device__ __forceinline__ void row_phase(const Frame& F, const Params& p, const int l, const int fin_mode) {
    unsigned char* ws = F.ws;
    const float* mod = (const float*)(ws + WS_MOD);
    bf16_t* HB = (bf16_t*)(ws + WS_HB); bf16_t* XR = (bf16_t*)(ws + WS_XR);
    const bf16_t* Y0 = (const bf16_t*)(ws + WS_R1); const bf16_t* Y1 = Y0 + (size_t)NTOK * D;
    const int nrows = (MODE == 3 || (MODE == 1 && l == 1)) ? NLAT : NTOK;
    const int chunk = (nrows + F.G - 1) / F.G, r_begin = F.bx * chunk, r_end = min(nrows, r_begin + chunk);
    const int lane = F.lane, w = F.wave;
    constexpr bool OUT8 = MODE == 1 || (MODE == 0 && F8_G1) || (MODE == 2 && F8_QKV);
    LAS float* wl = (LAS float*)F.lds;
    LAS float* cA = (LAS float*)(F.lds + 131072); LAS float* cB = cA + 2048;
    LAS int* lcnt = (LAS int*)(F.lds + LX_LCNT); LAS int* lbase = (LAS int*)(F.lds + LX_LBASE);
    LAS int* rec = (LAS int*)(F.lds + LX_REC); LAS float* recg = (LAS float*)(F.lds + LX_RECG);
    LAS float* rbl = (LAS float*)(F.lds + LX_MISC);
    if (MODE == 1) {
        const float* rw = inptr(p, 26);
        for (int i = F.tid; i < 2048 * 4; i += 512) { const int k = i >> 2, e4 = (i & 3) * 4; const f32x4 v = *(const f32x4*)(rw + k * 16 + e4);
#pragma unroll
            for (int j = 0; j < 4; ++j) wl[(e4 + j) * 2048 + k] = v[j]; }
        if (F.tid < 16) { lcnt[F.tid] = 0; rbl[F.tid] = inptr(p, 27)[F.tid]; }
    }
    const float* gain = MODE == 0 ? inptr(p, 6) : MODE == 1 ? inptr(p, 7) + (size_t)l * D : MODE == 2 ? inptr(p, 6) + D : inptr(p, 8);
    const int sh_off = (MODE == 1) ? 6144 : 0, sc_off = (MODE == 1) ? 8192 : 2048;
    const int lmod = (MODE == 2) ? 1 : l;
    const float* xin0 = inptr(p, 0); const float* xin2 = inptr(p, 2);
    for (int rs = r_begin; rs < r_end; rs += ROWCH) {
        const int re = min(r_end, rs + ROWCH);
        for (int sb = rs; sb < re;) {
            const int b = modrow_of(sb);
            const int bend = b < 16 ? (b + 1) * SEQ : NTOK, se = min(re, bend);
            __syncthreads();
            for (int c4 = F.tid; c4 < 512; c4 += 512) {
                const int col = c4 * 4; const f32x4 g = *(const f32x4*)(gain + col);
                if (MODE == 3) { *(LAS f32x4*)(cA + col) = g; }
                else { const f32x4 sc = *(const f32x4*)(mod + ((size_t)lmod * 17 + b) * MODW + sc_off + col), sh = *(const f32x4*)(mod + ((size_t)lmod * 17 + b) * MODW + sh_off + col);
                    *(LAS f32x4*)(cA + col) = g * (1.0f + sc); *(LAS f32x4*)(cB + col) = sh; }
                if (MODE == 2 || MODE == 3) *(LAS f32x4*)(wl + col) = *(const f32x4*)(mod + ((size_t)l * 17 + b) * MODW + 10240 + col) * (F8_Y ? 1.0f / Y8_SCALE : 1.0f);
            }
            __syncthreads();
            if (MODE == 1) {
                RowRegs c0, c1, n0, n1;
                int t = sb + w;
                if (t < se) row_load<1>(c0, t, lane, fin_mode, xin0, xin2, XR, Y0, Y1);
                if (t + 8 < se) row_load<1>(c1, t + 8, lane, fin_mode, xin0, xin2, XR, Y0, Y1);
#pragma unroll 1
                for (; t < se; t += 16) {
                    const bool has_b = t + 8 < se;
                    if (t + 16 < se) row_load<1>(n0, t + 16, lane, fin_mode, xin0, xin2, XR, Y0, Y1);
                    if (t + 24 < se) row_load<1>(n1, t + 24, lane, fin_mode, xin0, xin2, XR, Y0, Y1);
                    f32x4 va[8], vb[8];
                    ffn_norm_row(c0, t, lane, cA, cB, (unsigned char*)HB, va);
                    if (has_b) ffn_norm_row(c1, t + 8, lane, cA, cB, (unsigned char*)HB, vb);
                    else {
#pragma unroll
                        for (int j = 0; j < 8; ++j) vb[j] = va[j]; }
                    float pa[16], pb[16];
                    router_logits2(wl, lane, va, vb, pa, pb);
                    router_pick(pa, rbl, lcnt, rec, recg, t - rs, lane == 0);
                    router_pick(pb, rbl, lcnt, rec, recg, t + 8 - rs, lane == 0 && has_b);
#pragma unroll
                    for (int j = 0; j < 8; ++j) { c0.x[j] = n0.x[j]; c1.x[j] = n1.x[j]; }
                }
                sb = se; continue;
            }
            RowRegs cur, nxt;
            int t = sb + w;
            if (t < se) row_load<MODE>(cur, t, lane, fin_mode, xin0, xin2, XR, Y0, Y1);
            for (; t < se; t += 8) {
                const int tn = t + 8;
                if (tn < se) row_load<MODE>(nxt, tn, lane, fin_mode, xin0, xin2, XR, Y0, Y1);
                f32x4 v[8];
#pragma unroll
                for (int j = 0; j < 8; ++j) v[j] = cur.x[j];
                if (MODE == 2 || (MODE == 3 && fin_mode == 0)) {
#pragma unroll
                    for (int j = 0; j < 8; ++j) { const int col = 256 * j + 4 * lane; const f32x4 g = *(const LAS f32x4*)(wl + col); const u32x2 a = cur.y0[j], c = cur.y1[j];
#if F8_Y
                        const f32x2 a01 = __builtin_amdgcn_cvt_pk_f32_fp8((int)a.x, false), a23 = __builtin_amdgcn_cvt_pk_f32_fp8((int)a.x, true), c01 = __builtin_amdgcn_cvt_pk_f32_fp8((int)c.x, false), c23 = __builtin_amdgcn_cvt_pk_f32_fp8((int)c.x, true);
                        v[j][0] += g[0] * (a01[0] + c01[0]); v[j][1] += g[1] * (a01[1] + c01[1]);
                        v[j][2] += g[2] * (a23[0] + c23[0]); v[j][3] += g[3] * (a23[1] + c23[1]); }
#else
                        v[j][0] += g[0] * (bflo(a.x) + bflo(c.x)); v[j][1] += g[1] * (bfhi(a.x) + bfhi(c.x));
                        v[j][2] += g[2] * (bflo(a.y) + bflo(c.y)); v[j][3] += g[3] * (bfhi(a.y) + bfhi(c.y)); }
#endif
                    if (MODE == 2) {
#pragma unroll
                        for (int j = 0; j < 8; ++j) { u32x2 o; o.x = cvt_pk_bf16(v[j][0], v[j][1]); o.y = cvt_pk_bf16(v[j][2], v[j][3]); *(u32x2*)(XR + (size_t)t * D + 256 * j + 4 * lane) = o;
                            v[j] = (f32x4){bflo(o.x), bfhi(o.x), bflo(o.y), bfhi(o.y)}; }
                    }
                }
                float ss = 0.f;
#pragma unroll
                for (int j = 0; j < 8; ++j) ss += v[j][0] * v[j][0] + v[j][1] * v[j][1] + v[j][2] * v[j][2] + v[j][3] * v[j][3];
                ss = wave_allsum(ss);
                const float rstd = 1.0f / sqrtf(ss * (1.0f / 2048.0f) + EPS);
                if (MODE == 3) {
                    float* dst = F.out + (size_t)t * D;
#pragma unroll
                    for (int j = 0; j < 8; ++j) { const f32x4 g = *(const LAS f32x4*)(cA + 256 * j + 4 * lane); *(f32x4*)(dst + 256 * j + 4 * lane) = v[j] * rstd * g; }
                } else {
                    if (MODE == 0 && I8_G1) {
                        float am = 0.f;
#pragma unroll
                        for (int j = 0; j < 8; ++j) { const int col = 256 * j + 4 * lane;
                            const f32x4 ca = *(const LAS f32x4*)(cA + col), cb = *(const LAS f32x4*)(cB + col);
                            v[j] = v[j] * rstd * ca + cb;
                            am = fmaxf(am, fmaxf(fmaxf(fabsf(v[j][0]), fabsf(v[j][1])), fmaxf(fabsf(v[j][2]), fabsf(v[j][3])))); }
                        am = fmaxf(wave_allmax(am), 1e-20f);
                        const float qs = 127.0f * __builtin_amdgcn_rcpf(am);
#pragma unroll
                        for (int j = 0; j < 8; ++j) *(unsigned*)((unsigned char*)HB + (size_t)t * D + 256 * j + 4 * lane) = pack_i8x4(v[j][0] * qs, v[j][1] * qs, v[j][2] * qs, v[j][3] * qs);
                        if (lane == 0) ((float*)(ws + WS_ASC))[t] = am * (1.0f / 127.0f);
                    } else
#pragma unroll
                    for (int j = 0; j < 8; ++j) { const int col = 256 * j + 4 * lane;
                        const f32x4 ca = *(const LAS f32x4*)(cA + col), cb = *(const LAS f32x4*)(cB + col);
                        v[j] = v[j] * rstd * ca + cb;
                        if (OUT8) {
                            *(unsigned*)((unsigned char*)HB + (size_t)t * D + col) = pack_fp8x4(clamp8(v[j][0]), clamp8(v[j][1]), clamp8(v[j][2]), clamp8(v[j][3]));
                        } else {
                            u32x2 o; o.x = cvt_pk_bf16(v[j][0], v[j][1]); o.y = cvt_pk_bf16(v[j][2], v[j][3]);
                            *(u32x2*)(HB + (size_t)t * D + col) = o; } }
                }
                if (tn < se) {
#pragma unroll
                    for (int j = 0; j < 8; ++j) { cur.x[j] = nxt.x[j]; cur.y0[j] = nxt.y0[j]; cur.y1[j] = nxt.y1[j]; } }
            }
            sb = se;
        }
        if (MODE == 1) {
            __syncthreads();
            unsigned* cntg = (unsigned*)(ws + WS_CTL) + CW_CNT + l * 64;
            if (F.tid < 16) lbase[F.tid] = (int)__hip_atomic_fetch_add(cntg + F.tid, (unsigned)lcnt[F.tid], __ATOMIC_RELAXED, __HIP_MEMORY_SCOPE_AGENT);
            __syncthreads();
            int* list = (int*)(ws + WS_LIST); float* listg = (float*)(ws + WS_LISTG);
            const int nrec = (re - rs) * 2;
            for (int i = F.tid; i < nrec; i += 512) { const int rr = rec[i], e = rr >> 16, pos = lbase[e] + (rr & 0xffff); const int t = rs + (i >> 1);
                list[(size_t)e * NTOK + pos] = t * 2 + (i & 1); listg[(size_t)e * NTOK + pos] = recg[i]; }
            __syncthreads();
            if (F.tid < 16) lcnt[F.tid] = 0;
            __syncthreads();
        }
    }
}

namespace pg8 {
constexpr int BM = 256, BK = 64, HALF = 128, HTB = HALF * BK * 2, NXCD = 8, WGM = 8;
__host__ __device__ __forceinline__ int lds_byte(int r, int c) { const int st = (r >> 4) * 2 + (c >> 5), rr = r & 15, cc = c & 31, ob = rr * 64 + cc * 2; return st * 1024 + (ob ^ (((ob >> 9) & 1) << 5)); }
__host__ __device__ __forceinline__ void stage_rc(int b, int& R, int& C) { const int st = b / 1024, sb = b % 1024, swz = sb ^ (((sb >> 9) & 1) << 5); R = (st >> 1) * 16 + swz / 64; C = (st & 1) * 32 + (swz % 64) / 2; }
__host__ __device__ __forceinline__ int perm32(int rho) { const int n = rho >> 4, i = rho & 15; return 8 * (i >> 2) + 4 * n + (i & 3); }

struct Unit { int pm, pn, e, pos0, cnt; };

__device__ __forceinline__ bool static_map(long L, int nM, int nN, int& pm, int& pn) {
    const int nwg = nM * nN; if (L >= nwg) return false;
    int wgid = (int)L; { const int q = nwg / NXCD, r = nwg % NXCD, xcd = wgid % NXCD, off = wgid / NXCD; wgid = (xcd < r ? xcd * (q + 1) : r * (q + 1) + (xcd - r) * q) + off; }
    const int nig = WGM * nN, gid = wgid / nig, fm = gid * WGM, gsz = (nM - fm) < WGM ? (nM - fm) : WGM;
    pm = fm + ((wgid % nig) % gsz); pn = (wgid % nig) / gsz; return true;
}
__device__ __forceinline__ bool static_next(int i, int G, int c, int nM, int nN, int& pm, int& pn) { return static_map((long)i * G + c, nM, nN, pm, pn); }
template <bool FP8_, bool I8_ = false> struct DenseSched {
    static constexpr bool GATHER = false, FP8 = FP8_, I8 = I8_; static constexpr int ES = (FP8_ || I8_) ? 1 : 2;
    const char* A; const char* B; int nM, nN, K, G, c; int sw, sa;
    __device__ __forceinline__ int scale_w() const { return sw; } __device__ __forceinline__ int scale_a() const { return sa; }
    __device__ __forceinline__ bool next(int i, Unit& u) const { u.e = 0; u.pos0 = 0; u.cnt = 0; return static_next(i, G, c, nM, nN, u.pm, u.pn); }
    __device__ __forceinline__ const char* a_tile(const Unit& u) const { return A + (size_t)u.pm * 256 * K * ES; }
    __device__ __forceinline__ unsigned a_row_off(const Unit&, int r) const { return (unsigned)r * (unsigned)K * (unsigned)ES; }
    __device__ __forceinline__ const char* b_tile(const Unit& u) const { return B + (size_t)u.pn * 256 * K * ES; }
};
#ifndef MK_NTSTORE
#define MK_NTSTORE 1
#endif
__device__ __forceinline__ void st16(bf16_t* p, const u32x4 v) {
#if MK_NTSTORE
    __builtin_nontemporal_store(v, (u32x4*)p);
#else
    *(u32x4*)p = v;
#endif
}
template <bool FP8_> struct QkvSched {
    static constexpr bool GATHER = false, FP8 = FP8_, I8 = false; static constexpr int ES = FP8_ ? 1 : 2;
    const char* A; const char* B; int K, G, c; int sw, sa;
    __device__ __forceinline__ int scale_w() const { return sw; } __device__ __forceinline__ int scale_a() const { return sa; }
    __device__ __forceinline__ bool next(int i, Unit& u) const {
        u.pos0 = 0; u.cnt = 0; const long L = (long)i * G + c; constexpr int n1 = (NLAT / 256) * 24;
        if (L < n1) { u.e = 0; return static_map(L, NLAT / 256, 24, u.pm, u.pn); }
        u.e = 1; return static_map(L - n1, NCTX / 256, 16, u.pm, u.pn);
    }
    __device__ __forceinline__ const char* a_tile(const Unit& u) const { return A + ((size_t)(u.e ? NLAT : 0) + (size_t)u.pm * 256) * K * ES; }
    __device__ __forceinline__ unsigned a_row_off(const Unit&, int r) const { return (unsigned)r * (unsigned)K * (unsigned)ES; }
    __device__ __forceinline__ const char* b_tile(const Unit& u) const { return B + ((size_t)(u.e ? 2048 : 0) + (size_t)u.pn * 256) * K * ES; }
};
template <bool GATHER_> struct MoeSched {
    static constexpr bool GATHER = GATHER_, FP8 = true, I8 = false;
    const char* A; const char* B; size_t estride; const LAS int* pre; const LAS int* cnt; const int* list; int K, G, c; int sw, sa;
    __device__ __forceinline__ int scale_w() const { return sw; } __device__ __forceinline__ int scale_a() const { return sa; }
    __device__ __forceinline__ bool next(int i, Unit& u) const {
        const int MT = pre[16]; if (!static_next(i, G, c, MT, 8, u.pm, u.pn)) return false;
        int e = 0;
#pragma unroll
        for (int j = 1; j < 16; ++j) e += (u.pm >= pre[j]) ? 1 : 0;
        u.e = e; u.pos0 = (u.pm - pre[e]) * 256; u.cnt = cnt[e]; return true;
    }
    __device__ __forceinline__ const char* a_tile(const Unit& u) const { return GATHER ? A : A + (size_t)u.pm * 256 * K; }
    __device__ __forceinline__ unsigned a_row_off(const Unit& u, int r) const {
        if (!GATHER) return (unsigned)r * (unsigned)K;
        const int pos = u.pos0 + r; const int t2 = pos < u.cnt ? list[(size_t)u.e * NTOK + pos] : 0;
        return (unsigned)(t2 >> 1) * (unsigned)K;
    }
    __device__ __forceinline__ const char* b_tile(const Unit& u) const { return B + (size_t)u.e * estride + (size_t)u.pn * 256 * K; }
};

typedef int i32x4v __attribute__((ext_vector_type(4)));
typedef int i32x8v __attribute__((ext_vector_type(8)));
__device__ __forceinline__ i32x8v cat8(bf16x8 a, bf16x8 b) { const i32x4v x = __builtin_bit_cast(i32x4v, a), y = __builtin_bit_cast(i32x4v, b); return __builtin_shufflevector(x, y, 0, 1, 2, 3, 4, 5, 6, 7); }
__device__ __forceinline__ void mfma8(f32x4& acc, const i32x8v w, const i32x8v a, const int sw, const int sa) {
    asm volatile("v_mfma_scale_f32_16x16x128_f8f6f4 %0, %1, %2, %0, %3, %4 op_sel_hi:[0,0,0]" : "+v"(acc) : "v"(w), "v"(a), "v"(sw), "v"(sa));
}
template <class Epi, class Sched>
__device__ __forceinline__ void gemm_phase(LAS unsigned char* lds, const int wave_in, const int K, const Sched& S, const Epi& E) {
    const int tid = tid_rebuild(wave_in), wid = wave_in, lane = tid & 63, wr = wid >> 2, wc = wid & 3, fr = lane & 15, fq = lane >> 4;
    constexpr bool F8 = Sched::FP8;
    constexpr bool I8 = Sched::I8;
    constexpr int ES = (F8 || I8) ? 1 : 2;
    const int nt = K * ES / (BK * 2);
    constexpr bool GA = Sched::GATHER;
    unsigned voffB[2];
#pragma unroll
    for (int i = 0; i < 2; ++i) { int R, C; stage_rc(tid * 16 + i * 8192, R, C); const int Rb = (R & ~31) + perm32(R & 31); voffB[i] = (unsigned)(Rb * K * ES + C * 2); }
#define PG8_AOFF(u, h, i, dst) do { int R_, C_; stage_rc(tid * 16 + (i) * 8192, R_, C_); dst = S.a_row_off(u, (h) * 128 + R_) + (unsigned)C_ * 2u; } while (0)
    const size_t kstep = (size_t)(BK * 2);
    const size_t hstep = (size_t)HALF * K * ES;
    const unsigned ldsw = (unsigned)wid * 1024u;
    const int aoff = lds_byte(wr * 64 + fr, fq * 8), boff = lds_byte(wc * 32 + fr, fq * 8);
#define PG8_SA(b, h) (((b) * 2 + (h)) * HTB)
#define PG8_SB(b, h) ((4 + (b) * 2 + (h)) * HTB)
#define PG8_STAGE(bufoff, gbase, voff) do { _Pragma("unroll") for (int _i = 0; _i < 2; ++_i) \
        __builtin_amdgcn_global_load_lds((const unsigned*)((const char*)(gbase) + (voff)[_i]), (LAS unsigned*)(lds + (bufoff) + ldsw + _i * 8192), 16, 0, 0); } while (0)
#define PG8_LDA(dst, b, h) do { _Pragma("unroll") for (int m = 0; m < 4; ++m) _Pragma("unroll") for (int k = 0; k < 2; ++k) dst[m][k] = *(const LAS bf16x8*)(lds + PG8_SA(b, h) + aoff + m * 2048 + k * 1024); } while (0)
#define PG8_LDB(dst, b, h) do { _Pragma("unroll") for (int n = 0; n < 2; ++n) _Pragma("unroll") for (int k = 0; k < 2; ++k) dst[n][k] = *(const LAS bf16x8*)(lds + PG8_SB(b, h) + boff + n * 2048 + k * 1024); } while (0)
#define PG8_MMA(ai, bj, At, Bt) do { __builtin_amdgcn_s_setprio(1); if constexpr (F8) { _Pragma("unroll") for (int m = 0; m < 4; ++m) _Pragma("unroll") for (int n = 0; n < 2; ++n) \
        mfma8(acc[ai][bj][m][n], cat8(Bt[n][0], Bt[n][1]), cat8(At[m][0], At[m][1]), S.scale_w(), S.scale_a()); } else if constexpr (I8) { \
        _Pragma("unroll") for (int m = 0; m < 4; ++m) _Pragma("unroll") for (int n = 0; n < 2; ++n) _Pragma("unroll") for (int k = 0; k < 2; ++k) \
        acc[ai][bj][m][n] = __builtin_bit_cast(f32x4, __builtin_amdgcn_mfma_i32_16x16x64_i8(__builtin_bit_cast(i32x4v, Bt[n][k]), __builtin_bit_cast(i32x4v, At[m][k]), __builtin_bit_cast(i32x4v, acc[ai][bj][m][n]), 0, 0, 0)); } else \
        _Pragma("unroll") for (int m = 0; m < 4; ++m) _Pragma("unroll") for (int n = 0; n < 2; ++n) _Pragma("unroll") for (int k = 0; k < 2; ++k) \
        acc[ai][bj][m][n] = __builtin_amdgcn_mfma_f32_16x16x32_bf16(Bt[n][k], At[m][k], acc[ai][bj][m][n], 0, 0, 0); __builtin_amdgcn_s_setprio(0); } while (0)
#define PG8_WAIT_V(n) asm volatile("s_waitcnt vmcnt(" #n ")" ::: "memory")
#define PG8_WAIT_L(n) asm volatile("s_waitcnt lgkmcnt(" #n ")" ::: "memory")
#define PG8_BAR __builtin_amdgcn_s_barrier()
#define PG8_SCHED __builtin_amdgcn_sched_barrier(0)
    Unit cur, nxt; int ui = 0;
    if (!S.next(0, cur)) return;
#if MK_STAGGER
    { const unsigned long long t0_ = __builtin_amdgcn_s_memrealtime(); const unsigned long long dl_ = (unsigned long long)((blockIdx.x >> 3) & 7) * MK_STAGGER;
      while (__builtin_amdgcn_s_memrealtime() - t0_ < dl_) __builtin_amdgcn_s_sleep(8); }
#endif
    f32x4 acc[2][2][4][2];
#pragma unroll
    for (int a = 0; a < 2; ++a)
#pragma unroll
        for (int b = 0; b < 2; ++b)
#pragma unroll
            for (int m = 0; m < 4; ++m)
#pragma unroll
                for (int n = 0; n < 2; ++n) acc[a][b][m][n] = (f32x4){0.f, 0.f, 0.f, 0.f};
    bf16x8 At[4][2], B0[2][2], B1[2][2];
    unsigned cvo0[2], cvo1[2];
#pragma unroll
    for (int i = 0; i < 2; ++i) { PG8_AOFF(cur, 0, i, cvo0[i]); if (GA) PG8_AOFF(cur, 1, i, cvo1[i]); else cvo1[i] = cvo0[i]; }
    LAS unsigned* toff = (LAS unsigned*)(lds + LX + 5120);
    const size_t ahs = GA ? (size_t)0 : hstep;
    const char* cA = S.a_tile(cur); const char* cB = S.b_tile(cur);
    PG8_STAGE(PG8_SB(0, 0), cB, voffB); PG8_STAGE(PG8_SA(0, 0), cA, cvo0); PG8_STAGE(PG8_SB(0, 1), cB + hstep, voffB); PG8_STAGE(PG8_SA(0, 1), cA + ahs, cvo1);
    if (wr == 1) PG8_BAR;
#if MK_8PHASE
    PG8_WAIT_V(4); PG8_BAR;
#else
    PG8_WAIT_V(0); PG8_BAR;
#endif
    PG8_STAGE(PG8_SB(1, 0), cB + kstep, voffB); PG8_STAGE(PG8_SA(1, 0), cA + kstep, cvo0); PG8_STAGE(PG8_SB(1, 1), cB + hstep + kstep, voffB);
    PG8_WAIT_V(6); PG8_BAR;
    for (;;) {
        const bool has_next = S.next(ui + 1, nxt);
        const char* nA = has_next ? S.a_tile(nxt) : cA; const char* nB = has_next ? S.b_tile(nxt) : cB;
        if (GA && has_next && tid < 256) toff[((ui + 1) & 1) * 256 + tid] = S.a_row_off(nxt, tid);
        for (int t = 0; t < nt; t += 2) {
            const bool last = (t == nt - 2);
            const char* a1 = cA + (size_t)(t + 1) * kstep;
            const char* a2 = last ? nA : cA + (size_t)(t + 2) * kstep; const char* b2 = last ? nB : cB + (size_t)(t + 2) * kstep;
            const char* a3 = a2 + kstep; const char* b3 = b2 + kstep;
#if MK_8PHASE
            PG8_LDB(B0, 0, 0); PG8_SCHED; PG8_LDA(At, 0, 0); PG8_STAGE(PG8_SA(1, 1), a1 + ahs, cvo1);
            PG8_WAIT_L(8); PG8_BAR; PG8_WAIT_L(0); PG8_MMA(0, 0, At, B0); PG8_BAR; PG8_SCHED;
            if (GA && last && has_next) {
#pragma unroll
                for (int i = 0; i < 2; ++i) { int R_, C_; stage_rc(tid * 16 + i * 8192, R_, C_); const int tb_ = ((ui + 1) & 1) * 256; cvo0[i] = toff[tb_ + R_] + (unsigned)C_ * 2u; cvo1[i] = toff[tb_ + 128 + R_] + (unsigned)C_ * 2u; } }
            PG8_LDB(B1, 0, 1); PG8_STAGE(PG8_SB(0, 0), b2, voffB);
            PG8_BAR; PG8_WAIT_L(0); PG8_MMA(0, 1, At, B1); PG8_BAR;
            PG8_LDA(At, 0, 1); PG8_STAGE(PG8_SA(0, 0), a2, cvo0);
            PG8_BAR; PG8_WAIT_L(0); PG8_MMA(1, 0, At, B0); PG8_BAR; PG8_SCHED;
            PG8_STAGE(PG8_SB(0, 1), b2 + hstep, voffB);
            PG8_WAIT_V(6); PG8_BAR; PG8_MMA(1, 1, At, B1); PG8_BAR;
            PG8_LDB(B0, 1, 0); PG8_SCHED; PG8_LDA(At, 1, 0); PG8_STAGE(PG8_SA(0, 1), a2 + ahs, cvo1);
            PG8_WAIT_L(8); PG8_BAR; PG8_WAIT_L(0); PG8_MMA(0, 0, At, B0); PG8_BAR; PG8_SCHED;
            PG8_LDB(B1, 1, 1); PG8_STAGE(PG8_SB(1, 0), b3, voffB);
            PG8_BAR; PG8_WAIT_L(0); PG8_MMA(0, 1, At, B1); PG8_BAR;
            PG8_LDA(At, 1, 1); PG8_STAGE(PG8_SA(1, 0), a3, cvo0);
            PG8_BAR; PG8_WAIT_L(0); PG8_MMA(1, 0, At, B0); PG8_BAR; PG8_SCHED;
            PG8_STAGE(PG8_SB(1, 1), b3 + hstep, voffB);
            PG8_WAIT_V(6); PG8_BAR; PG8_MMA(1, 1, At, B1); PG8_BAR;
#else
            PG8_LDB(B0, 0, 0); PG8_LDB(B1, 0, 1); PG8_SCHED; PG8_LDA(At, 0, 0); PG8_STAGE(PG8_SA(1, 1), a1 + ahs, cvo1);
            PG8_WAIT_L(0); PG8_BAR; PG8_MMA(0, 0, At, B0); PG8_MMA(0, 1, At, B1); PG8_BAR; PG8_SCHED;
            if (GA && last && has_next) {
#pragma unroll
                for (int i = 0; i < 2; ++i) { int R_, C_; stage_rc(tid * 16 + i * 8192, R_, C_); const int tb_ = ((ui + 1) & 1) * 256; cvo0[i] = toff[tb_ + R_] + (unsigned)C_ * 2u; cvo1[i] = toff[tb_ + 128 + R_] + (unsigned)C_ * 2u; } }
            PG8_LDA(At, 0, 1); PG8_STAGE(PG8_SB(0, 0), b2, voffB); PG8_STAGE(PG8_SA(0, 0), a2, cvo0); PG8_STAGE(PG8_SB(0, 1), b2 + hstep, voffB);
            PG8_WAIT_V(6); PG8_WAIT_L(0); PG8_BAR; PG8_MMA(1, 0, At, B0); PG8_MMA(1, 1, At, B1); PG8_BAR; PG8_SCHED;
            PG8_LDB(B0, 1, 0); PG8_LDB(B1, 1, 1); PG8_SCHED; PG8_LDA(At, 1, 0); PG8_STAGE(PG8_SA(0, 1), a2 + ahs, cvo1);
            PG8_WAIT_L(0); PG8_BAR; PG8_MMA(0, 0, At, B0); PG8_MMA(0, 1, At, B1); PG8_BAR; PG8_SCHED;
            PG8_LDA(At, 1, 1); PG8_STAGE(PG8_SB(1, 0), b3, voffB); PG8_STAGE(PG8_SA(1, 0), a3, cvo0); PG8_STAGE(PG8_SB(1, 1), b3 + hstep, voffB);
            PG8_WAIT_V(6); PG8_WAIT_L(0); PG8_BAR; PG8_MMA(1, 0, At, B0); PG8_MMA(1, 1, At, B1); PG8_BAR; PG8_SCHED;
#endif
        }
        if constexpr (F8) asm volatile("s_nop 15\n\ts_nop 15" : "+v"(acc[1][1][0][0]), "+v"(acc[1][1][0][1]), "+v"(acc[1][1][1][0]), "+v"(acc[1][1][1][1]), "+v"(acc[1][1][2][0]), "+v"(acc[1][1][2][1]), "+v"(acc[1][1][3][0]), "+v"(acc[1][1][3][1]) :: "memory");
        int lane_e = lane_id(); asm volatile("" : "+v"(lane_e));
        const int fr_e = lane_e & 15, fq_e = lane_e >> 4;
        {
            const int col_e = wc * 32 + 8 * fq_e;
            typename Epi::UPre up; E.upre(cur, col_e, up);
#pragma unroll
            for (int b0 = 0; b0 < 8; b0 += Epi::EB) {
                typename Epi::Pre pre[Epi::EB];
#pragma unroll
                for (int q = 0; q < Epi::EB; ++q) { const int ai = (b0 + q) >> 2, m = (b0 + q) & 3; E.pre(cur, ai * HALF + wr * 64 + m * 16 + fr_e, col_e, pre[q]); }
#pragma unroll
                for (int q = 0; q < Epi::EB; ++q) { const int ai = (b0 + q) >> 2, m = (b0 + q) & 3;
                    float lo[8], hi[8];
#pragma unroll
                    for (int n = 0; n < 2; ++n)
#pragma unroll
                        for (int j = 0; j < 4; ++j) {
                            if constexpr (I8) { lo[4 * n + j] = (float)__float_as_int(acc[ai][0][m][n][j]); hi[4 * n + j] = (float)__float_as_int(acc[ai][1][m][n][j]); }
                            else { lo[4 * n + j] = acc[ai][0][m][n][j]; hi[4 * n + j] = acc[ai][1][m][n][j]; } }
                    E.put(cur, ai * HALF + wr * 64 + m * 16 + fr_e, col_e, lo, hi, pre[q], up);
                }
                asm volatile("" ::: "memory");
            }
        }
        if (!has_next) break;
#pragma unroll
        for (int a = 0; a < 2; ++a)
#pragma unroll
            for (int b = 0; b < 2; ++b)
#pragma unroll
                for (int m = 0; m < 4; ++m)
#pragma unroll
                    for (int n = 0; n < 2; ++n) acc[a][b][m][n] = (f32x4){0.f, 0.f, 0.f, 0.f};
        cur = nxt; cA = nA; cB = nB; ++ui;
    }
    PG8_WAIT_V(0);
    if (wr == 0) PG8_BAR;
    PG8_BAR;
#undef PG8_AOFF
#undef PG8_SA
#undef PG8_SB
#undef PG8_STAGE
#undef PG8_LDA
#undef PG8_LDB
#undef PG8_MMA
#undef PG8_WAIT_V
#undef PG8_WAIT_L
#undef PG8_BAR
#undef PG8_SCHED
}

template <class Epi, class Sched>
__device__ __forceinline__ void gemm_naive(const int K, const Sched& S, const Epi& E) {
    Unit u;
    for (int i = 0; S.next(i, u); ++i) {
        const char* At = S.a_tile(u); const char* Bt = S.b_tile(u);
        for (int item = threadIdx.x; item < 4096; item += 512) {
            const int r = item & 255, c = (item >> 8) * 8;
            const bf16_t* a = (const bf16_t*)(At + S.a_row_off(u, r));
            float lo[8], hi[8];
#pragma unroll
            for (int j = 0; j < 8; ++j) { lo[j] = 0.f; hi[j] = 0.f; }
            for (int k = 0; k < K; k += 8) {
                float av[8]; unpack8(*(const u32x4*)(a + k), av);
#pragma unroll
                for (int j = 0; j < 8; ++j) { float bv[8];
                    unpack8(*(const u32x4*)((const bf16_t*)Bt + (size_t)(c + j) * K + k), bv);
#pragma unroll
                    for (int q = 0; q < 8; ++q) lo[j] += av[q] * bv[q];
                    unpack8(*(const u32x4*)((const bf16_t*)Bt + (size_t)(128 + c + j) * K + k), bv);
#pragma unroll
                    for (int q = 0; q < 8; ++q) hi[j] += av[q] * bv[q]; }
            }
            { typename Epi::UPre up; E.upre(u, c, up); typename Epi::Pre pr; E.pre(u, r, c, pr); E.put(u, r, c, lo, hi, pr, up); }
        }
    }
}
template <class Epi, class Sched>
__device__ __forceinline__ void gemm_run(LAS unsigned char* lds, const int wave_in, const int K, const Sched& S, const Epi& E) {
#if MK_NAIVE
    (void)wave_in; gemm_naive<Epi, Sched>(K, S, E);
#else
    gemm_phase<Epi, Sched>(lds, wave_in, K, S, E);
#endif
}

struct EpiIn0 {
    static constexpr int EB = 8; struct Pre { float rs; }; struct UPre {};
    bf16_t* P; bf16_t* GB; bf16_t* GY; bf16_t* XB; const float* asc;
    __device__ __forceinline__ void upre(const Unit&, int, UPre&) const {}
    __device__ __forceinline__ void pre(const Unit& u, int r, int, Pre& p) const { p.rs = I8_G1 ? asc[(size_t)u.pm * 256 + r] * W1DQ : 1.0f; }
    __device__ __forceinline__ void put(const Unit& u, int r, int c, const float (&lo_)[8], const float (&hi_)[8], const Pre& p, const UPre&) const {
        const size_t t = (size_t)u.pm * 256 + r;
        float lo[8], hi[8];
#pragma unroll
        for (int j = 0; j < 8; ++j) { lo[j] = I8_G1 ? lo_[j] * p.rs : lo_[j]; hi[j] = I8_G1 ? hi_[j] * p.rs : hi_[j]; }
        if (u.pn < 8) { float v[8];
#pragma unroll
            for (int j = 0; j < 8; ++j) v[j] = lo[j] * hi[j];
            st16((P + t * 1024 + u.pn * 128 + c), pack8(v)); }
        else if (u.pn < 12) { bf16_t* d = GB + t * 1024 + (u.pn - 8) * 256 + c; st16(d, pack8(lo)); st16((d + 128), pack8(hi)); }
        else if (u.pn < 16) { float a[8], b[8];
#pragma unroll
            for (int j = 0; j < 8; ++j) { a[j] = fgelu_tanh(lo[j]); b[j] = fgelu_tanh(hi[j]); }
            bf16_t* d = GY + t * 1024 + (u.pn - 12) * 256 + c; st16(d, pack8(a)); st16((d + 128), pack8(b)); }
        else { bf16_t* d = XB + t * 1024 + (u.pn - 16) * 256 + c; st16(d, pack8(lo)); st16((d + 128), pack8(hi)); }
    }
};
template <bool F32BASE> struct EpiRes {
    static constexpr int EB = 4;
    struct UPre { f32x4 g[4]; };
    struct Pre { u32x4 x[F32BASE ? 4 : 2]; };
    const float* base_lat; const float* base_ctx; bf16_t* XR; const float* g1;
    __device__ __forceinline__ void upre(const Unit& u, int c, UPre& up) const {
        const float* gp = g1 + (size_t)modrow_of(u.pm * 256) * MODW + u.pn * 256 + c;
        up.g[0] = *(const f32x4*)gp; up.g[1] = *(const f32x4*)(gp + 4); up.g[2] = *(const f32x4*)(gp + 128); up.g[3] = *(const f32x4*)(gp + 132);
    }
    __device__ __forceinline__ void pre(const Unit& u, int r, int c, Pre& p) const {
        const int t0 = u.pm * 256, col = u.pn * 256 + c;
        if (F32BASE) { const float* bp = t0 < NLAT ? base_lat + (size_t)(t0 + r) * D + col : base_ctx + (size_t)(t0 - NLAT + r) * D + col;
            p.x[0] = *(const u32x4*)bp; p.x[1] = *(const u32x4*)(bp + 4); p.x[2] = *(const u32x4*)(bp + 128); p.x[3] = *(const u32x4*)(bp + 132); }
        else { const bf16_t* dp = XR + (size_t)(t0 + r) * D + col; p.x[0] = *(const u32x4*)dp; p.x[1] = *(const u32x4*)(dp + 128); }
    }
    __device__ __forceinline__ void put(const Unit& u, int r, int c, const float (&lo)[8], const float (&hi)[8], const Pre& p, const UPre& up) const {
        const int t0 = u.pm * 256, col = u.pn * 256 + c;
        float xl[8], xh[8];
        if (F32BASE) {
#pragma unroll
            for (int j = 0; j < 4; ++j) { xl[j] = __uint_as_float(p.x[0][j]); xl[4 + j] = __uint_as_float(p.x[1][j]); xh[j] = __uint_as_float(p.x[2][j]); xh[4 + j] = __uint_as_float(p.x[3][j]); } }
        else { unpack8(p.x[0], xl); unpack8(p.x[1], xh); }
#pragma unroll
        for (int j = 0; j < 4; ++j) { xl[j] += up.g[0][j] * lo[j]; xl[4 + j] += up.g[1][j] * lo[4 + j]; xh[j] += up.g[2][j] * hi[j]; xh[4 + j] += up.g[3][j] * hi[4 + j]; }
        bf16_t* dp = XR + (size_t)(t0 + r) * D + col;
        st16(dp, pack8(xl)); st16((dp + 128), pack8(xh));
    }
};
struct EpiGU {
    static constexpr int EB = 8; struct Pre {}; struct UPre {};
    unsigned char* hid;
    __device__ __forceinline__ void upre(const Unit&, int, UPre&) const {}
    __device__ __forceinline__ void pre(const Unit&, int, int, Pre&) const {}
    __device__ __forceinline__ void put(const Unit& u, int r, int c, const float (&lo)[8], const float (&hi)[8], const Pre&, const UPre&) const {
        float v[8];
#pragma unroll
        for (int j = 0; j < 8; ++j) v[j] = clamp8(lo[j] * __builtin_amdgcn_rcpf(1.0f + __builtin_amdgcn_exp2f(-lo[j])) * hi[j]);
        u32x2 w; w.x = pack_fp8x4(v[0], v[1], v[2], v[3]); w.y = pack_fp8x4(v[4], v[5], v[6], v[7]);
        *(u32x2*)(hid + ((size_t)u.pm * 256 + r) * FF + u.pn * 128 + c) = w;
    }
};
struct EpiDN {
    static constexpr int EB = 8; struct Pre { int t2; float g; }; struct UPre {};
    bf16_t* Y; const int* list; const float* listg;
    __device__ __forceinline__ void upre(const Unit&, int, UPre&) const {}
    __device__ __forceinline__ void pre(const Unit& u, int r, int, Pre& p) const {
        const int pos = u.pos0 + r;
        const int t2 = list[(size_t)u.e * NTOK + pos]; p.g = listg[(size_t)u.e * NTOK + pos]; p.t2 = pos < u.cnt ? t2 : -1;
    }
    __device__ __forceinline__ void put(const Unit& u, int r, int c, const float (&lo)[8], const float (&hi)[8], const Pre& p, const UPre&) const {
        const int t2 = p.t2; const float g = p.g; if (t2 < 0) return;
        float a[8], b[8];
#if F8_Y
        const float g8 = g * Y8_SCALE;
#pragma unroll
        for (int j = 0; j < 8; ++j) { a[j] = clamp8(g8 * lo[j]); b[j] = clamp8(g8 * hi[j]); }
        unsigned char* d = (unsigned char*)Y + ((size_t)(t2 & 1) * NTOK + (t2 >> 1)) * D + u.pn * 256 + 2 * c;
        u32x4 w; w.x = pack_fp8x4(a[0], a[1], a[2], a[3]); w.y = pack_fp8x4(a[4], a[5], a[6], a[7]); w.z = pack_fp8x4(b[0], b[1], b[2], b[3]); w.w = pack_fp8x4(b[4], b[5], b[6], b[7]);
        *(u32x4*)d = w;
#else
#pragma unroll
        for (int j = 0; j < 8; ++j) { a[j] = g * lo[j]; b[j] = g * hi[j]; }
        bf16_t* d = Y + ((size_t)(t2 & 1) * NTOK + (t2 >> 1)) * D + u.pn * 256 + c;
        st16(d, pack8(a)); st16((d + 128), pack8(b));
#endif
    }
};
struct EpiQKV {
    static constexpr int EB = 2; struct Pre { f32x4 c0, c1, s0, s1; }; struct UPre {};
    bf16_t* Q; bf16_t* Kb; bf16_t* Vb; const float* ropec; const float* ropes;
    __device__ __forceinline__ void upre(const Unit&, int, UPre&) const {}
    __device__ __forceinline__ void pre(const Unit& u, int r, int c, Pre& p) const {
        { const int s = (u.pm * 256 + r) & 2047, a = (c >> 5) & 1, j0 = c & 31, pos = a ? (s & 63) : (s >> 6);
            p.c0 = *(const f32x4*)(ropec + pos * 32 + j0); p.c1 = *(const f32x4*)(ropec + pos * 32 + j0 + 4); p.s0 = *(const f32x4*)(ropes + pos * 32 + j0); p.s1 = *(const f32x4*)(ropes + pos * 32 + j0 + 4); }
    }
    __device__ __forceinline__ void put(const Unit& u, int r, int c, const float (&lo)[8], const float (&hi)[8], const Pre& p, const UPre&) const {
        const int ctx = u.e, t = u.pm * 256 + r, png = u.pn + 8 * ctx;
        int b, s; size_t kvrow;
        if (ctx) { b = t >> 8; s = t & 255; kvrow = (size_t)b * KVL + s; } else { b = t >> 11; s = t & 2047; kvrow = (size_t)b * KVL + CTXL + s; }
        if (png < 16) {
            const int head = png & 7, m = c >> 6, a = (c >> 5) & 1, j0 = c & 31;
            float ol[8], oh[8];
            if (!ctx) { const f32x4 c0 = p.c0, c1 = p.c1, s0 = p.s0, s1 = p.s1;
#pragma unroll
                for (int j = 0; j < 8; ++j) { const float cs = j < 4 ? c0[j & 3] : c1[j & 3], sn = j < 4 ? s0[j & 3] : s1[j & 3]; ol[j] = lo[j] * cs - hi[j] * sn; oh[j] = hi[j] * cs + lo[j] * sn; } }
            else {
#pragma unroll
                for (int j = 0; j < 8; ++j) { ol[j] = lo[j]; oh[j] = hi[j]; } }
#if F8_QK
            unsigned char* d = (png < 8 ? (unsigned char*)Q + (size_t)t * D : (unsigned char*)Kb + kvrow * D) + head * 256 + m * 128 + a * 64 + (j0 >> 3) * 16;
            u32x4 w; w.x = pack_fp8x4(clamp8(ol[0]), clamp8(ol[1]), clamp8(ol[2]), clamp8(ol[3])); w.y = pack_fp8x4(clamp8(ol[4]), clamp8(ol[5]), clamp8(ol[6]), clamp8(ol[7]));
            w.z = pack_fp8x4(clamp8(oh[0]), clamp8(oh[1]), clamp8(oh[2]), clamp8(oh[3])); w.w = pack_fp8x4(clamp8(oh[4]), clamp8(oh[5]), clamp8(oh[6]), clamp8(oh[7]));
            *(u32x4*)d = w;
#else
            bf16_t* d = (png < 8 ? Q + (size_t)t * D : Kb + kvrow * D) + head * 256 + m * 128 + a * 64 + j0;
            st16(d, pack8(ol)); st16((d + 32), pack8(oh));
#endif
        } else {
#if F8_PV
            unsigned char* vt = (unsigned char*)Vb + ((size_t)(b * 8 + (png - 16)) * 256 + c) * KVL + (kvrow - (size_t)b * KVL);
#pragma unroll
            for (int j = 0; j < 8; ++j) { vt[(size_t)j * KVL] = (unsigned char)pack_fp8x1(clamp8(lo[j])); vt[(size_t)(128 + j) * KVL] = (unsigned char)pack_fp8x1(clamp8(hi[j])); }
#else
            bf16_t* d = Vb + kvrow * D + (png - 16) * 256 + c; st16(d, pack8(lo)); st16((d + 128), pack8(hi));
#endif
        }
    }
};
}

__device__ __forceinline__ void scan_phase(const Frame& F, const Params& p) {
    unsigned char* ws = F.ws;
    const bf16_t* P = (const bf16_t*)(ws + WS_R1); const bf16_t* GB = P + (size_t)NTOK * 1024; const bf16_t* GY = GB + (size_t)NTOK * 1024; const bf16_t* XB = GY + (size_t)NTOK * 1024;
    bf16_t* A3 = (bf16_t*)(ws + WS_HB);
    float* HS = (float*)(ws + WS_HID);
    const int tid = F.tid, lane = F.lane, w = F.wave;
    {
        const float* cw = inptr(p, 10);
        for (int it = F.bx * 512 + tid; it < NTOK * 128; it += F.G * 512) {
            const int t = it >> 7, ch = (it & 127) * 8;
            int s, len; if (t < NLAT) { s = t & 2047; len = SEQ; } else { s = (t - NLAT) & 255; len = CTXL; }
            float pm[8], pc[8], pp[8], gb[8], o[8];
            unpack8(*(const u32x4*)(P + (size_t)t * 1024 + ch), pc);
            if (s >= 1) unpack8(*(const u32x4*)(P + (size_t)(t - 1) * 1024 + ch), pm); else {
#pragma unroll
                for (int j = 0; j < 8; ++j) pm[j] = 0.f; }
            if (s + 1 < len) unpack8(*(const u32x4*)(P + (size_t)(t + 1) * 1024 + ch), pp); else {
#pragma unroll
                for (int j = 0; j < 8; ++j) pp[j] = 0.f; }
            unpack8(*(const u32x4*)(GB + (size_t)t * 1024 + ch), gb);
#pragma unroll
            for (int j = 0; j < 8; ++j) o[j] = gb[j] * (cw[ch + j] * pm[j] + cw[1024 + ch + j] * pc[j] + cw[2048 + ch + j] * pp[j]);
            if (F8_G3) { u32x2 w8; w8.x = pack_fp8x4(clamp8(A8_SCALE * o[0]), clamp8(A8_SCALE * o[1]), clamp8(A8_SCALE * o[2]), clamp8(A8_SCALE * o[3])); w8.y = pack_fp8x4(clamp8(A8_SCALE * o[4]), clamp8(A8_SCALE * o[5]), clamp8(A8_SCALE * o[6]), clamp8(A8_SCALE * o[7]));
                *(u32x2*)((unsigned char*)A3 + (size_t)t * D + ch) = w8; }
            else *(u32x4*)(A3 + (size_t)t * D + ch) = pack8(o);
        }
    }
    LAS unsigned char* lds = F.lds;
    LAS bf16_t* Ush = (LAS bf16_t*)lds;
    LAS bf16_t* Gsh = (LAS bf16_t*)(lds + 34816);
    LAS float* Ash = (LAS float*)(lds + 69632); LAS float* Bsh = (LAS float*)(lds + 102400);
    LAS float* SA = (LAS float*)(lds + 135168); LAS float* SB = (LAS float*)(lds + 137216); LAS float* carry = (LAS float*)(lds + 139264);
    for (int unit = F.bx; unit < 256; unit += F.G) {
        const int b = unit >> 4, hd = (unit >> 1) & 7, half = unit & 1;
        const int cg = (tid & 15) * 8, chg = hd * 128 + cg;
        LAS float* cwl = (LAS float*)(lds + 139520);
        { const float* cbw = inptr(p, 11); const float* cbb = inptr(p, 12);
          __syncthreads();
          cwl[tid] = cbw[(tid >> 7) * 1024 + hd * 128 + (tid & 127)]; if (tid < 128) cwl[512 + tid] = cbb[hd * 128 + tid];
          __syncthreads(); }
        const int tb = w & 3, cbk = w >> 2, r32 = lane & 31, hi = lane >> 5;
        const int chl = cbk * 32 + r32, chglob = hd * 128 + half * 64 + chl;
        const int sch = tid & 63, chunk = tid >> 6, schglob = hd * 128 + half * 64 + sch;
        for (int dir = 0; dir < 2; ++dir) {
            const bf16_t* gw = (const bf16_t*)(ws + WS_GW) + ((size_t)((dir * 8 + hd) * 2 + half) * 128) * 128;
            __syncthreads();
#pragma unroll
            for (int it = 0; it < 4; ++it) { const int q = tid + 512 * it, row = q >> 4, pc = q & 15; *(LAS u32x4*)(Gsh + row * 136 + pc * 8) = *(const u32x4*)(gw + (size_t)row * 128 + pc * 8); }
            const float ba = inptr(p, 14)[dir * 1024 + chglob], bi = inptr(p, 16)[dir * 1024 + chglob];
            const float cl = 8.0f * log1pf(expf(-(inptr(p, 17)[dir * 1024 + chglob])));
            if (tid < 64) carry[tid] = 0.f;
            __syncthreads();
            for (int ti = 0; ti < 18; ++ti) {
                int seg_ctx, s0;
                if (ti < 2) { seg_ctx = 1; s0 = dir == 0 ? ti * 128 : (1 - ti) * 128; } else { seg_ctx = 0; s0 = dir == 0 ? (ti - 2) * 128 : (17 - ti) * 128; }
                const int len = seg_ctx ? CTXL : SEQ; const size_t row0 = seg_ctx ? (size_t)NLAT + b * CTXL : (size_t)b * SEQ;
                {
                    const int g4 = (tid >> 4) * 4;
                    u32x4 xp[7];
#pragma unroll
                    for (int r = 0; r < 7; ++r) { const int sq = s0 + g4 + r - 2; xp[r] = (u32x4){0u, 0u, 0u, 0u};
                        if (sq >= 0 && sq < len) xp[r] = *(const u32x4*)(XB + (row0 + sq) * 1024 + chg); }
                    float uacc[4][8];
                    { const f32x4 b0 = *(const LAS f32x4*)(cwl + 512 + cg), b1 = *(const LAS f32x4*)(cwl + 512 + cg + 4);
#pragma unroll
                      for (int i = 0; i < 4; ++i)
#pragma unroll
                        for (int j = 0; j < 4; ++j) { uacc[i][j] = b0[j]; uacc[i][4 + j] = b1[j]; } }
#pragma unroll
                    for (int r = 0; r < 7; ++r) { float xv[8]; unpack8(xp[r], xv);
#pragma unroll
                        for (int i = 0; i < 4; ++i) { const int q = r - i;
                            if (q >= 0 && q < 4) { const f32x4 w0 = *(const LAS f32x4*)(cwl + q * 128 + cg), w1 = *(const LAS f32x4*)(cwl + q * 128 + cg + 4);
#pragma unroll
                                for (int j = 0; j < 4; ++j) { uacc[i][j] += w0[j] * xv[j]; uacc[i][4 + j] += w1[j] * xv[4 + j]; } } } }
#pragma unroll
                    for (int i = 0; i < 4; ++i) *(LAS u32x4*)(Ush + (g4 + i) * 136 + cg) = pack8(uacc[i]);
                }
                __syncthreads();
                f32x16 ar = {}, ai = {};
#pragma unroll
                for (int ks = 0; ks < 8; ++ks) { const bf16x8 af = *(const LAS bf16x8*)(Ush + (tb * 32 + r32) * 136 + ks * 16 + hi * 8);
                    const bf16x8 br = *(const LAS bf16x8*)(Gsh + (cbk * 32 + r32) * 136 + ks * 16 + hi * 8), bi8 = *(const LAS bf16x8*)(Gsh + (64 + cbk * 32 + r32) * 136 + ks * 16 + hi * 8);
                    ar = __builtin_amdgcn_mfma_f32_32x32x16_bf16(af, br, ar, 0, 0, 0); ai = __builtin_amdgcn_mfma_f32_32x32x16_bf16(af, bi8, ai, 0, 0, 0); }
#pragma unroll
                for (int rg = 0; rg < 16; ++rg) { const int tok = tb * 32 + (rg & 3) + 8 * (rg >> 2) + 4 * hi;
                    const float rr = fsigmoid(ar[rg] + ba), ii = fsigmoid(ai[rg] + bi);
                    const float la = -cl * rr, a = __expf(la);
                    const float om = 1.0f - a * a;
                    const float uu = bf2f(Ush[tok * 136 + half * 64 + chl]);
                    Ash[tok * 64 + chl] = a; Bsh[tok * 64 + chl] = __builtin_amdgcn_sqrtf(om) * ii * uu; }
                __syncthreads();
                {
                    const int tile_id = seg_ctx ? (s0 >> 7) : 2 + (s0 >> 7);
                    float* hsp = HS + (((size_t)unit * 18 + tile_id) * 512 + tid) * 16;
                    const size_t rowc = row0 + s0 + chunk * 16;
                    f32x4 hf4[4]; unsigned short gyv[16];
                    if (dir == 1) {
#pragma unroll
                        for (int q = 0; q < 4; ++q) hf4[q] = *(const f32x4*)(hsp + 4 * q);
#pragma unroll
                        for (int i = 0; i < 16; ++i) gyv[i] = GY[(rowc + i) * 1024 + schglob];
                    }
                    float av[16], bv[16];
#pragma unroll
                    for (int i = 0; i < 16; ++i) { av[i] = Ash[(chunk * 16 + i) * 64 + sch]; bv[i] = Bsh[(chunk * 16 + i) * 64 + sch]; }
                    float Aa = 1.f, Hh = 0.f;
                    if (dir == 0) {
#pragma unroll
                        for (int i = 0; i < 16; ++i) { Hh = av[i] * Hh + bv[i]; Aa *= av[i]; } }
                    else {
#pragma unroll
                        for (int i = 15; i >= 0; --i) { Hh = av[i] * Hh + bv[i]; Aa *= av[i]; } }
                    SA[chunk * 64 + sch] = Aa; SB[chunk * 64 + sch] = Hh;
                    __syncthreads();
                    float c = carry[sch];
                    if (dir == 0) { for (int j = 0; j < chunk; ++j) c = SA[j * 64 + sch] * c + SB[j * 64 + sch]; }
                    else { for (int j = 7; j > chunk; --j) c = SA[j * 64 + sch] * c + SB[j * 64 + sch]; }
                    __syncthreads();
                    if (chunk == (dir == 0 ? 7 : 0)) carry[sch] = Aa * c + Hh;
                    float h = c;
                    if (dir == 0) {
                        float hv[16];
#pragma unroll
                        for (int i = 0; i < 16; ++i) { h = av[i] * h + bv[i]; hv[i] = h; }
#pragma unroll
                        for (int q = 0; q < 4; ++q) *(f32x4*)(hsp + 4 * q) = (f32x4){hv[4 * q], hv[4 * q + 1], hv[4 * q + 2], hv[4 * q + 3]};
                    } else {
#pragma unroll
                        for (int i = 15; i >= 0; --i) { h = av[i] * h + bv[i];
                            const float yv = bf2f(gyv[i]) * (hf4[i >> 2][i & 3] + h);
                            if (F8_G3) ((unsigned char*)A3)[(rowc + i) * D + 1024 + schglob] = (unsigned char)pack_fp8x1(clamp8(A8_SCALE * yv));
                            else A3[(rowc + i) * D + 1024 + schglob] = (bf16_t)(cvt_pk_bf16(yv, 0.f) & 0xffffu); }
                    }
                }
            }
            __syncthreads();
        }
    }
}

namespace att {
constexpr int DH = 128, NW = 8, QBLK = 32, KVBLK = 64, LDQ = 2048, LDK = 2048, LDO = 2048, KVL8 = 2304;
constexpr float SCALE = 0.088388347648318440f;
constexpr float THR = F8_PV ? 6.f : 8.f;
#ifndef ATT_SDEPTH
#define ATT_SDEPTH 1
#endif
constexpr int SDEPTH = ATT_SDEPTH;
constexpr int SHM_V = KVBLK * DH * 2, SHM_K = KVBLK * DH * 2;
constexpr int SHM_ATTN = 2 * SHM_V + 2 * SHM_K + NW * 64 * 4 + NW * 32 * 4;
#define KSWZ(row, colB) ((row) * 256 + ((colB) ^ (((row) & 7) << 4)))
#define SBAR() __builtin_amdgcn_sched_barrier(0)
__device__ __forceinline__ int crow(int r, int hi) { return (r & 3) + 8 * (r >> 2) + 4 * hi; }
__device__ __forceinline__ unsigned cvtpk(float lo, float hi) { unsigned r; asm volatile("v_cvt_pk_bf16_f32 %0, %1, %2" : "=v"(r) : "v"(lo), "v"(hi)); return r; }
__device__ __forceinline__ void partialSM(f32x16& p0, f32x16& p1, float& m_reg, float& mn, float& alpha) {
  constexpr float C = SCALE * 1.4426950408889634f;
  float pmax = p0[0]; for (int r = 1; r < 16; ++r) pmax = fmaxf(pmax, p0[r]); for (int r = 0; r < 16; ++r) pmax = fmaxf(pmax, p1[r]);
  { auto rr = __builtin_amdgcn_permlane32_swap(__float_as_uint(pmax), __float_as_uint(pmax), false, false);
    pmax = fmaxf(__uint_as_float(rr[0]), __uint_as_float(rr[1])); }
  if (__builtin_expect(__all(pmax - m_reg <= THR / SCALE), 1)) { mn = m_reg; alpha = 1.f; }
  else { mn = fmaxf(m_reg, pmax); alpha = __builtin_amdgcn_exp2f((m_reg - mn) * C); m_reg = mn; }
  float mnC = -mn * C;
  for (int r = 0; r < 16; ++r) p0[r] = fmaf(p0[r], C, mnC); for (int r = 0; r < 16; ++r) p1[r] = fmaf(p1[r], C, mnC);
  for (int r = 0; r < 16; ++r) p0[r] = __builtin_amdgcn_exp2f(p0[r]);
}
__device__ __forceinline__ void finishSM(f32x16& p0, f32x16& p1, float alpha, float& l_reg, bf16x8& pa0, bf16x8& pa1, bf16x8& pa2, bf16x8& pa3) {
  for (int r = 0; r < 16; ++r) p1[r] = __builtin_amdgcn_exp2f(p1[r]);
  float ps = 0; for (int r = 0; r < 16; ++r) ps += p0[r]; for (int r = 0; r < 16; ++r) ps += p1[r];
  { auto rr = __builtin_amdgcn_permlane32_swap(__float_as_uint(ps), __float_as_uint(ps), false, false);
    ps = __uint_as_float(rr[0]) + __uint_as_float(rr[1]); }
  l_reg = l_reg * alpha + ps;
#define PK4(P, BASE, OUT) do { unsigned a0 = cvtpk(P[BASE + 0], P[BASE + 1]), a1 = cvtpk(P[BASE + 2], P[BASE + 3]);   \
    unsigned b0 = cvtpk(P[BASE + 4], P[BASE + 5]), b1 = cvtpk(P[BASE + 6], P[BASE + 7]);                              \
    auto r0 = __builtin_amdgcn_permlane32_swap(a0, b0, false, false); auto r1 = __builtin_amdgcn_permlane32_swap(a1, b1, false, false); \
    u32x4 w = {r0[0], r1[0], r0[1], r1[1]}; OUT = *reinterpret_cast<bf16x8*>(&w); } while (0)
  PK4(p0, 0, pa0); PK4(p0, 8, pa1); PK4(p1, 0, pa2); PK4(p1, 8, pa3);
#undef PK4
}
__device__ __forceinline__ void qkt(f32x16& p0, f32x16& p1, const bf16_t* Ks, const bf16x8* qr, int r32, int hi) {
  p0 = f32x16{}; p1 = f32x16{};
  for (int d0 = 0; d0 < 8; ++d0) { int cb = (d0 * 16 + hi * 8) * 2;
    bf16x8 b0 = *reinterpret_cast<const bf16x8*>((const char*)Ks + KSWZ(r32, cb));
    bf16x8 b1 = *reinterpret_cast<const bf16x8*>((const char*)Ks + KSWZ(32 + r32, cb));
    p0 = __builtin_amdgcn_mfma_f32_32x32x16_bf16(b0, qr[d0], p0, 0, 0, 0);
    p1 = __builtin_amdgcn_mfma_f32_32x32x16_bf16(b1, qr[d0], p1, 0, 0, 0); }
}
__device__ __forceinline__ int v_st(int k, int c) { const int kk = (k & ~0xC) | ((k & 4) << 1) | ((k & 8) >> 1); return ((kk >> 3) * 4 + (c >> 5)) * 512 + ((kk & 7) * 32 + (c & 31)) * 2; }
__device__ __forceinline__ int v_rd_base(int lane) { return ((lane & 3) << 3) | (((lane >> 2) & 3) << 6) | (((lane >> 4) & 1) << 5) | (((lane >> 5) & 1) << 8); }
constexpr int v_rd_off(int d0, int ks, int half) { return d0 * 512 + ks * 4096 + half * 2048; }
template <int OFF> __device__ __forceinline__ s16x4 tr_read(int vb) {
  s16x4 r; asm volatile("ds_read_b64_tr_b16 %0, %1 offset:%2" : "=&v"(r) : "v"(vb), "i"(OFF) : "memory"); return r;
}
template <int D0> __device__ __forceinline__ void pv_one(f32x16& od, int vb, bf16x8 pa0, bf16x8 pa1, bf16x8 pa2, bf16x8 pa3) {
  const s16x4 l0 = tr_read<v_rd_off(D0, 0, 0)>(vb), h0 = tr_read<v_rd_off(D0, 0, 1)>(vb), l1 = tr_read<v_rd_off(D0, 1, 0)>(vb), h1 = tr_read<v_rd_off(D0, 1, 1)>(vb);
  const s16x4 l2 = tr_read<v_rd_off(D0, 2, 0)>(vb), h2 = tr_read<v_rd_off(D0, 2, 1)>(vb), l3 = tr_read<v_rd_off(D0, 3, 0)>(vb), h3 = tr_read<v_rd_off(D0, 3, 1)>(vb);
  asm volatile("s_waitcnt lgkmcnt(0)" ::: "memory"); SBAR();
#define PK(L, H) (bf16x8){L[0], L[1], L[2], L[3], H[0], H[1], H[2], H[3]}
  od = __builtin_amdgcn_mfma_f32_32x32x16_bf16(pa0, PK(l0, h0), od, 0, 0, 0);
  od = __builtin_amdgcn_mfma_f32_32x32x16_bf16(pa1, PK(l1, h1), od, 0, 0, 0);
  od = __builtin_amdgcn_mfma_f32_32x32x16_bf16(pa2, PK(l2, h2), od, 0, 0, 0);
  od = __builtin_amdgcn_mfma_f32_32x32x16_bf16(pa3, PK(l3, h3), od, 0, 0, 0);
#undef PK
}
__device__ __forceinline__ void pv_d0(f32x16* o, int vb, bf16x8 pa0, bf16x8 pa1, bf16x8 pa2, bf16x8 pa3) {
  pv_one<0>(o[0], vb, pa0, pa1, pa2, pa3); pv_one<1>(o[1], vb, pa0, pa1, pa2, pa3); pv_one<2>(o[2], vb, pa0, pa1, pa2, pa3); pv_one<3>(o[3], vb, pa0, pa1, pa2, pa3);
}
__device__ __forceinline__ void attn_pass(const bf16_t* __restrict__ Qb, const bf16_t* __restrict__ Kh, const bf16_t* __restrict__ Vh, bf16_t* __restrict__ Ob,
                                          float* __restrict__ scr, const int wave_in, const int pass, const float lam, const float onem, const float* __restrict__ subg, int seq, char* lds) {
  const int tid = tid_rebuild(wave_in), wid = wave_in;
  const int lane = tid & 63, r32 = lane & 31, hi = lane >> 5;
  bf16_t* V_lds = (bf16_t*)lds; bf16_t* K_lds = (bf16_t*)(lds + 2 * SHM_V);
  float* wsl = (float*)(lds + 2 * SHM_V + 2 * SHM_K) + wid * 64; float* li_l = wsl; float* al_l = wsl + 32;
  float* rq = (float*)(lds + 2 * SHM_V + 2 * SHM_K + NW * 64 * 4) + wid * 32;
  float m_reg = -1e30f, l_reg = 0; f32x16 o[4] = {}; bf16x8 qr[8];
  const bf16_t* Qw = Qb + (long)(wid * QBLK + r32) * LDQ + hi * 8;
#pragma unroll
  for (int d0 = 0; d0 < 8; ++d0) qr[d0] = *reinterpret_cast<const bf16x8*>(Qw + d0 * 16);
  const int sr = tid >> 4, sc = (tid & 15) * 8, vst0 = v_st(sr, sc), vst1 = v_st(32 + sr, sc);
  const int vb0 = (int)(uintptr_t)V_lds + v_rd_base(lane);
  struct { bf16x8 vs0, vs1, ks0, ks1; } sr_[SDEPTH];
#define SLOAD(i, k0) do { sr_[i].vs0 = *reinterpret_cast<const bf16x8*>(&Vh[(long)((k0) + sr) * LDK + sc]); sr_[i].vs1 = *reinterpret_cast<const bf16x8*>(&Vh[(long)((k0) + 32 + sr) * LDK + sc]); \
    sr_[i].ks0 = *reinterpret_cast<const bf16x8*>(&Kh[(long)((k0) + sr) * LDK + sc]); sr_[i].ks1 = *reinterpret_cast<const bf16x8*>(&Kh[(long)((k0) + 32 + sr) * LDK + sc]); } while (0)
#define SWRITE(b, i) do { *(bf16x8*)((char*)V_lds + (b) * SHM_V + vst0) = sr_[i].vs0;          \
    *(bf16x8*)((char*)V_lds + (b) * SHM_V + vst1) = sr_[i].vs1; int kc = sc * 2;               \
    *(bf16x8*)((char*)K_lds + (b) * SHM_K + KSWZ(sr, kc)) = sr_[i].ks0;                       \
    *(bf16x8*)((char*)K_lds + (b) * SHM_K + KSWZ(32 + sr, kc)) = sr_[i].ks1; } while (0)
#define SWAIT() do { if constexpr (SDEPTH == 2) asm volatile("s_waitcnt vmcnt(4)" ::: "memory"); else asm volatile("s_waitcnt vmcnt(0)" ::: "memory"); } while (0)
#define RESC(a) do { if (__any((a) < 1.f)) { if (hi == 0) al_l[r32] = (a); asm volatile("s_waitcnt lgkmcnt(0)" ::: "memory"); \
    for (int d = 0; d < 4; ++d) for (int r = 0; r < 16; ++r) o[d][r] *= al_l[crow(r, hi)]; } } while (0)
  f32x16 pA0, pA1, pB0, pB1; float mnA, mnB, alA, alB; bf16x8 pa0, pa1, pa2, pa3; const int NT = seq / KVBLK;
  constexpr int SE = 0, SO = SDEPTH - 1;
  SLOAD(SE, 0); asm volatile("s_waitcnt vmcnt(0)" ::: "memory"); SWRITE(0, SE); __syncthreads();
  qkt(pA0, pA1, K_lds, qr, r32, hi); partialSM(pA0, pA1, m_reg, mnA, alA);
  SLOAD(SO, KVBLK); if constexpr (SDEPTH == 2) { if (2 < NT) SLOAD(SE, 2 * KVBLK); }
  SWAIT(); SWRITE(1, SO); __syncthreads();
  for (int j = 1; j + 1 < NT; j += 2) {
    SBAR(); qkt(pB0, pB1, (bf16_t*)((char*)K_lds + SHM_K), qr, r32, hi);
    finishSM(pA0, pA1, alA, l_reg, pa0, pa1, pa2, pa3); SBAR();
    SLOAD(SO, (j + SDEPTH) * KVBLK); SBAR();
    pv_d0(o, vb0, pa0, pa1, pa2, pa3); partialSM(pB0, pB1, m_reg, mnB, alB);
    __syncthreads(); SWAIT(); SWRITE(0, SE);
    RESC(alB); __syncthreads();
    SBAR(); qkt(pA0, pA1, K_lds, qr, r32, hi);
    finishSM(pB0, pB1, alB, l_reg, pa0, pa1, pa2, pa3); SBAR();
    if (SDEPTH == 1 || j + 3 < NT) SLOAD(SE, (j + 1 + SDEPTH) * KVBLK); SBAR();
    pv_d0(o, vb0 + (int)SHM_V, pa0, pa1, pa2, pa3); partialSM(pA0, pA1, m_reg, mnA, alA);
    __syncthreads(); SWAIT(); SWRITE(1, SO);
    RESC(alA); __syncthreads();
  }
  SBAR(); qkt(pB0, pB1, (bf16_t*)((char*)K_lds + SHM_K), qr, r32, hi);
  finishSM(pA0, pA1, alA, l_reg, pa0, pa1, pa2, pa3); SBAR();
  pv_d0(o, vb0, pa0, pa1, pa2, pa3); partialSM(pB0, pB1, m_reg, mnB, alB);
  __syncthreads(); RESC(alB);
  finishSM(pB0, pB1, alB, l_reg, pa0, pa1, pa2, pa3); SBAR();
  pv_d0(o, vb0 + (int)SHM_V, pa0, pa1, pa2, pa3);
  if (hi == 0) li_l[r32] = l_reg; asm volatile("s_waitcnt lgkmcnt(0)" ::: "memory");
  float rli[16];
#pragma unroll
  for (int r = 0; r < 16; ++r) rli[r] = __builtin_amdgcn_rcpf(li_l[crow(r, hi)]);
  typedef __attribute__((address_space(1))) float gf32; typedef __attribute__((address_space(1))) bf16_t gbf16;
  gf32* scr_l = (gf32*)scr; gbf16* Ob_l = (gbf16*)Ob; int lane_e = lane; asm volatile("" : "+s"(scr_l), "+s"(Ob_l), "+v"(lane_e));
  const int r32e = lane_e & 31, hie = lane_e >> 5;
  gf32* S = scr_l + (size_t)wid * 4096 + lane_e + (pass >= 2 ? 32768 : 0);
#define ATT_BASE(ptr, d0) gf32* ptr = S + (d0) * 1024; asm volatile("" : "+v"(ptr))
  if (pass == 0 || pass == 2) {
#pragma unroll
    for (int d0 = 0; d0 < 4; ++d0) { ATT_BASE(dst, d0);
#pragma unroll
      for (int r = 0; r < 16; ++r) dst[r * 64] = o[d0][r] * rli[r]; }
  } else {
    float q[16];
#pragma unroll
    for (int d0 = 0; d0 < 4; ++d0) { ATT_BASE(srcp, d0);
#pragma unroll
      for (int r = 0; r < 16; ++r) { const float c = srcp[r * 64] - lam * o[d0][r] * rli[r]; o[d0][r] = c; q[r] = d0 == 0 ? c * c : q[r] + c * c; }
      asm volatile("" ::: "memory"); }
#pragma unroll
    for (int r = 0; r < 16; ++r) {
#pragma unroll
      for (int off = 1; off <= 16; off <<= 1) q[r] += shfl_xor_l(q[r], off, lane_e); }
    if (pass == 1) {
#pragma unroll
      for (int d0 = 0; d0 < 4; ++d0) { ATT_BASE(dst, d0);
#pragma unroll
        for (int r = 0; r < 16; ++r) dst[r * 64] = o[d0][r]; }
      if (r32e == 0) {
#pragma unroll
        for (int r = 0; r < 16; ++r) rq[hie * 16 + r] = q[r]; }
    } else {
      if (r32e == 0) {
#pragma unroll
        for (int r = 0; r < 16; ++r) rq[hie * 16 + r] = onem * __builtin_amdgcn_rsqf((q[r] + rq[hie * 16 + r]) * (1.0f / 256.0f) + EPS); }
      asm volatile("s_waitcnt lgkmcnt(0)" ::: "memory");
      float g0[4], g1[4];
#pragma unroll
      for (int d0 = 0; d0 < 4; ++d0) { g0[d0] = subg[d0 * 32 + r32e]; g1[d0] = subg[128 + d0 * 32 + r32e]; }
      S = scr_l + (size_t)wid * 4096 + lane_e;
      ATT_BASE(s0a, 0); ATT_BASE(s0b, 1); ATT_BASE(s0c, 2); ATT_BASE(s0d, 3);
#pragma unroll
      for (int r = 0; r < 16; ++r) { const float rs = rq[hie * 16 + r];
        gbf16* orow = Ob_l + (long)(wid * QBLK + crow(r, hie)) * LDO + r32e; asm volatile("" : "+v"(orow) :: "memory");
        const float h0 = s0a[r * 64], h1 = s0b[r * 64], h2 = s0c[r * 64], h3 = s0d[r * 64];
        orow[128 +  0] = (bf16_t)(cvtpk(o[0][r] * rs * g1[0], 0.f) & 0xffffu); orow[128 + 32] = (bf16_t)(cvtpk(o[1][r] * rs * g1[1], 0.f) & 0xffffu);
        orow[128 + 64] = (bf16_t)(cvtpk(o[2][r] * rs * g1[2], 0.f) & 0xffffu); orow[128 + 96] = (bf16_t)(cvtpk(o[3][r] * rs * g1[3], 0.f) & 0xffffu);
        orow[ 0] = (bf16_t)(cvtpk(h0 * rs * g0[0], 0.f) & 0xffffu); orow[32] = (bf16_t)(cvtpk(h1 * rs * g0[1], 0.f) & 0xffffu);
        orow[64] = (bf16_t)(cvtpk(h2 * rs * g0[2], 0.f) & 0xffffu); orow[96] = (bf16_t)(cvtpk(h3 * rs * g0[3], 0.f) & 0xffffu); }
    }
  }
#undef ATT_BASE
#undef SLOAD
#undef SWRITE
#undef SWAIT
#undef RESC
}

constexpr int A2_V = 0, A2_K = 65536, A2_PEX = 98304, A2_MEX = 114688, A2_LEX = 115712, A2_RQ = 117760, A2_LDS = 118784;
#define A2_TR4(D0, l0, h0, l1, h1) const s16x4 l0 = tr_read<v_rd_off(D0, 0, 0)>(vbk), h0 = tr_read<v_rd_off(D0, 0, 1)>(vbk), l1 = tr_read<v_rd_off(D0, 1, 0)>(vbk), h1 = tr_read<v_rd_off(D0, 1, 1)>(vbk)
#define A2_PK(L, H) (bf16x8){L[0], L[1], L[2], L[3], H[0], H[1], H[2], H[3]}
#define A2_MM(od, l0, h0, l1, h1) do { od = __builtin_amdgcn_mfma_f32_32x32x16_bf16(pa, A2_PK(l0, h0), od, 0, 0, 0); od = __builtin_amdgcn_mfma_f32_32x32x16_bf16(pb, A2_PK(l1, h1), od, 0, 0, 0); } while (0)
__device__ __forceinline__ void pv_half(f32x16* o, int vb, int kh, bf16x8 pa, bf16x8 pb) {
  const int vbk = vb + kh * 8192;
  A2_TR4(0, a0, b0, a1, b1); A2_TR4(1, c0, d0, c1, d1);
  asm volatile("s_waitcnt lgkmcnt(4)" ::: "memory"); SBAR(); A2_MM(o[0], a0, b0, a1, b1); SBAR();
  A2_TR4(2, e0, f0, e1, f1);
  asm volatile("s_waitcnt lgkmcnt(4)" ::: "memory"); SBAR(); A2_MM(o[1], c0, d0, c1, d1); SBAR();
  A2_TR4(3, g0, h0, g1, h1);
  asm volatile("s_waitcnt lgkmcnt(4)" ::: "memory"); SBAR(); A2_MM(o[2], e0, f0, e1, f1); SBAR();
  asm volatile("s_waitcnt lgkmcnt(0)" ::: "memory"); SBAR(); A2_MM(o[3], g0, h0, g1, h1);
}
#undef A2_TR4
#undef A2_PK
#undef A2_MM
__device__ __forceinline__ void attn_pass2(const bf16_t* __restrict__ Qb, const bf16_t* __restrict__ Kh, const bf16_t* __restrict__ Vh, bf16_t* __restrict__ Ob,
                                           float* __restrict__ scr, const int wave_in, const int pass, const float lam, const float onem, const float* __restrict__ subg, int seq, char* lds) {
  constexpr float C = SCALE * 1.4426950408889634f;
  const int tid = tid_rebuild(wave_in), wid = wave_in;
  const int lane = tid & 63, r32 = lane & 31, hi = lane >> 5, pair = wid >> 1, rho = wid & 1;
  char* V_lds = lds + A2_V; char* K_lds = lds + A2_K;
  char* pex_own = lds + A2_PEX + wid * 2048; char* pex_par = lds + A2_PEX + (wid ^ 1) * 2048;
  float* mex_own = (float*)(lds + A2_MEX) + wid * 32; float* mex_par = (float*)(lds + A2_MEX) + (wid ^ 1) * 32;
  float* lex = (float*)(lds + A2_LEX) + wid * 64; float* lex_par = (float*)(lds + A2_LEX) + (wid ^ 1) * 64; float* al_l = lex + 32;
  float* rq = (float*)(lds + A2_RQ) + wid * 32; float* rq_par = (float*)(lds + A2_RQ) + (wid ^ 1) * 32;
  float m_reg = -1e30f, l_reg = 0; f32x16 o[4] = {};
#if F8_QK
  pg8::i32x8v q8[2];
  { const unsigned char* Q8w = (const unsigned char*)Qb + (long)(pair * QBLK + r32) * LDQ + hi * 32;
#pragma unroll
    for (int st = 0; st < 2; ++st) q8[st] = pg8::cat8(*reinterpret_cast<const bf16x8*>(Q8w + st * 64), *reinterpret_cast<const bf16x8*>(Q8w + st * 64 + 16)); }
  const int krow8 = tid >> 3, kch8 = tid & 7;
#define K8OFF(row, ch) ((row) * 128 + ((((ch)) ^ (((row) >> 1) & 7)) << 4))
#else
  bf16x8 qr[8];
  const bf16_t* Qw = Qb + (long)(pair * QBLK + r32) * LDQ + hi * 8;
#pragma unroll
  for (int d0 = 0; d0 < 8; ++d0) qr[d0] = *reinterpret_cast<const bf16x8*>(Qw + d0 * 16);
#endif
  const int sr = tid >> 4, sc = (tid & 15) * 8, vst0 = v_st(sr, sc), vst1 = v_st(32 + sr, sc);
  const int vrb = (int)(uintptr_t)V_lds + v_rd_base(lane) + rho * 16384;
  struct Stg { bf16x8 ks0, ks1, v00, v10, v01, v11; } sA, sB;
#if F8_QK
#define SLOADK(T, k0) T.ks0 = *reinterpret_cast<const bf16x8*>((const unsigned char*)Kh + (long)((k0) + krow8) * LDK + kch8 * 16)
#if F8_PV
#define SLN "3"
#else
#define SLN "5"
#endif
#else
#define SLOADK(T, k0) T.ks0 = *reinterpret_cast<const bf16x8*>(&Kh[(long)((k0) + sr) * LDK + sc]); T.ks1 = *reinterpret_cast<const bf16x8*>(&Kh[(long)((k0) + 32 + sr) * LDK + sc])
#define SLN "6"
#endif
#if F8_PV
  const int vrow0 = tid >> 2, vch = tid & 3;
#define V8OFF(row, ch) ((row) * 64 + ((((ch)) ^ (((row) >> 2) & 3)) << 4))
#define SLOAD2(T, k0) do { SLOADK(T, k0); \
    T.v00 = *reinterpret_cast<const bf16x8*>((const unsigned char*)Vh + (long)vrow0 * KVL8 + (k0) + vch * 16); T.v10 = *reinterpret_cast<const bf16x8*>((const unsigned char*)Vh + (long)(128 + vrow0) * KVL8 + (k0) + vch * 16); } while (0)
#else
#define SLOAD2(T, k0) do { SLOADK(T, k0); \
    T.v00 = *reinterpret_cast<const bf16x8*>(&Vh[(long)((k0) + sr) * LDK + sc]); T.v10 = *reinterpret_cast<const bf16x8*>(&Vh[(long)((k0) + 32 + sr) * LDK + sc]); \
    T.v01 = *reinterpret_cast<const bf16x8*>(&Vh[(long)((k0) + sr) * LDK + 128 + sc]); T.v11 = *reinterpret_cast<const bf16x8*>(&Vh[(long)((k0) + 32 + sr) * LDK + 128 + sc]); } while (0)
#endif
#if F8_QK
#define SWRITE_K(T, b) do { *(bf16x8*)(K_lds + (b) * 16384 + K8OFF(krow8, kch8)) = T.ks0; } while (0)
#else
#define SWRITE_K(T, b) do { const int kc_ = sc * 2; *(bf16x8*)(K_lds + (b) * 16384 + KSWZ(sr, kc_)) = T.ks0; *(bf16x8*)(K_lds + (b) * 16384 + KSWZ(32 + sr, kc_)) = T.ks1; } while (0)
#endif
#if F8_PV
#define SWRITE_V(T, b) do { *(bf16x8*)(V_lds + (b) * 16384 + V8OFF(vrow0, vch)) = T.v00; *(bf16x8*)(V_lds + (b) * 16384 + V8OFF(128 + vrow0, vch)) = T.v10; } while (0)
#define PUB8(P, alpha, pown) do { \
    float ps_ = 0.f; _Pragma("unroll") for (int r = 0; r < 16; ++r) ps_ += P[r]; \
    { auto rr_ = __builtin_amdgcn_permlane32_swap(__float_as_uint(ps_), __float_as_uint(ps_), false, false); ps_ = __uint_as_float(rr_[0]) + __uint_as_float(rr_[1]); } \
    l_reg = l_reg * (alpha) + ps_; \
    { const unsigned d0_ = pack_fp8x4(P[0], P[1], P[2], P[3]), d1_ = pack_fp8x4(P[4], P[5], P[6], P[7]), d2_ = pack_fp8x4(P[8], P[9], P[10], P[11]), d3_ = pack_fp8x4(P[12], P[13], P[14], P[15]); \
      auto r0 = __builtin_amdgcn_permlane32_swap(d0_, d0_, false, false); auto r1 = __builtin_amdgcn_permlane32_swap(d1_, d1_, false, false); \
      auto r2 = __builtin_amdgcn_permlane32_swap(d2_, d2_, false, false); auto r3 = __builtin_amdgcn_permlane32_swap(d3_, d3_, false, false); \
      pown = (pg8::i32x8v){(int)r0[0], (int)r0[1], (int)r1[0], (int)r1[1], (int)r2[0], (int)r2[1], (int)r3[0], (int)r3[1]}; \
      if (hi == 0) { *(u32x4*)(pex_own + r32 * 16) = (u32x4){r0[0], r0[1], r1[0], r1[1]}; *(u32x4*)(pex_own + 512 + r32 * 16) = (u32x4){r2[0], r2[1], r3[0], r3[1]}; } } } while (0)
#define PV8(b, pown) do { const u32x4 qa_ = *(const u32x4*)(pex_par + r32 * 16), qb_ = *(const u32x4*)(pex_par + 512 + r32 * 16); \
    const pg8::i32x8v ppar_ = {(int)qa_[0], (int)qa_[1], (int)qa_[2], (int)qa_[3], (int)qb_[0], (int)qb_[1], (int)qb_[2], (int)qb_[3]}; \
    pg8::i32x8v pA_; _Pragma("unroll") for (int e = 0; e < 8; ++e) pA_[e] = (hi == rho) ? pown[e] : ppar_[e]; \
    _Pragma("unroll") for (int d0 = 0; d0 < 4; ++d0) { const int vr_ = 128 * rho + 32 * d0 + r32; \
      const pg8::i32x8v vf_ = pg8::cat8(*reinterpret_cast<const bf16x8*>(V_lds + (b) * 16384 + V8OFF(vr_, 2 * hi)), *reinterpret_cast<const bf16x8*>(V_lds + (b) * 16384 + V8OFF(vr_, 2 * hi + 1))); \
      o[d0] = __builtin_amdgcn_mfma_scale_f32_32x32x64_f8f6f4(pA_, vf_, o[d0], 0, 0, 0, 0x7f7f7f7f, 0, 0x7f7f7f7f); } } while (0)
#else
#define SWRITE_V(T, b) do { *(bf16x8*)(V_lds + (b) * 32768 + vst0) = T.v00; *(bf16x8*)(V_lds + (b) * 32768 + vst1) = T.v10; \
    *(bf16x8*)(V_lds + (b) * 32768 + 16384 + vst0) = T.v01; *(bf16x8*)(V_lds + (b) * 32768 + 16384 + vst1) = T.v11; } while (0)
#endif
#if F8_QK
#define KFRAG8(b, st) pg8::cat8(*reinterpret_cast<const bf16x8*>(K_lds + (b) * 16384 + K8OFF(32 * rho + r32, 4 * (st) + 2 * hi)), *reinterpret_cast<const bf16x8*>(K_lds + (b) * 16384 + K8OFF(32 * rho + r32, 4 * (st) + 2 * hi + 1)))
#define MFMA8(kf, st, Pin) __builtin_amdgcn_mfma_scale_f32_32x32x64_f8f6f4(kf, q8[st], Pin, 0, 0, 0, 0x7f7f7f7f, 0, 0x7f7f7f7f)
#define QKT2(P, b) do { const pg8::i32x8v k0_ = KFRAG8(b, 0), k1_ = KFRAG8(b, 1); P = MFMA8(k0_, 0, f32x16{}); P = MFMA8(k1_, 1, P); } while (0)
#define QKT2X(P, b, PP, mref) do { const float mnC_ = -(mref) * C; const pg8::i32x8v k0_ = KFRAG8(b, 0), k1_ = KFRAG8(b, 1); \
    SBAR(); _Pragma("unroll") for (int r = 0; r < 8; ++r) PP[r] = __builtin_amdgcn_exp2f(fmaf(PP[r], C, mnC_)); SBAR(); \
    P = MFMA8(k0_, 0, f32x16{}); SBAR(); \
    _Pragma("unroll") for (int r = 8; r < 16; ++r) PP[r] = __builtin_amdgcn_exp2f(fmaf(PP[r], C, mnC_)); SBAR(); \
    P = MFMA8(k1_, 1, P); SBAR(); } while (0)
#else
#define QKT2(P, b) do { P = f32x16{}; _Pragma("unroll") for (int d0 = 0; d0 < 8; ++d0) { const int cb_ = (d0 * 16 + hi * 8) * 2; \
    const bf16x8 kf_ = *reinterpret_cast<const bf16x8*>(K_lds + (b) * 16384 + KSWZ(32 * rho + r32, cb_)); P = __builtin_amdgcn_mfma_f32_32x32x16_bf16(kf_, qr[d0], P, 0, 0, 0); } } while (0)
#define KFRAG2(b, d0) (*reinterpret_cast<const bf16x8*>(K_lds + (b) * 16384 + KSWZ(32 * rho + r32, ((d0) * 16 + hi * 8) * 2)))
#define QKT2X(P, b, PP, mref) do { const float mnC_ = -(mref) * C; bf16x8 kfa_ = KFRAG2(b, 0), kfb_ = KFRAG2(b, 1); P = f32x16{}; \
    _Pragma("unroll") for (int d0 = 0; d0 < 8; d0 += 2) { \
      SBAR(); PP[2 * d0] = __builtin_amdgcn_exp2f(fmaf(PP[2 * d0], C, mnC_)); PP[2 * d0 + 1] = __builtin_amdgcn_exp2f(fmaf(PP[2 * d0 + 1], C, mnC_)); SBAR(); \
      P = __builtin_amdgcn_mfma_f32_32x32x16_bf16(kfa_, qr[d0], P, 0, 0, 0); SBAR(); if (d0 + 2 < 8) kfa_ = KFRAG2(b, d0 + 2); \
      SBAR(); PP[2 * d0 + 2] = __builtin_amdgcn_exp2f(fmaf(PP[2 * d0 + 2], C, mnC_)); PP[2 * d0 + 3] = __builtin_amdgcn_exp2f(fmaf(PP[2 * d0 + 3], C, mnC_)); SBAR(); \
      P = __builtin_amdgcn_mfma_f32_32x32x16_bf16(kfb_, qr[d0 + 1], P, 0, 0, 0); SBAR(); if (d0 + 3 < 8) kfb_ = KFRAG2(b, d0 + 3); } } while (0)
#endif
#define ROWMAX2(P, out) do { float pm_ = P[0]; _Pragma("unroll") for (int r = 1; r < 16; ++r) pm_ = fmaxf(pm_, P[r]); \
    auto rr_ = __builtin_amdgcn_permlane32_swap(__float_as_uint(pm_), __float_as_uint(pm_), false, false); out = fmaxf(__uint_as_float(rr_[0]), __uint_as_float(rr_[1])); } while (0)
#define DECIDE2(pm_own, alpha_out) do { const float pj_ = fmaxf(pm_own, mex_par[r32]); \
    if (__builtin_expect(__all(pj_ - m_reg <= THR / SCALE), 1)) { alpha_out = 1.f; } else { const float mn_ = fmaxf(m_reg, pj_); alpha_out = __builtin_amdgcn_exp2f((m_reg - mn_) * C); m_reg = mn_; } } while (0)
#define EXP2PUB(P, mref, alpha, pa_a, pa_b) do { const float mnC_ = -(mref) * C; _Pragma("unroll") for (int r = 0; r < 16; ++r) P[r] = __builtin_amdgcn_exp2f(fmaf(P[r], C, mnC_)); \
    float ps_ = 0.f; _Pragma("unroll") for (int r = 0; r < 16; ++r) ps_ += P[r]; \
    { auto rr_ = __builtin_amdgcn_permlane32_swap(__float_as_uint(ps_), __float_as_uint(ps_), false, false); ps_ = __uint_as_float(rr_[0]) + __uint_as_float(rr_[1]); } \
    l_reg = l_reg * (alpha) + ps_; \
    { unsigned a0 = cvtpk(P[0], P[1]), a1 = cvtpk(P[2], P[3]), b0 = cvtpk(P[4], P[5]), b1 = cvtpk(P[6], P[7]); \
      auto r0 = __builtin_amdgcn_permlane32_swap(a0, b0, false, false); auto r1 = __builtin_amdgcn_permlane32_swap(a1, b1, false, false); u32x4 w_ = {r0[0], r1[0], r0[1], r1[1]}; pa_a = *reinterpret_cast<bf16x8*>(&w_); } \
    { unsigned a0 = cvtpk(P[8], P[9]), a1 = cvtpk(P[10], P[11]), b0 = cvtpk(P[12], P[13]), b1 = cvtpk(P[14], P[15]); \
      auto r0 = __builtin_amdgcn_permlane32_swap(a0, b0, false, false); auto r1 = __builtin_amdgcn_permlane32_swap(a1, b1, false, false); u32x4 w_ = {r0[0], r1[0], r0[1], r1[1]}; pa_b = *reinterpret_cast<bf16x8*>(&w_); } \
    *(bf16x8*)(pex_own + lane * 16) = pa_a; *(bf16x8*)(pex_own + 1024 + lane * 16) = pa_b; } while (0)
#define PUB2(P, alpha, pa_a, pa_b) do { \
    float ps_ = 0.f; _Pragma("unroll") for (int r = 0; r < 16; ++r) ps_ += P[r]; \
    { auto rr_ = __builtin_amdgcn_permlane32_swap(__float_as_uint(ps_), __float_as_uint(ps_), false, false); ps_ = __uint_as_float(rr_[0]) + __uint_as_float(rr_[1]); } \
    l_reg = l_reg * (alpha) + ps_; \
    { unsigned a0 = cvtpk(P[0], P[1]), a1 = cvtpk(P[2], P[3]), b0 = cvtpk(P[4], P[5]), b1 = cvtpk(P[6], P[7]); \
      auto r0 = __builtin_amdgcn_permlane32_swap(a0, b0, false, false); auto r1 = __builtin_amdgcn_permlane32_swap(a1, b1, false, false); u32x4 w_ = {r0[0], r1[0], r0[1], r1[1]}; pa_a = *reinterpret_cast<bf16x8*>(&w_); } \
    { unsigned a0 = cvtpk(P[8], P[9]), a1 = cvtpk(P[10], P[11]), b0 = cvtpk(P[12], P[13]), b1 = cvtpk(P[14], P[15]); \
      auto r0 = __builtin_amdgcn_permlane32_swap(a0, b0, false, false); auto r1 = __builtin_amdgcn_permlane32_swap(a1, b1, false, false); u32x4 w_ = {r0[0], r1[0], r0[1], r1[1]}; pa_b = *reinterpret_cast<bf16x8*>(&w_); } \
    *(bf16x8*)(pex_own + lane * 16) = pa_a; *(bf16x8*)(pex_own + 1024 + lane * 16) = pa_b; } while (0)
#define RESC2(a) do { if (__any((a) < 1.f)) { if (hi == 0) al_l[r32] = (a); asm volatile("s_waitcnt lgkmcnt(0)" ::: "memory"); \
    for (int d = 0; d < 4; ++d) for (int r = 0; r < 16; ++r) o[d][r] *= al_l[crow(r, hi)]; } } while (0)
  const int NT = seq / KVBLK;
  f32x16 pc, pp; float pm_c, al_p = 1.f, al_c; bf16x8 pa_a, pa_b; pg8::i32x8v pown;
  SLOAD2(sA, 0); asm volatile("s_waitcnt vmcnt(0)" ::: "memory"); SWRITE_K(sA, 0); SWRITE_V(sA, 0);
  SLOAD2(sB, KVBLK); if (2 < NT) SLOAD2(sA, 2 * KVBLK);
  __syncthreads();
  QKT2(pp, 0); ROWMAX2(pp, pm_c); if (hi == 0) mex_own[r32] = pm_c;
  if (2 < NT) asm volatile("s_waitcnt vmcnt(" SLN ")" ::: "memory"); else asm volatile("s_waitcnt vmcnt(0)" ::: "memory");
  SWRITE_K(sB, 1); SWRITE_V(sB, 1); __syncthreads();
  DECIDE2(pm_c, al_p);
  float mref_p = m_reg;
  __syncthreads();
#if F8_PV
#define ATT2_MID(j, L) PUB8(pp, al_p, pown); SBAR(); \
    if ((j) + 2 < NT) SLOAD2(L, ((j) + 2) * KVBLK); SBAR(); \
    ROWMAX2(pc, pm_c); if (hi == 0) mex_own[r32] = pm_c; \
    __syncthreads(); \
    PV8(bp, pown);
#else
#define ATT2_MID(j, L) PUB2(pp, al_p, pa_a, pa_b); SBAR(); \
    if ((j) + 2 < NT) SLOAD2(L, ((j) + 2) * KVBLK); SBAR(); \
    pv_half(o, vrb + bp * 32768, rho, pa_a, pa_b); \
    ROWMAX2(pc, pm_c); if (hi == 0) mex_own[r32] = pm_c; \
    __syncthreads(); \
    { const bf16x8 qa = *(const bf16x8*)(pex_par + lane * 16), qb = *(const bf16x8*)(pex_par + 1024 + lane * 16); \
      pv_half(o, vrb + bp * 32768, rho ^ 1, qa, qb); }
#endif
#define ATT2_ITER(j, W, L) do { const int bj = (j) & 1, bp = bj ^ 1; \
    SBAR(); QKT2X(pc, bj, pp, mref_p); \
    ATT2_MID(j, L) \
    DECIDE2(pm_c, al_c); \
    if ((j) + 1 < NT) { if ((j) + 2 < NT) asm volatile("s_waitcnt vmcnt(" SLN ")" ::: "memory"); else asm volatile("s_waitcnt vmcnt(0)" ::: "memory"); SWRITE_K(W, bp); } \
    RESC2(al_c); \
    __syncthreads(); \
    if ((j) + 1 < NT) SWRITE_V(W, bp); \
    pp = pc; mref_p = m_reg; al_p = al_c; } while (0)
#pragma unroll 1
  for (int j = 1; j + 1 < NT; j += 2) { ATT2_ITER(j, sA, sB); ATT2_ITER(j + 1, sB, sA); }
  ATT2_ITER(NT - 1, sA, sB);
#undef ATT2_ITER
#undef ATT2_MID
  { const int bp = (NT - 1) & 1;
#if F8_PV
    { const float mnC_ = -mref_p * C;
#pragma unroll
      for (int r = 0; r < 16; ++r) pp[r] = __builtin_amdgcn_exp2f(fmaf(pp[r], C, mnC_)); }
    PUB8(pp, al_p, pown); SBAR();
    __syncthreads();
    PV8(bp, pown);
#else
    EXP2PUB(pp, mref_p, al_p, pa_a, pa_b); SBAR();
    pv_half(o, vrb + bp * 32768, rho, pa_a, pa_b);
    __syncthreads();
    { const bf16x8 qa = *(const bf16x8*)(pex_par + lane * 16), qb = *(const bf16x8*)(pex_par + 1024 + lane * 16);
      pv_half(o, vrb + bp * 32768, rho ^ 1, qa, qb); }
#endif
  }
  typedef __attribute__((address_space(1))) float gf32; typedef __attribute__((address_space(1))) bf16_t gbf16;
  gf32* scr_l = (gf32*)scr; gbf16* Ob_l = (gbf16*)Ob; int lane_e = lane; asm volatile("" : "+s"(scr_l), "+s"(Ob_l), "+v"(lane_e));
  const int r32e = lane_e & 31, hie = lane_e >> 5;
  if (hie == 0) lex[r32e] = l_reg;
  __syncthreads();
  float rli[16];
#pragma unroll
  for (int r = 0; r < 16; ++r) rli[r] = __builtin_amdgcn_rcpf(lex[crow(r, hie)] + lex_par[crow(r, hie)]);
  gf32* S = scr_l + (size_t)wid * 4096 + lane_e;
#define ATT_BASE(ptr, d0) gf32* ptr = S + (d0) * 1024; asm volatile("" : "+v"(ptr))
  if (pass == 0) {
#pragma unroll
    for (int d0 = 0; d0 < 4; ++d0) { ATT_BASE(dst, d0);
#pragma unroll
      for (int r = 0; r < 16; ++r) dst[r * 64] = o[d0][r] * rli[r]; }
  } else {
    float q[16];
    const float lam_e = *(const float*)(lds + LX_MISC + 256);
#pragma unroll
    for (int d0 = 0; d0 < 4; ++d0) { ATT_BASE(srcp, d0);
#pragma unroll
      for (int r = 0; r < 16; ++r) { const float c = srcp[r * 64] - lam_e * o[d0][r] * rli[r]; o[d0][r] = c; q[r] = d0 == 0 ? c * c : q[r] + c * c; }
      asm volatile("" ::: "memory"); }
#pragma unroll
    for (int r = 0; r < 16; ++r) {
#pragma unroll
      for (int off = 1; off <= 16; off <<= 1) q[r] += shfl_xor_l(q[r], off, lane_e); }
    if (r32e == 0) {
#pragma unroll
      for (int r = 0; r < 16; ++r) rq[hie * 16 + r] = q[r]; }
    __syncthreads();
    float g1[4];
#pragma unroll
    for (int d0 = 0; d0 < 4; ++d0) g1[d0] = subg[rho * 128 + d0 * 32 + r32e];
#pragma unroll
    for (int r = 0; r < 16; ++r) { const float rs = onem * __builtin_amdgcn_rsqf((rq[hie * 16 + r] + rq_par[hie * 16 + r]) * (1.0f / 256.0f) + EPS);
#if F8_WO
      typedef __attribute__((address_space(1))) unsigned char gu8;
      gu8* orow = (gu8*)Ob_l + (long)(pair * QBLK + crow(r, hie)) * LDO + rho * 128 + r32e; asm volatile("" : "+v"(orow) :: "memory");
      const float rs8 = rs * A8_SCALE;
      orow[ 0] = (unsigned char)pack_fp8x1(clamp8(o[0][r] * rs8 * g1[0])); orow[32] = (unsigned char)pack_fp8x1(clamp8(o[1][r] * rs8 * g1[1]));
      orow[64] = (unsigned char)pack_fp8x1(clamp8(o[2][r] * rs8 * g1[2])); orow[96] = (unsigned char)pack_fp8x1(clamp8(o[3][r] * rs8 * g1[3])); }
#else
      gbf16* orow = Ob_l + (long)(pair * QBLK + crow(r, hie)) * LDO + rho * 128 + r32e; asm volatile("" : "+v"(orow) :: "memory");
      orow[ 0] = (bf16_t)(cvtpk(o[0][r] * rs * g1[0], 0.f) & 0xffffu); orow[32] = (bf16_t)(cvtpk(o[1][r] * rs * g1[1], 0.f) & 0xffffu);
      orow[64] = (bf16_t)(cvtpk(o[2][r] * rs * g1[2], 0.f) & 0xffffu); orow[96] = (bf16_t)(cvtpk(o[3][r] * rs * g1[3], 0.f) & 0xffffu); }
#endif
  }
#undef ATT_BASE
#undef SLOAD2
#undef SWRITE_K
#undef SWRITE_V
#undef QKT2
#undef ROWMAX2
#undef DECIDE2
#undef EXP2PUB
#undef PUB2
#undef QKT2X
#undef KFRAG2
#undef RESC2
}
}

__device__ __forceinline__ void attn_phase(const Frame& F, const Params& p) {
    unsigned char* ws = F.ws;
    const bf16_t* Q = (const bf16_t*)(ws + WS_HID); const bf16_t* Kb = (const bf16_t*)(ws + WS_R1); const bf16_t* Vb = Kb + (size_t)NB * KVL * D;
    bf16_t* O = (bf16_t*)(ws + WS_HB);
    float* scr = (float*)(ws + WS_ATTSCR) + (size_t)F.bx * 65536;
    const float* q1 = inptr(p, 20); const float* k1 = inptr(p, 21); const float* q2 = inptr(p, 22); const float* k2 = inptr(p, 23); const float* subg = inptr(p, 24);
    float d1 = q1[F.lane] * k1[F.lane] + q1[64 + F.lane] * k1[64 + F.lane];
    float d2 = q2[F.lane] * k2[F.lane] + q2[64 + F.lane] * k2[64 + F.lane];
#pragma unroll
    for (int o = 32; o >= 1; o >>= 1) { d1 += shfl_xor_l(d1, o, F.lane); d2 += shfl_xor_l(d2, o, F.lane); }
    const float lam_init = 0.8f - 0.6f * 0.7408182206817179f;
    const float lam = expf(d1) - expf(d2) + lam_init, onem = 1.0f - lam_init;
    if (F.tid == 0) *(LAS float*)(F.lds + LX_MISC + 256) = lam;
    const int vcu = (F.G % 8 == 0) ? (F.bx % 8) * (F.G / 8) + F.bx / 8 : F.bx;
#if MK_ATT2
#pragma unroll 1
    for (int U = vcu; U < NB * 8 * 16; U += F.G) {
        const int bh = U >> 4, b = bh >> 3, h = bh & 7, qb = U & 15;
#if F8_QK
        const bf16_t* Qb = (const bf16_t*)((const unsigned char*)Q + ((size_t)b * SEQ + qb * 128) * D + h * 256);
        const bf16_t* Kh = (const bf16_t*)((const unsigned char*)Kb + (size_t)b * KVL * D + h * 256);
#else
        const bf16_t* Qb = Q + ((size_t)b * SEQ + qb * 128) * D + h * 256;
        const bf16_t* Kh = Kb + (size_t)b * KVL * D + h * 256;
#endif
#if F8_PV
        const bf16_t* Vh = (const bf16_t*)((const unsigned char*)Vb + ((size_t)(b * 8 + h) * 256) * KVL);
#else
        const bf16_t* Vh = Vb + (size_t)b * KVL * D + h * 256;
#endif
        bf16_t* Ob = F8_WO ? (bf16_t*)((unsigned char*)O + ((size_t)b * SEQ + qb * 128) * D + h * 256) : O + ((size_t)b * SEQ + qb * 128) * D + h * 256;
#pragma unroll 1
        for (int pass = 0; pass < 2; ++pass) {
            __syncthreads();
#if F8_QK
            att::attn_pass2((const bf16_t*)((const unsigned char*)Qb + pass * 128), (const bf16_t*)((const unsigned char*)Kh + pass * 128), Vh, Ob, scr, F.wave, pass, lam, onem, subg, KVL, (char*)F.lds);
#else
            att::attn_pass2(Qb + pass * 128, Kh + pass * 128, Vh, Ob, scr, F.wave, pass, lam, onem, subg, KVL, (char*)F.lds);
#endif
        }
    }
#else
#pragma unroll 1
    for (int U = vcu; U < NB * 8 * 8; U += F.G) {
        const int bh = U >> 3, b = bh >> 3, h = bh & 7, qb = U & 7;
        const bf16_t* Qb = Q + ((size_t)b * SEQ + qb * 256) * D + h * 256;
        const bf16_t* Kh = Kb + (size_t)b * KVL * D + h * 256;
        const bf16_t* Vh = Vb + (size_t)b * KVL * D + h * 256;
        bf16_t* Ob = O + ((size_t)b * SEQ + qb * 256) * D + h * 256;
#pragma unroll 1
        for (int pass = 0; pass < 4; ++pass) {
            const int m = pass & 1, vh = pass >> 1;
            __syncthreads();
            att::attn_pass(Qb + m * 128, Kh + m * 128, Vh + vh * 128, Ob, scr, F.wave, pass, lam, onem, subg, KVL, (char*)F.lds);
        }
    }
#endif
    __syncthreads();
}

__device__ __forceinline__ void moe_setup(const Frame& F, int l) {
    LAS int* pre = (LAS int*)(F.lds + LX_PRE); LAS int* cnt = (LAS int*)(F.lds + LX_CNT);
    __syncthreads();
    if (F.tid == 0) {
        const unsigned* cntg = (const unsigned*)(F.ws + WS_CTL) + CW_CNT + l * 64; int acc = 0;
        for (int e = 0; e < 16; ++e) { const int c = (int)__hip_atomic_load(cntg + e, __ATOMIC_RELAXED, __HIP_MEMORY_SCOPE_AGENT); cnt[e] = c; pre[e] = acc; acc += (c + 255) >> 8; }
        pre[16] = acc;
    }
    __syncthreads();
}

__global__ void __launch_bounds__(512, 2) mega_fwd(Params p) {
    extern __shared__ __attribute__((aligned(16))) unsigned char lds_raw[];
    Frame F;
    F.lds = (LAS unsigned char*)lds_raw;
    F.wave = __builtin_amdgcn_readfirstlane(threadIdx.x >> 6); refresh(F);
    F.G = gridDim.x; F.bx = blockIdx.x; F.ws = p.ws; F.out = p.out;
    if (F.tid < 4) ((LAS unsigned*)(F.lds + LX_BAR))[F.tid] = 0u;
    __syncthreads();
    XcdBarrier bar = xcd_barrier_post((unsigned*)(p.ws + WS_CTL) + CW_BAR, (volatile LAS unsigned*)(F.lds + LX_BAR));
    const int lo = p.ph_lo, hi = p.ph_hi, stop = p.stop;
#define PHR(v) ({ int _v = (v); asm volatile("" : "+s"(_v)); _v; })
    unsigned char* ws = p.ws;
    const float* mod = (const float*)(ws + WS_MOD);
    int ph = 0;
#ifndef MK_MASK
#define MK_MASK 0x1ffff
#endif
#define RUN(k) (((MK_MASK >> (k)) & 1) && PHR(lo) <= (k) && (k) < PHR(hi) && ((k) < PHR(stop) || (k) == NPHASE - 1))
#define REP(k) for (int rep_ = 0; rep_ <= ((MK_REPEAT >> (k)) & 1); ++rep_)
#define SEAM(k) do { if ((k) + 1 < PHR(hi)) xcd_barrier(bar); } while (0)

    if (RUN(0)) { refresh(F); REP(0) p0_prologue(F, p); } if (PHR(lo) <= 0 && 0 < PHR(hi)) SEAM(0);
    if (false) { refresh(F); p1_modreduce(F, p);
#ifdef MK_XBAR
        for (int xb_ = 0; xb_ < MK_XBAR; ++xb_) xcd_barrier(bar);
#endif
    }
    if (RUN(2)) { refresh(F); REP(2) row_phase<0>(F, p, 0, 0); } if (PHR(lo) <= 2 && 2 < PHR(hi)) SEAM(2);
    ph = 3;
    if (RUN(3)) { refresh(F);
        pg8::DenseSched<F8_G1 != 0, I8_G1 != 0> S{(const char*)(ws + WS_HB), (const char*)(ws + WS_W1), NTOK / 256, 5120 / 256, 2048, F.G, F.bx, 0x79797979, 0x7f7f7f7f};
        bf16_t* g1o = (bf16_t*)(ws + WS_R1);
        pg8::EpiIn0 E{g1o, g1o + (size_t)NTOK * 1024, g1o + (size_t)2 * NTOK * 1024, g1o + (size_t)3 * NTOK * 1024, (const float*)(ws + WS_ASC)};
        REP(3) pg8::gemm_run(F.lds, F.wave, 2048, S, E);
#if MK_TAILFILL
        refresh(F); tail_fill(F, p, 0, 0, false);
#endif
    } if (PHR(lo) <= 3 && 3 < PHR(hi)) SEAM(3);
    if (RUN(4)) { refresh(F); REP(4) scan_phase(F, p); } if (PHR(lo) <= 4 && 4 < PHR(hi)) SEAM(4);
    if (RUN(5)) { refresh(F);
        pg8::DenseSched<F8_G3 != 0> S{(const char*)(ws + WS_HB), (const char*)(ws + WS_W3), NTOK / 256, 2048 / 256, 2048, F.G, F.bx, 0x79797979, 0x7c7c7c7c};
        pg8::EpiRes<true> E{inptr(p, 0), inptr(p, 2), (bf16_t*)(ws + WS_XR), mod + 4096};
        REP(5) pg8::gemm_run(F.lds, F.wave, 2048, S, E);
#if MK_TAILFILL
        refresh(F); tail_fill(F, p, 0, 1, false);
#endif
    } if (PHR(lo) <= 5 && 5 < PHR(hi)) SEAM(5);
    for (int l = 0; l < 2; ++l) {
        const int base = l == 0 ? 6 : 13;
        if (l == 1) {
            if (RUN(10)) { refresh(F);
                pg8::EpiQKV E{(bf16_t*)(ws + WS_HID), (bf16_t*)(ws + WS_R1), (bf16_t*)(ws + WS_R1) + (size_t)NB * KVL * D, (const float*)(ws + WS_ROPE), (const float*)(ws + WS_ROPE) + 2048};
                pg8::QkvSched<F8_QKV != 0> S{(const char*)(ws + WS_HB), (const char*)(ws + WS_WQKV), 2048, F.G, F.bx, 0x79797979, 0x7f7f7f7f};
                REP(10) pg8::gemm_run(F.lds, F.wave, 2048, S, E);
            } if (PHR(lo) <= 10 && 10 < PHR(hi)) SEAM(10);
            if (RUN(11)) { refresh(F); REP(11) attn_phase(F, p); } if (PHR(lo) <= 11 && 11 < PHR(hi)) SEAM(11);
            if (RUN(12)) { refresh(F);
                pg8::DenseSched<F8_WO != 0> S{(const char*)(ws + WS_HB), (const char*)(ws + WS_WO), NLAT / 256, 2048 / 256, 2048, F.G, F.bx, 0x79797979, 0x7c7c7c7c};
                pg8::EpiRes<false> E{nullptr, nullptr, (bf16_t*)(ws + WS_XR), mod + (size_t)17 * MODW + 4096};
                pg8::gemm_run(F.lds, F.wave, 2048, S, E);
            } if (PHR(lo) <= 12 && 12 < PHR(hi)) SEAM(12);
        }
        if (RUN(base)) { refresh(F);
#if MK_TAILFILL
            tail_fill(F, p, l, 0, true); refresh(F);
#endif
            row_phase<1>(F, p, l, 0); } if (PHR(lo) <= base && base < PHR(hi)) SEAM(base);
        if (RUN(base + 1)) { refresh(F);
            moe_setup(F, l);
            pg8::MoeSched<true> S{(const char*)(ws + WS_HB), (const char*)(ws + WS_WGU) + (size_t)l * WGU_LSTRIDE, (size_t)2048 * 2048,
                                  (const LAS int*)(F.lds + LX_PRE), (const LAS int*)(F.lds + LX_CNT), (const int*)(ws + WS_LIST), 2048, F.G, F.bx, 0x79797979, 0x7f7f7f7f};
            pg8::EpiGU E{ws + WS_HID};
            REP(7) pg8::gemm_run(F.lds, F.wave, 2048, S, E);
#if MK_TAILFILL
            if (l == 0) { refresh(F); tail_fill(F, p, 1, 2, false); }
#endif
        } if (PHR(lo) <= base + 1 && base + 1 < PHR(hi)) SEAM(base + 1);
        if (RUN(base + 2)) { refresh(F);
            moe_setup(F, l);
            pg8::MoeSched<false> S{(const char*)(ws + WS_HID), (const char*)(ws + WS_WD) + (size_t)l * WD_LSTRIDE, (size_t)2048 * 1024,
                                   (const LAS int*)(F.lds + LX_PRE), (const LAS int*)(F.lds + LX_CNT), (const int*)(ws + WS_LIST), 1024, F.G, F.bx, 0x79797979, 0x7d7d7d7d};
            pg8::EpiDN E{(bf16_t*)(ws + WS_R1), (const int*)(ws + WS_LIST), (const float*)(ws + WS_LISTG)};
            REP(8) pg8::gemm_run(F.lds, F.wave, 1024, S, E);
#if MK_TAILFILL
#endif
        } if (PHR(lo) <= base + 2 && base + 2 < PHR(hi)) SEAM(base + 2);
        if (l == 0) { if (RUN(9)) { refresh(F); row_phase<2>(F, p, 0, 0); } if (PHR(lo) <= 9 && 9 < PHR(hi)) SEAM(9); }
        else { if (RUN(16)) { refresh(F); REP(16) row_phase<3>(F, p, 1, p.fin_mode); } }
    }
    (void)ph;
#undef RUN
#undef SEAM
}

extern "C" void kernel_launch(void* const* d_in, const int* in_sizes, int n_in, void* d_out, int out_size, void* d_ws, size_t ws_size, hipStream_t stream) {
    static int grid = 0;
    if (grid == 0) {
        if (n_in != 31 || in_sizes[0] != NLAT * D || out_size != NLAT * D || ws_size < WS_END) {
            fprintf(stderr, "kernel_launch: shape/workspace mismatch: n_in %d in0 %d out %d ws %zu (need %zu)\n", n_in, n_in > 0 ? in_sizes[0] : -1, out_size, ws_size, (size_t)WS_END); grid = -1; return; }
        int dev = 0, cus = 0, per_cu = 0;
        if (hipGetDevice(&dev) != hipSuccess || hipDeviceGetAttribute(&cus, hipDeviceAttributeMultiprocessorCount, dev) != hipSuccess) { grid = -1; return; }
        if (hipFuncSetAttribute((const void*)mega_fwd, hipFuncAttributeMaxDynamicSharedMemorySize, LDS_BYTES) != hipSuccess) { fprintf(stderr, "kernel_launch: hipFuncSetAttribute failed\n"); grid = -1; return; }
        if (hipOccupancyMaxActiveBlocksPerMultiprocessor(&per_cu, (const void*)mega_fwd, 512, LDS_BYTES) != hipSuccess || per_cu < 1)
            fprintf(stderr, "kernel_launch: occupancy query reports %d blocks per CU\n", per_cu);
        (void)hipGetLastError();
        grid = cus;
    }
    if (grid < 0) return;
    (void)hipMemsetAsync((char*)d_ws + WS_CTL, 0, CTL_BYTES, stream);
    Params p{};
    for (int i = 0; i < 31; ++i) p.in[i] = (const float*)d_in[i];
    p.out = (float*)d_out; p.ws = (unsigned char*)d_ws;
    p.stop = MK_STOP;
    p.fin_mode = (MK_STOP >= NPHASE - 1) ? 0 : (MK_STOP <= 5 ? 2 : 1);
#if MK_LAUNCHES
    for (int ph = 0; ph < NPHASE; ++ph) {
        if (!(ph < MK_STOP || ph == NPHASE - 1)) continue;
        p.ph_lo = ph; p.ph_hi = ph + 1;
        hipLaunchKernelGGL(mega_fwd, dim3(grid), dim3(512), LDS_BYTES, stream, p);
    }
#else
    p.ph_lo = 0; p.ph_hi = NPHASE;
    hipLaunchKernelGGL(mega_fwd, dim3(grid), dim3(512), LDS_BYTES, stream, p);
#endif
    const hipError_t le = hipPeekAtLastError();
    if (le != hipSuccess) fprintf(stderr, "kernel_launch: launch failed: %s\n", hipGetErrorName(le));
}
```

```cpp
#include <hip/hip_runtime.h>
#include <cstdio>
#include <cstdint>

#ifndef F8_G1
#define F8_G1 0
#endif
#ifndef I8_G1
#define I8_G1 1
#endif
#ifndef F8_G3
#define F8_G3 0
#endif
#ifndef F8_QKV
#define F8_QKV 1
#endif
#ifndef F8_WO
#define F8_WO 1
#endif
#ifndef F8_QK
#define F8_QK 1
#endif
#ifndef F8_PV
#define F8_PV 1
#endif
#ifndef F8_Y
#define F8_Y 1
#endif
#ifndef MK_8PHASE
#define MK_8PHASE 0
#endif
#ifndef MK_TAILFILL
#define MK_TAILFILL 1
#endif
#ifndef MK_LAUNCHES
#define MK_LAUNCHES 0
#endif
#ifndef MK_STOP
#define MK_STOP 99
#endif
#ifndef MK_REPEAT
#define MK_REPEAT 0
#endif
#ifndef MK_STAGGER
#define MK_STAGGER 0
#endif
#ifndef MK_P0PIPE
#define MK_P0PIPE 0
#endif
#ifndef MK_ATT2
#define MK_ATT2 1
#endif
#ifndef MK_NAIVE
#define MK_NAIVE 0
#endif

#define LAS __attribute__((address_space(3)))
typedef unsigned short bf16_t;
typedef short bf16x8 __attribute__((ext_vector_type(8)));
typedef short s16x4 __attribute__((ext_vector_type(4)));
typedef float f32x4 __attribute__((ext_vector_type(4)));
typedef float f32x2 __attribute__((ext_vector_type(2)));
typedef float f32x16 __attribute__((ext_vector_type(16)));
typedef unsigned u32x4 __attribute__((ext_vector_type(4)));
typedef unsigned u32x2 __attribute__((ext_vector_type(2)));

constexpr int D = 2048, NB = 16, SEQ = 2048, CTXL = 256;
constexpr int NLAT = NB * SEQ, NCTX = NB * CTXL, NTOK = NLAT + NCTX;
constexpr int NE = 16, FF = 1024, KVL = CTXL + SEQ;
constexpr int MODW = 6 * D;
constexpr float EPS = 1e-6f;
constexpr int NPHASE = 17;

constexpr size_t al256(size_t x) { return (x + 255) & ~(size_t)255; }
constexpr size_t WS_CTL = 0, CTL_BYTES = 65536;
constexpr int CW_BAR = 0, CW_CNT = 4096, CW_FILL = 6144, CW_DONE = 6160;
constexpr size_t WS_MOD = WS_CTL + CTL_BYTES;
constexpr size_t WS_ROPE = WS_MOD + al256((size_t)2 * 17 * MODW * 4);
constexpr size_t WS_GW = WS_ROPE + 16384;
constexpr size_t WS_W1 = WS_GW + (size_t)2 * 8 * 2 * 128 * 128 * 2;
constexpr size_t WS_W3 = WS_W1 + (size_t)5120 * 2048 * 2;
constexpr size_t WS_WQKV = WS_W3 + (size_t)2048 * 2048 * 2;
constexpr size_t WS_WO = WS_WQKV + (size_t)6144 * 2048 * 2;
constexpr size_t WS_WGU = WS_WO + (size_t)2048 * 2048 * 2;
constexpr size_t WS_WD = WS_WGU + (size_t)32 * 2048 * 2048 * 2;
constexpr size_t WS_XR = WS_WD + (size_t)32 * 2048 * 1024 * 2;
constexpr size_t WS_HB = WS_XR + (size_t)NTOK * D * 2;
constexpr size_t WS_R1 = WS_HB + (size_t)NTOK * D * 2;
constexpr size_t R1_BYTES = (size_t)2 * NTOK * D * 2;
constexpr size_t WS_HID = WS_R1 + R1_BYTES;
constexpr size_t HID_ROWS = 77824, HID_BYTES = HID_ROWS * FF * 2;
constexpr size_t WS_LIST = WS_HID + HID_BYTES;
constexpr size_t WS_LISTG = WS_LIST + (size_t)NE * NTOK * 4;
constexpr size_t WS_ASC = WS_LISTG + (size_t)NE * NTOK * 4;
constexpr size_t WS_END = WS_ASC + (size_t)NTOK * 4;
constexpr size_t WS_ATTSCR = WS_WGU;
static_assert((size_t)NTOK * 1024 * 4 <= HID_BYTES && (size_t)NLAT * D * 2 <= HID_BYTES && (size_t)2 * 16 * 17 * MODW * 4 <= HID_BYTES, "HID aliases");
static_assert((size_t)256 * 65536 * 4 <= (size_t)16 * 2048 * 2048 * 2, "attention scratch fits in layer-0 expert weights");

constexpr int STAGE_BYTES = 131072;
constexpr int LX = 147456;
constexpr int LX_BAR = LX + 0;
constexpr int LX_PRE = LX + 64;
constexpr int LX_CNT = LX + 192;
constexpr int LX_LCNT = LX + 256;
constexpr int LX_LBASE = LX + 320;
constexpr int LX_REC = LX + 512;
constexpr int LX_RECG = LX + 2048;
constexpr int LX_MISC = LX + 4096;
constexpr int LDS_BYTES = LX + 8192;
constexpr int ROWCH = 192;

struct Params { const float* in[31]; float* out; unsigned char* ws; int ph_lo, ph_hi; int fin_mode, stop; };

__device__ __forceinline__ const float* inptr(const Params& p, int i) { asm volatile("" : "+s"(i)); return p.in[i]; }
__device__ __forceinline__ unsigned cvt_pk_bf16(float lo, float hi) { unsigned r; asm("v_cvt_pk_bf16_f32 %0, %1, %2" : "=v"(r) : "v"(lo), "v"(hi)); return r; }
__device__ __forceinline__ float bflo(unsigned w) { return __uint_as_float(w << 16); }
__device__ __forceinline__ float bfhi(unsigned w) { return __uint_as_float(w & 0xffff0000u); }
__device__ __forceinline__ float bf2f(bf16_t b) { return __uint_as_float(((unsigned)b) << 16); }
__device__ __forceinline__ float fsigmoid(float x) { return __builtin_amdgcn_rcpf(1.0f + __expf(-x)); }
__device__ __forceinline__ float fsilu(float x) { return x * fsigmoid(x); }
__device__ __forceinline__ float fgelu_tanh(float x) { const float z = 1.5957691216057308f * (x + 0.044715f * x * x * x); return x * fsigmoid(z); }
__device__ __forceinline__ float clamp8(float x) { return __builtin_fminf(__builtin_fmaxf(x, -448.0f), 448.0f); }
__device__ __forceinline__ unsigned pack_fp8x1(float a) { return (unsigned)__builtin_amdgcn_cvt_pk_fp8_f32(a, 0.f, 0, false) & 0xffu; }
__device__ __forceinline__ unsigned pack_i8x4(float a, float b, float c, float d) {
    const int qa = (int)__builtin_rintf(__builtin_fminf(__builtin_fmaxf(a, -127.f), 127.f)), qb = (int)__builtin_rintf(__builtin_fminf(__builtin_fmaxf(b, -127.f), 127.f));
    const int qc = (int)__builtin_rintf(__builtin_fminf(__builtin_fmaxf(c, -127.f), 127.f)), qd = (int)__builtin_rintf(__builtin_fminf(__builtin_fmaxf(d, -127.f), 127.f));
    return (unsigned)(qa & 255) | ((unsigned)(qb & 255) << 8) | ((unsigned)(qc & 255) << 16) | ((unsigned)qd << 24);
}
__device__ __forceinline__ unsigned pack_fp8x4(float a, float b, float c, float d) { int w = __builtin_amdgcn_cvt_pk_fp8_f32(a, b, 0, false); w = __builtin_amdgcn_cvt_pk_fp8_f32(c, d, w, true); return (unsigned)w; }
__device__ __forceinline__ u32x4 pack8(const float (&v)[8]) { u32x4 w; w.x = cvt_pk_bf16(v[0], v[1]); w.y = cvt_pk_bf16(v[2], v[3]); w.z = cvt_pk_bf16(v[4], v[5]); w.w = cvt_pk_bf16(v[6], v[7]); return w; }
__device__ __forceinline__ void unpack8(const u32x4 w, float (&v)[8]) { v[0] = bflo(w.x); v[1] = bfhi(w.x); v[2] = bflo(w.y); v[3] = bfhi(w.y); v[4] = bflo(w.z); v[5] = bfhi(w.z); v[6] = bflo(w.w); v[7] = bfhi(w.w); }

#define XB_TMO      128
#define XB_XCNT(j)  (256  + 64 * (j))
#define XB_XSUB(j)  (1280 + 64 * (j))
#define XB_XGEN(j)  (2304 + 64 * (j))
#define XB_TOP      3328
#define XB_TOPGEN   3392
#define XCD_BAR_WORDS 3456
#define XB_SPIN_CAP (1u << 18)
__device__ __forceinline__ unsigned xb_ld(unsigned* p)              { return __hip_atomic_load(p, __ATOMIC_RELAXED, __HIP_MEMORY_SCOPE_AGENT); }
__device__ __forceinline__ unsigned xb_add(unsigned* p, unsigned v) { return __hip_atomic_fetch_add(p, v, __ATOMIC_RELAXED, __HIP_MEMORY_SCOPE_AGENT); }
__device__ __forceinline__ unsigned xb_xcc_id() { return (unsigned)__builtin_amdgcn_s_getreg((3 << 11) | 20) & 0xFu; }
#define XB_SPIN(cond, bar) do { unsigned _sp = 0; while (cond) { __builtin_amdgcn_s_sleep(1); \
    if ((++_sp & 255u) == 0u) { if (xb_ld(&(bar)[XB_TMO])) break; if (_sp > XB_SPIN_CAP) { atomicAdd(&(bar)[XB_TMO], 1u); break; } } } } while (0)
struct XcdBarrier { unsigned* bar; unsigned x; volatile LAS unsigned* st; };
__device__ __forceinline__ XcdBarrier xcd_barrier_post(unsigned* bar, volatile LAS unsigned* st) {
    XcdBarrier b; b.bar = bar; b.x = xb_xcc_id(); b.st = st;
    if (threadIdx.x == 0) (void)xb_add(&bar[XB_XCNT(b.x)], 1u);
    return b;
}
__device__ __forceinline__ void xcd_barrier_complete(unsigned* bar, unsigned x, unsigned& nloc, unsigned& nx) {
    const unsigned G = gridDim.x * gridDim.y * gridDim.z;
    unsigned sum, cnt, mine, sp = 0u;
    for (;;) {
        sum = 0u; cnt = 0u; mine = 0u;
#pragma unroll
        for (unsigned j = 0; j < 16; ++j) { const unsigned c = xb_ld(&bar[XB_XCNT(j)]); sum += c; cnt += (c > 0u) ? 1u : 0u; mine = (j == x) ? c : mine; }
        if (sum == G) break;
        __builtin_amdgcn_s_sleep(1);
        if ((++sp & 255u) == 0u) { if (xb_ld(&bar[XB_TMO])) break; if (sp > XB_SPIN_CAP) { atomicAdd(&bar[XB_TMO], 1u); break; } }
    }
    nloc = mine > 0u ? mine : 1u; nx = cnt > 0u ? cnt : 1u;
}
__device__ __forceinline__ void xcd_barrier(const XcdBarrier& b) {
    asm volatile("s_waitcnt vmcnt(0)" ::: "memory");
    __syncthreads();
    if (threadIdx.x == 0) {
        unsigned* bar = b.bar;
        __builtin_amdgcn_s_waitcnt(0);
        unsigned nloc = b.st[0], nx = b.st[1];
        if (nloc == 0u) { xcd_barrier_complete(bar, b.x, nloc, nx); b.st[0] = nloc; b.st[1] = nx; }
        const unsigned old = xb_add(&bar[XB_XSUB(b.x)], 1u);
        const unsigned gen = old / nloc;
        if (old + 1u == (gen + 1u) * nloc) {
            __builtin_amdgcn_fence(__ATOMIC_RELEASE, "agent");
            asm volatile("s_waitcnt vmcnt(0)" ::: "memory");
            const unsigned og = xb_add(&bar[XB_TOP], 1u);
            const unsigned tg = og / nx;
            if (og + 1u == (tg + 1u) * nx) xb_add(&bar[XB_TOPGEN], 1u);
            else XB_SPIN(xb_ld(&bar[XB_TOPGEN]) == tg, bar);
            __builtin_amdgcn_fence(__ATOMIC_ACQUIRE, "agent");
            xb_add(&bar[XB_XGEN(b.x)], 1u);
            asm volatile("s_waitcnt vmcnt(0)" ::: "memory");
        } else {
            XB_SPIN(xb_ld(&bar[XB_XGEN(b.x)]) == gen, bar);
            __builtin_amdgcn_fence(__ATOMIC_ACQUIRE, "agent");
            asm volatile("s_waitcnt vmcnt(0)" ::: "memory");
        }
    }
    __syncthreads();
}

struct Frame {
    LAS unsigned char* lds;
    int tid, lane, wave, G, bx;
    unsigned char* ws;
    float* out;
};
__device__ __forceinline__ int lane_id() { int l; asm volatile("v_mbcnt_lo_u32_b32 %0, -1, 0\n\tv_mbcnt_hi_u32_b32 %0, -1, %0" : "=v"(l)); return l; }
__device__ __forceinline__ float shfl_xor_l(float v, int off, int lane_l) { return __uint_as_float((unsigned)__builtin_amdgcn_ds_bpermute((lane_l ^ off) << 2, (int)__float_as_uint(v))); }
template <int CTRL> __device__ __forceinline__ float dpp_mov_f(float v) { return __int_as_float(__builtin_amdgcn_update_dpp(0, __float_as_int(v), CTRL, 0xf, 0xf, false)); }
__device__ __forceinline__ float wave_allsum(float v) {
    v += dpp_mov_f<0x128>(v); v += dpp_mov_f<0x124>(v); v += dpp_mov_f<0x122>(v); v += dpp_mov_f<0x121>(v);
    v += __int_as_float(__builtin_amdgcn_ds_swizzle(__float_as_int(v), 0x401F));
    const auto r = __builtin_amdgcn_permlane32_swap(__float_as_uint(v), __float_as_uint(v), false, false);
    return __uint_as_float(r[0]) + __uint_as_float(r[1]);
}
__device__ __forceinline__ float wave_allmax(float v) {
    v = fmaxf(v, dpp_mov_f<0x128>(v)); v = fmaxf(v, dpp_mov_f<0x124>(v)); v = fmaxf(v, dpp_mov_f<0x122>(v)); v = fmaxf(v, dpp_mov_f<0x121>(v));
    v = fmaxf(v, __int_as_float(__builtin_amdgcn_ds_swizzle(__float_as_int(v), 0x401F)));
    const auto r = __builtin_amdgcn_permlane32_swap(__float_as_uint(v), __float_as_uint(v), false, false);
    return fmaxf(__uint_as_float(r[0]), __uint_as_float(r[1]));
}
__device__ __forceinline__ int tid_rebuild(int wave) { int t = wave * 64 + lane_id(); asm volatile("" : "+v"(t)); return t; }
__device__ __forceinline__ void refresh(Frame& F) { const int t = tid_rebuild(F.wave); F.tid = t; F.lane = t & 63; }
__device__ __forceinline__ int modrow_of(int t) { return t < NLAT ? (t >> 11) : 16; }

constexpr int XT_W1 = (F8_G1 || I8_G1) ? 0 : 20 * 32, XT_W3 = F8_G3 ? 0 : 8 * 32, XT_WQKV = F8_QKV ? 0 : 24 * 32, XT_WO = F8_WO ? 0 : 8 * 32;
constexpr int XT_BF = XT_W1 + XT_W3 + XT_WQKV + XT_WO;
constexpr int XT8_W1 = (F8_G1 || I8_G1) ? 20 * 16 : 0, XT8_W3 = F8_G3 ? 8 * 16 : 0, XT8_WQKV = F8_QKV ? 24 * 16 : 0, XT8_WO = F8_WO ? 8 * 16 : 0;
constexpr int XT8_WGU = 32 * 8 * 16, XT8_WD = 32 * 8 * 8, XT8_TOTAL = XT8_W1 + XT8_W3 + XT8_WQKV + XT8_WO + XT8_WGU + XT8_WD;
constexpr float Y8_SCALE = 16.0f;
constexpr float A8_SCALE = 8.0f;
constexpr int XT8_DENSE = XT8_W1 + XT8_W3 + XT8_WQKV + XT8_WO;
constexpr int XT_TOTAL = XT_BF + XT8_TOTAL;
constexpr float GU_GATE_K = 1.4426950408889634f, GU_UP_K = 4.0f / 1.4426950408889634f;
constexpr float W1Q = 127.0f / 0.09375f, W1DQ = 0.09375f / 127.0f;
constexpr float W8_SCALE = 64.0f;
constexpr float H8_SCALE = 4.0f;
constexpr size_t WGU_LSTRIDE = (size_t)16 * 2048 * 2048 * 2, WD_LSTRIDE = (size_t)16 * 2048 * 1024 * 2;
constexpr int ADA_UNITS = 0;
constexpr int P0_UNITS = XT_TOTAL + ADA_UNITS + 1 + 16;

struct XTile { const float* src; bf16_t* dst; int ld, K, rb, kb; };
__device__ __forceinline__ int col0_w1(const int rb, const int gi) {
    return rb < 8 ? (gi < 4 ? 1024 + rb * 128 + gi * 32 : 2048 + rb * 128 + (gi - 4) * 32) : rb < 12 ? (rb - 8) * 256 + gi * 32 : rb < 16 ? 3072 + (rb - 12) * 256 + gi * 32 : 4096 + (rb - 16) * 256 + gi * 32; }
__device__ __forceinline__ int col0_wqkv(const int rb, const int gi) {
    if (rb < 16) { const int part = rb >> 3, head = rb & 7, g4 = gi & 3, m = g4 >> 1, a = g4 & 1; return part * 2048 + head * 256 + m * 128 + a * 64 + (gi >= 4 ? 32 : 0); }
    return 4096 + (rb - 16) * 256 + gi * 32; }
__device__ __forceinline__ XTile xt_decode(int T, const int gi, const Params& p, unsigned char* ws) {
    XTile x; int col0;
    if (T < XT_W1) { x.rb = T >> 5; x.kb = T & 31; x.K = 2048; x.ld = 5120; x.src = inptr(p, 9); x.dst = (bf16_t*)(ws + WS_W1); col0 = col0_w1(x.rb, gi); }
    else if ((T -= XT_W1) < XT_W3) { x.rb = T >> 5; x.kb = T & 31; x.K = 2048; x.ld = 2048; x.src = inptr(p, 18); x.dst = (bf16_t*)(ws + WS_W3); col0 = x.rb * 256 + gi * 32; }
    else if ((T -= XT_W3) < XT_WQKV) { x.rb = T >> 5; x.kb = T & 31; x.K = 2048; x.ld = 6144; x.src = inptr(p, 19); x.dst = (bf16_t*)(ws + WS_WQKV); col0 = col0_wqkv(x.rb, gi); }
    else { T -= XT_WQKV; x.rb = T >> 5; x.kb = T & 31; x.K = 2048; x.ld = 2048; x.src = inptr(p, 25); x.dst = (bf16_t*)(ws + WS_WO); col0 = x.rb * 256 + gi * 32; }
    x.src += col0; return x;
}
struct XRegs { f32x4 v0[4], v1[4]; };
__device__ __forceinline__ void xt_load(XRegs& R, const XTile& x, const int lane) {
    const int kq = lane >> 3, c4 = (lane & 7) * 4;
    const float* s = x.src + (size_t)(x.kb * 64 + 2 * kq) * x.ld + c4;
#pragma unroll
    for (int it = 0; it < 4; ++it) { R.v0[it] = *(const f32x4*)(s + (size_t)(16 * it) * x.ld); R.v1[it] = *(const f32x4*)(s + (size_t)(16 * it + 1) * x.ld); }
}
__device__ __forceinline__ void xt_store(const Frame& F, const XRegs& R, const XTile& x) {
    LAS unsigned* T = (LAS unsigned*)F.lds;
    const int l = F.lane, w = F.wave, kq = l >> 3, c4 = (l & 7) * 4;
#pragma unroll
    for (int it = 0; it < 4; ++it)
#pragma unroll
        for (int j = 0; j < 4; ++j) T[(w * 32 + c4 + j) * 36 + 8 * it + kq] = cvt_pk_bf16(R.v0[it][j], R.v1[it][j]);
    __syncthreads();
#pragma unroll
    for (int it = 0; it < 4; ++it) { const int q = F.tid + 512 * it, row = q >> 3, piece = q & 7;
        const u32x4 v = *(const LAS u32x4*)(T + row * 36 + piece * 4);
        *(u32x4*)(x.dst + (size_t)(x.rb * 256 + row) * x.K + x.kb * 64 + piece * 8) = v; }
    __syncthreads();
}

struct XTile8 { const float* src; unsigned char* dst; int ld, K, rb, kb, pair, i8; float scale; };
__device__ __forceinline__ XTile8 xt8_decode(int T, const int gi, const Params& p, unsigned char* ws) {
    XTile8 x; int col0; x.pair = 0; x.i8 = 0; x.scale = W8_SCALE;
    if (T < XT8_W1) { x.rb = T >> 4; x.kb = T & 15; x.K = 2048; x.ld = 5120; x.src = inptr(p, 9); x.dst = ws + WS_W1; col0 = col0_w1(x.rb, gi); if (I8_G1) { x.i8 = 1; x.scale = W1Q; } }
    else if ((T -= XT8_W1) < XT8_W3) { x.rb = T >> 4; x.kb = T & 15; x.K = 2048; x.ld = 2048; x.src = inptr(p, 18); x.dst = ws + WS_W3; col0 = x.rb * 256 + gi * 32; }
    else if ((T -= XT8_W3) < XT8_WQKV) { x.rb = T >> 4; x.kb = T & 15; x.K = 2048; x.ld = 6144; x.src = inptr(p, 19); x.dst = ws + WS_WQKV; col0 = col0_wqkv(x.rb, gi); }
    else if ((T -= XT8_WQKV) < XT8_WO) { x.rb = T >> 4; x.kb = T & 15; x.K = 2048; x.ld = 2048; x.src = inptr(p, 25); x.dst = ws + WS_WO; col0 = x.rb * 256 + gi * 32; }
    else if ((T -= XT8_WO) < XT8_WGU) { const int le = T >> 7; x.rb = (T >> 4) & 7; x.kb = T & 15; x.K = 2048; x.ld = 1024;
        x.src = (gi < 4 ? inptr(p, 28) : inptr(p, 29)) + (size_t)le * 2048 * 1024; col0 = x.rb * 128 + (gi & 3) * 32;
        x.scale = gi < 4 ? W8_SCALE * GU_GATE_K : W8_SCALE * GU_UP_K;
        x.dst = ws + WS_WGU + (size_t)(le >> 4) * WGU_LSTRIDE + (size_t)(le & 15) * 2048 * 2048; }
    else { T -= XT8_WGU; const int le = T >> 6; x.rb = (T >> 3) & 7; x.kb = T & 7; x.K = 1024; x.ld = 2048;
        x.src = inptr(p, 30) + (size_t)le * 1024 * 2048;
        if (F8_Y) { x.pair = 1; col0 = x.rb * 256 + (gi & 3) * 64 + (gi >> 2) * 8; }
        else col0 = x.rb * 256 + gi * 32;
        x.dst = ws + WS_WD + (size_t)(le >> 4) * WD_LSTRIDE + (size_t)(le & 15) * 2048 * 1024; }
    x.src += col0; return x;
}
struct XRegs8 { f32x4 v[4][4]; };
__device__ __forceinline__ void xt8_load(XRegs8& R, const XTile8& x, const int lane) {
    const int kq = lane >> 3, c4 = (lane & 7) * 4;
    const float* s = x.src + (size_t)(x.kb * 128 + 4 * kq) * x.ld + (x.pair ? 16 * (c4 >> 3) + (c4 & 7) : c4);
#pragma unroll
    for (int it = 0; it < 4; ++it)
#pragma unroll
        for (int j = 0; j < 4; ++j) R.v[it][j] = *(const f32x4*)(s + (size_t)(32 * it + j) * x.ld);
}
__device__ __forceinline__ void xt8_store(const Frame& F, const XRegs8& R, const XTile8& x) {
    LAS unsigned* T = (LAS unsigned*)F.lds;
    const int l = F.lane, w = F.wave, kq = l >> 3, c4 = (l & 7) * 4;
#pragma unroll
    for (int it = 0; it < 4; ++it)
#pragma unroll
        for (int c = 0; c < 4; ++c) T[(w * 32 + c4 + c) * 36 + 8 * it + kq] = x.i8 ? pack_i8x4(x.scale * R.v[it][0][c], x.scale * R.v[it][1][c], x.scale * R.v[it][2][c], x.scale * R.v[it][3][c])
                                                                          : pack_fp8x4(x.scale * R.v[it][0][c], x.scale * R.v[it][1][c], x.scale * R.v[it][2][c], x.scale * R.v[it][3][c]);
    __syncthreads();
#pragma unroll
    for (int it = 0; it < 4; ++it) { const int q = F.tid + 512 * it, row = q >> 3, piece = q & 7;
        const u32x4 v = *(const LAS u32x4*)(T + row * 36 + piece * 4);
        *(u32x4*)(x.dst + (size_t)(x.rb * 256 + row) * x.K + x.kb * 128 + piece * 16) = v; }
    __syncthreads();
}

__device__ __forceinline__ void p0_prologue(const Frame& F, const Params& p) {
    unsigned char* ws = F.ws;
    {
        for (int u = F.bx; u < XT_BF; u += F.G) { XRegs cur; const XTile xc = xt_decode(u, F.wave, p, ws); xt_load(cur, xc, F.lane); xt_store(F, cur, xc); }
        for (int u = F.bx; u < (MK_TAILFILL ? XT8_DENSE : XT8_TOTAL); u += F.G) { XRegs8 cur; const XTile8 xc = xt8_decode(u, F.wave, p, ws); xt8_load(cur, xc, F.lane); xt8_store(F, cur, xc); }
    }
    {
        LAS float* sS = (LAS float*)F.lds;
        const float* cin = inptr(p, 1); const float* cctx = inptr(p, 3); const float* adaw = inptr(p, 4); const float* adab = inptr(p, 5);
        float* mod = (float*)(ws + WS_MOD);
        for (int cbk = F.bx; cbk < 256; cbk += F.G) {
            __syncthreads();
            for (int i = F.tid; i < 17 * 2048; i += 512) { const int r = i >> 11, k = i & 2047; const float cv = r < 16 ? cin[r * D + k] : cctx[k]; sS[i] = cv / (1.0f + expf(-cv)); }
            __syncthreads();
            const int colg = cbk * 96, l = colg / MODW, n0 = colg % MODW;
            const int c = F.tid % 24, kl = F.tid / 24;
            f32x4 acc[17];
#pragma unroll
            for (int r = 0; r < 17; ++r) acc[r] = (f32x4){0.f, 0.f, 0.f, 0.f};
            if (kl < 21) {
                const float* wp = adaw + ((size_t)l * D) * MODW + n0 + c * 4;
#pragma unroll 1
                for (int k0 = kl; k0 < 2048; k0 += 21 * 8) {
                    f32x4 wv[8];
#pragma unroll
                    for (int j = 0; j < 8; ++j) { const int k = k0 + 21 * j; wv[j] = k < 2048 ? *(const f32x4*)(wp + (size_t)k * MODW) : (f32x4){0.f, 0.f, 0.f, 0.f}; }
#pragma unroll
                    for (int j = 0; j < 8; ++j) { const int k = min(k0 + 21 * j, 2047);
#pragma unroll
                        for (int r = 0; r < 17; ++r) acc[r] += sS[r * 2048 + k] * wv[j]; }
                }
            }
            __syncthreads();
            if (kl < 21) {
#pragma unroll
                for (int r = 0; r < 17; ++r) *(LAS f32x4*)(sS + (kl * 17 + r) * 96 + c * 4) = acc[r];
            }
            __syncthreads();
            for (int o = F.tid; o < 17 * 96; o += 512) { const int r = o / 96, cc = o % 96; float sum = adab[(size_t)l * MODW + n0 + cc];
#pragma unroll
                for (int q = 0; q < 21; ++q) sum += sS[(q * 17 + r) * 96 + cc];
                mod[((size_t)l * 17 + r) * MODW + n0 + cc] = sum; }
        }
        __syncthreads();
    }
    const int first = XT_TOTAL + ((F.bx - XT_TOTAL % F.G) % F.G + F.G) % F.G;
    for (int u = first; u < P0_UNITS; u += F.G) {
        if (false) {
        } else if (u == XT_TOTAL + ADA_UNITS) {
            float* rc = (float*)(ws + WS_ROPE); float* rs = rc + 2048;
            for (int i = F.tid; i < 2048; i += 512) { const int pos = i >> 5, j = i & 31;
                const float inv = exp2f(-(float)(2 * j) * (13.287712379549449f / 64.0f)); const float ang = (float)pos * inv;
                rc[i] = cosf(ang); rs[i] = sinf(ang); }
        } else {
            const int q = u - (XT_TOTAL + ADA_UNITS + 1), d = q >> 3, h = q & 7;
            bf16_t* gw = (bf16_t*)(ws + WS_GW) + (size_t)(d * 8 + h) * 2 * 128 * 128;
            const float* wa = inptr(p, 13) + (size_t)(d * 8 + h) * 128 * 128; const float* wi = inptr(p, 15) + (size_t)(d * 8 + h) * 128 * 128;
            for (int i = F.tid; i < 128 * 128; i += 512) { const int k = i >> 7, j = i & 127, half = j >> 6, o = j & 63;
                gw[(size_t)(half * 128 + o) * 128 + k] = (bf16_t)(cvt_pk_bf16(wa[i], 0.f) & 0xffffu);
                gw[(size_t)(half * 128 + 64 + o) * 128 + k] = (bf16_t)(cvt_pk_bf16(wi[i], 0.f) & 0xffffu); }
        }
    }
}

__device__ __forceinline__ void moe_tile(const Frame& F, const Params& p, const int layer, const int i) {
    const int T = XT8_DENSE + (i < 2048 ? layer * 2048 + i : XT8_WGU + layer * 1024 + (i - 2048));
    XRegs8 cur; const XTile8 xc = xt8_decode(T, F.wave, p, F.ws); xt8_load(cur, xc, F.lane); xt8_store(F, cur, xc);
}
__device__ __forceinline__ void tail_fill(const Frame& F, const Params& p, const int layer, const int done_slot, const bool exhaust) {
    unsigned* ctl = (unsigned*)(F.ws + WS_CTL);
    LAS int* slot = (LAS int*)(F.lds + LX_MISC + 512);
    __syncthreads();
    if (F.tid == 0 && !exhaust) __hip_atomic_fetch_add(ctl + CW_DONE + done_slot, 1u, __ATOMIC_RELAXED, __HIP_MEMORY_SCOPE_AGENT);
#pragma unroll 1
    for (;;) {
        if (F.tid == 0) { int t = -1;
            const bool go = exhaust || __hip_atomic_load(ctl + CW_DONE + done_slot, __ATOMIC_RELAXED, __HIP_MEMORY_SCOPE_AGENT) < (unsigned)F.G;
            if (go) { const unsigned c = __hip_atomic_fetch_add(ctl + CW_FILL + layer, 1u, __ATOMIC_RELAXED, __HIP_MEMORY_SCOPE_AGENT); if (c < 3072u) t = (int)c; }
            *slot = t; }
        __syncthreads();
        const int t = *slot;
        if (t < 0) break;
        moe_tile(F, p, layer, t);
    }
    __syncthreads();
}

__device__ __forceinline__ void p1_modreduce(const Frame& F, const Params& p) {
    const float* part = (const float*)(F.ws + WS_HID); float* mod = (float*)(F.ws + WS_MOD);
    const int n4 = 2 * 17 * MODW / 4; const float* adab = inptr(p, 5);
    for (int i = F.bx * 512 + F.tid; i < n4; i += F.G * 512) {
        const int e = i * 4, l = e / (17 * MODW), rr = (e / MODW) % 17, n = e % MODW;
        f32x4 s = *(const f32x4*)(adab + (size_t)l * MODW + n);
#pragma unroll
        for (int kc = 0; kc < 16; ++kc) s += *(const f32x4*)(part + ((size_t)(l * 16 + kc) * 17 + rr) * MODW + n);
        *(f32x4*)(mod + e) = s;
    }
}

struct RowRegs { f32x4 x[8]; u32x2 y0[8], y1[8]; };
template <int MODE>
__device__ __forceinline__ void row_load(RowRegs& R, const int t, const int lane, const int fin_mode, const float* xin0, const float* xin2, const bf16_t* XR, const bf16_t* Y0, const bf16_t* Y1) {
    if (MODE == 0 || (MODE == 3 && fin_mode == 2)) {
        const float* src = t < NLAT ? xin0 + (size_t)t * D : xin2 + (size_t)(t - NLAT) * D;
#pragma unroll
        for (int j = 0; j < 8; ++j) R.x[j] = *(const f32x4*)(src + 256 * j + 4 * lane);
    } else {
#pragma unroll
        for (int j = 0; j < 8; ++j) { const u32x2 a = *(const u32x2*)(XR + (size_t)t * D + 256 * j + 4 * lane); R.x[j] = (f32x4){bflo(a.x), bfhi(a.x), bflo(a.y), bfhi(a.y)}; }
    }
    if (MODE == 2 || (MODE == 3 && fin_mode == 0)) {
#pragma unroll
        for (int j = 0; j < 8; ++j) {
#if F8_Y
            R.y0[j].x = *(const unsigned*)((const unsigned char*)Y0 + (size_t)t * D + 256 * j + 4 * lane); R.y1[j].x = *(const unsigned*)((const unsigned char*)Y0 + ((size_t)NTOK + t) * D + 256 * j + 4 * lane);
#else
            R.y0[j] = *(const u32x2*)(Y0 + (size_t)t * D + 256 * j + 4 * lane); R.y1[j] = *(const u32x2*)(Y1 + (size_t)t * D + 256 * j + 4 * lane);
#endif
        }
    }
}
__device__ __forceinline__ void router_logits2(const LAS float* wl, const int lane, const f32x4 (&va)[8], const f32x4 (&vb)[8], float (&pa)[16], float (&pb)[16]) {
#pragma unroll
    for (int e = 0; e < 16; ++e) { f32x2 sa = {0.f, 0.f}, sb = {0.f, 0.f};
#pragma unroll
        for (int j = 0; j < 8; ++j) { const f32x4 wv = *(const LAS f32x4*)(wl + e * 2048 + 256 * j + 4 * lane);
            const f32x2 w01 = {wv[0], wv[1]}, w23 = {wv[2], wv[3]};
            sa += (f32x2){va[j][0], va[j][1]} * w01; sa += (f32x2){va[j][2], va[j][3]} * w23;
            sb += (f32x2){vb[j][0], vb[j][1]} * w01; sb += (f32x2){vb[j][2], vb[j][3]} * w23; }
        pa[e] = wave_allsum(sa[0] + sa[1]); pb[e] = wave_allsum(sb[0] + sb[1]); }
}
__device__ __forceinline__ void router_pick(const float (&pe)[16], const LAS float* rbl, LAS int* lcnt, LAS int* rec, LAS float* recg, const int rl, const bool file) {
    float scv[16], sel[16];
#pragma unroll
    for (int e = 0; e < 16; ++e) { scv[e] = __builtin_amdgcn_rcpf(1.0f + __expf(-pe[e])); sel[e] = scv[e] + rbl[e]; }
    float best = -3.0e38f, bs1 = 0.f, bs2 = 0.f; int be1 = 0, be2 = 1;
#pragma unroll
    for (int g = 0; g < 4; ++g) {
        const float a0 = sel[4 * g], a1 = sel[4 * g + 1], a2 = sel[4 * g + 2], a3 = sel[4 * g + 3];
        const float c0 = scv[4 * g], c1 = scv[4 * g + 1], c2 = scv[4 * g + 2], c3 = scv[4 * g + 3];
        int i1 = 0; float m1 = a0, s1 = c0; if (a1 > m1) { m1 = a1; i1 = 1; s1 = c1; } if (a2 > m1) { m1 = a2; i1 = 2; s1 = c2; } if (a3 > m1) { m1 = a3; i1 = 3; s1 = c3; }
        int i2 = -1; float m2 = -3.0e38f, s2 = 0.f;
        if (i1 != 0 && a0 > m2) { m2 = a0; i2 = 0; s2 = c0; } if (i1 != 1 && a1 > m2) { m2 = a1; i2 = 1; s2 = c1; } if (i1 != 2 && a2 > m2) { m2 = a2; i2 = 2; s2 = c2; } if (i1 != 3 && a3 > m2) { m2 = a3; i2 = 3; s2 = c3; }
        const float gs = m1 + m2;
        if (gs > best) { best = gs; be1 = 4 * g + i1; be2 = 4 * g + i2; bs1 = s1; bs2 = s2; }
    }
    if (file) { const float inv = 1.0f / (bs1 + bs2);
        const int p1 = __hip_atomic_fetch_add(lcnt + be1, 1, __ATOMIC_RELAXED, __HIP_MEMORY_SCOPE_WORKGROUP), p2 = __hip_atomic_fetch_add(lcnt + be2, 1, __ATOMIC_RELAXED, __HIP_MEMORY_SCOPE_WORKGROUP);
        rec[rl * 2] = (be1 << 16) | p1; rec[rl * 2 + 1] = (be2 << 16) | p2; recg[rl * 2] = bs1 * inv; recg[rl * 2 + 1] = bs2 * inv; }
}
__device__ __forceinline__ void ffn_norm_row(const RowRegs& R, const int t, const int lane, const LAS float* cA, const LAS float* cB, unsigned char* HB8, f32x4 (&v)[8]) {
    float ss = 0.f;
#pragma unroll
    for (int j = 0; j < 8; ++j) { v[j] = R.x[j]; ss += v[j][0] * v[j][0] + v[j][1] * v[j][1] + v[j][2] * v[j][2] + v[j][3] * v[j][3]; }
    ss = wave_allsum(ss);
    const float rstd = 1.0f / sqrtf(ss * (1.0f / 2048.0f) + EPS);
#pragma unroll
    for (int j = 0; j < 8; ++j) { const int col = 256 * j + 4 * lane;
        const f32x4 ca = *(const LAS f32x4*)(cA + col), cb = *(const LAS f32x4*)(cB + col);
        v[j] = v[j] * rstd * ca + cb;
        *(unsigned*)(HB8 + (size_t)t * D + col) = pack_fp8x4(clamp8(v[j][0]), clamp8(v[j][1]), clamp8(v[j][2]), clamp8(v[j][3])); }
}
template <int MODE>
__device__ __forceinline__ void row_phase(const Frame& F, const Params& p, const int l, const int fin_mode) {
    unsigned char* ws = F.ws;
    const float* mod = (const float*)(ws + WS_MOD);
    bf16_t* HB = (bf16_t*)(ws + WS_HB); bf16_t* XR = (bf16_t*)(ws + WS_XR);
    const bf16_t* Y0 = (const bf16_t*)(ws + WS_R1); const bf16_t* Y1 = Y0 + (size_t)NTOK * D;
    const int nrows = (MODE == 3 || (MODE == 1 && l == 1)) ? NLAT : NTOK;
    const int chunk = (nrows + F.G - 1) / F.G, r_begin = F.bx * chunk, r_end = min(nrows, r_begin + chunk);
    const int lane = F.lane, w = F.wave;
    constexpr bool OUT8 = MODE == 1 || (MODE == 0 && F8_G1) || (MODE == 2 && F8_QKV);
    LAS float* wl = (LAS float*)F.lds;
    LAS float* cA = (LAS float*)(F.lds + 131072); LAS float* cB = cA + 2048;
    LAS int* lcnt = (LAS int*)(F.lds + LX_LCNT); LAS int* lbase = (LAS int*)(F.lds + LX_LBASE);
    LAS int* rec = (LAS int*)(F.lds + LX_REC); LAS float* recg = (LAS float*)(F.lds + LX_RECG);
    LAS float* rbl = (LAS float*)(F.lds + LX_MISC);
    if (MODE == 1) {
        const float* rw = inptr(p, 26);
        for (int i = F.tid; i < 2048 * 4; i += 512) { const int k = i >> 2, e4 = (i & 3) * 4; const f32x4 v = *(const f32x4*)(rw + k * 16 + e4);
#pragma unroll
            for (int j = 0; j < 4; ++j) wl[(e4 + j) * 2048 + k] = v[j]; }
        if (F.tid < 16) { lcnt[F.tid] = 0; rbl[F.tid] = inptr(p, 27)[F.tid]; }
    }
    const float* gain = MODE == 0 ? inptr(p, 6) : MODE == 1 ? inptr(p, 7) + (size_t)l * D : MODE == 2 ? inptr(p, 6) + D : inptr(p, 8);
    const int sh_off = (MODE == 1) ? 6144 : 0, sc_off = (MODE == 1) ? 8192 : 2048;
    const int lmod = (MODE == 2) ? 1 : l;
    const float* xin0 = inptr(p, 0); const float* xin2 = inptr(p, 2);
    for (int rs = r_begin; rs < r_end; rs += ROWCH) {
        const int re = min(r_end, rs + ROWCH);
        for (int sb = rs; sb < re;) {
            const int b = modrow_of(sb);
            const int bend = b < 16 ? (b + 1) * SEQ : NTOK, se = min(re, bend);
            __syncthreads();
            for (int c4 = F.tid; c4 < 512; c4 += 512) {
                const int col = c4 * 4; const f32x4 g = *(const f32x4*)(gain + col);
                if (MODE == 3) { *(LAS f32x4*)(cA + col) = g; }
                else { const f32x4 sc = *(const f32x4*)(mod + ((size_t)lmod * 17 + b) * MODW + sc_off + col), sh = *(const f32x4*)(mod + ((size_t)lmod * 17 + b) * MODW + sh_off + col);
                    *(LAS f32x4*)(cA + col) = g * (1.0f + sc); *(LAS f32x4*)(cB + col) = sh; }
                if (MODE == 2 || MODE == 3) *(LAS f32x4*)(wl + col) = *(const f32x4*)(mod + ((size_t)l * 17 + b) * MODW + 10240 + col) * (F8_Y ? 1.0f / Y8_SCALE : 1.0f);
            }
            __syncthreads();
            if (MODE == 1) {
                RowRegs c0, c1, n0, n1;
                int t = sb + w;
                if (t < se) row_load<1>(c0, t, lane, fin_mode, xin0, xin2, XR, Y0, Y1);
                if (t + 8 < se) row_load<1>(c1, t + 8, lane, fin_mode, xin0, xin2, XR, Y0, Y1);
#pragma unroll 1
                for (; t < se; t += 16) {
                    const bool has_b = t + 8 < se;
                    if (t + 16 < se) row_load<1>(n0, t + 16, lane, fin_mode, xin0, xin2, XR, Y0, Y1);
                    if (t + 24 < se) row_load<1>(n1, t + 24, lane, fin_mode, xin0, xin2, XR, Y0, Y1);
                    f32x4 va[8], vb[8];
                    ffn_norm_row(c0, t, lane, cA, cB, (unsigned char*)HB, va);
                    if (has_b) ffn_norm_row(c1, t + 8, lane, cA, cB, (unsigned char*)HB, vb);
                    else {
#pragma unroll
                        for (int j = 0; j < 8; ++j) vb[j] = va[j]; }
                    float pa[16], pb[16];
                    router_logits2(wl, lane, va, vb, pa, pb);
                    router_pick(pa, rbl, lcnt, rec, recg, t - rs, lane == 0);
                    router_pick(pb, rbl, lcnt, rec, recg, t + 8 - rs, lane == 0 && has_b);
#pragma unroll
                    for (int j = 0; j < 8; ++j) { c0.x[j] = n0.x[j]; c1.x[j] = n1.x[j]; }
                }
                sb = se; continue;
            }
            RowRegs cur, nxt;
            int t = sb + w;
            if (t < se) row_load<MODE>(cur, t, lane, fin_mode, xin0, xin2, XR, Y0, Y1);
            for (; t < se; t += 8) {
                const int tn = t + 8;
                if (tn < se) row_load<MODE>(nxt, tn, lane, fin_mode, xin0, xin2, XR, Y0, Y1);
                f32x4 v[8];
#pragma unroll
                for (int j = 0; j < 8; ++j) v[j] = cur.x[j];
                if (MODE == 2 || (MODE == 3 && fin_mode == 0)) {
#pragma unroll
                    for (int j = 0; j < 8; ++j) { const int col = 256 * j + 4 * lane; const f32x4 g = *(const LAS f32x4*)(wl + col); const u32x2 a = cur.y0[j], c = cur.y1[j];
#if F8_Y
                        const f32x2 a01 = __builtin_amdgcn_cvt_pk_f32_fp8((int)a.x, false), a23 = __builtin_amdgcn_cvt_pk_f32_fp8((int)a.x, true), c01 = __builtin_amdgcn_cvt_pk_f32_fp8((int)c.x, false), c23 = __builtin_amdgcn_cvt_pk_f32_fp8((int)c.x, true);
                        v[j][0] += g[0] * (a01[0] + c01[0]); v[j][1] += g[1] * (a01[1] + c01[1]);
                        v[j][2] += g[2] * (a23[0] + c23[0]); v[j][3] += g[3] * (a23[1] + c23[1]); }
#else
                        v[j][0] += g[0] * (bflo(a.x) + bflo(c.x)); v[j][1] += g[1] * (bfhi(a.x) + bfhi(c.x));
                        v[j][2] += g[2] * (bflo(a.y) + bflo(c.y)); v[j][3] += g[3] * (bfhi(a.y) + bfhi(c.y)); }
#endif
                    if (MODE == 2) {
#pragma unroll
                        for (int j = 0; j < 8; ++j) { u32x2 o; o.x = cvt_pk_bf16(v[j][0], v[j][1]); o.y = cvt_pk_bf16(v[j][2], v[j][3]); *(u32x2*)(XR + (size_t)t * D + 256 * j + 4 * lane) = o;
                            v[j] = (f32x4){bflo(o.x), bfhi(o.x), bflo(o.y), bfhi(o.y)}; }
                    }
                }
                float ss = 0.f;
#pragma unroll
                for (int j = 0; j < 8; ++j) ss += v[j][0] * v[j][0] + v[j][1] * v[j][1] + v[j][2] * v[j][2] + v[j][3] * v[j][3];
                ss = wave_allsum(ss);
                const float rstd = 1.0f / sqrtf(ss * (1.0f / 2048.0f) + EPS);
                if (MODE == 3) {
                    float* dst = F.out + (size_t)t * D;
#pragma unroll
                    for (int j = 0; j < 8; ++j) { const f32x4 g = *(const LAS f32x4*)(cA + 256 * j + 4 * lane); *(f32x4*)(dst + 256 * j + 4 * lane) = v[j] * rstd * g; }
                } else {
                    if (MODE == 0 && I8_G1) {
                        float am = 0.f;
#pragma unroll
                        for (int j = 0; j < 8; ++j) { const int col = 256 * j + 4 * lane;
                            const f32x4 ca = *(const LAS f32x4*)(cA + col), cb = *(const LAS f32x4*)(cB + col);
                            v[j] = v[j] * rstd * ca + cb;
                            am = fmaxf(am, fmaxf(fmaxf(fabsf(v[j][0]), fabsf(v[j][1])), fmaxf(fabsf(v[j][2]), fabsf(v[j][3])))); }
                        am = fmaxf(wave_allmax(am), 1e-20f);
                        const float qs = 127.0f * __builtin_amdgcn_rcpf(am);
#pragma unroll
                        for (int j = 0; j < 8; ++j) *(unsigned*)((unsigned char*)HB + (size_t)t * D + 256 * j + 4 * lane) = pack_i8x4(v[j][0] * qs, v[j][1] * qs, v[j][2] * qs, v[j][3] * qs);
                        if (lane == 0) ((float*)(ws + WS_ASC))[t] = am * (1.0f / 127.0f);
                    } else
#pragma unroll
                    for (int j = 0; j < 8; ++j) { const int col = 256 * j + 4 * lane;
                        const f32x4 ca = *(const LAS f32x4*)(cA + col), cb = *(const LAS f32x4*)(cB + col);
                        v[j] = v[j] * rstd * ca + cb;
                        if (OUT8) {
                            *(unsigned*)((unsigned char*)HB + (size_t)t * D + col) = pack_fp8x4(clamp8(v[j][0]), clamp8(v[j][1]), clamp8(v[j][2]), clamp8(v[j][3]));
                        } else {
                            u32x2 o; o.x = cvt_pk_bf16(v[j][0], v[j][1]); o.y = cvt_pk_bf16(v[j][2], v[j][3]);
                            *(u32x2*)(HB + (size_t)t * D + col) = o; } }
                }
                if (tn < se) {
#pragma unroll
                    for (int j = 0; j < 8; ++j) { cur.x[j] = nxt.x[j]; cur.y0[j] = nxt.y0[j]; cur.y1[j] = nxt.y1[j]; } }
            }
            sb = se;
        }
        if (MODE == 1) {
            __syncthreads();
            unsigned* cntg = (unsigned*)(ws + WS_CTL) + CW_CNT + l * 64;
            if (F.tid < 16) lbase[F.tid] = (int)__hip_atomic_fetch_add(cntg + F.tid, (unsigned)lcnt[F.tid], __ATOMIC_RELAXED, __HIP_MEMORY_SCOPE_AGENT);
            __syncthreads();
            int* list = (int*)(ws + WS_LIST); float* listg = (float*)(ws + WS_LISTG);
            const int nrec = (re - rs) * 2;
            for (int i = F.tid; i < nrec; i += 512) { const int rr = rec[i], e = rr >> 16, pos = lbase[e] + (rr & 0xffff); const int t = rs + (i >> 1);
                list[(size_t)e * NTOK + pos] = t * 2 + (i & 1); listg[(size_t)e * NTOK + pos] = recg[i]; }
            __syncthreads();
            if (F.tid < 16) lcnt[F.tid] = 0;
            __syncthreads();
        }
    }
}

namespace pg8 {
constexpr int BM = 256, BK = 64, HALF = 128, HTB = HALF * BK * 2, NXCD = 8, WGM = 8;
__host__ __device__ __forceinline__ int lds_byte(int r, int c) { const int st = (r >> 4) * 2 + (c >> 5), rr = r & 15, cc = c & 31, ob = rr * 64 + cc * 2; return st * 1024 + (ob ^ (((ob >> 9) & 1) << 5)); }
__host__ __device__ __forceinline__ void stage_rc(int b, int& R, int& C) { const int st = b / 1024, sb = b % 1024, swz = sb ^ (((sb >> 9) & 1) << 5); R = (st >> 1) * 16 + swz / 64; C = (st & 1) * 32 + (swz % 64) / 2; }
__host__ __device__ __forceinline__ int perm32(int rho) { const int n = rho >> 4, i = rho & 15; return 8 * (i >> 2) + 4 * n + (i & 3); }

struct Unit { int pm, pn, e, pos0, cnt; };

__device__ __forceinline__ bool static_map(long L, int nM, int nN, int& pm, int& pn) {
    const int nwg = nM * nN; if (L >= nwg) return false;
    int wgid = (int)L; { const int q = nwg / NXCD, r = nwg % NXCD, xcd = wgid % NXCD, off = wgid / NXCD; wgid = (xcd < r ? xcd * (q + 1) : r * (q + 1) + (xcd - r) * q) + off; }
    const int nig = WGM * nN, gid = wgid / nig, fm = gid * WGM, gsz = (nM - fm) < WGM ? (nM - fm) : WGM;
    pm = fm + ((wgid % nig) % gsz); pn = (wgid % nig) / gsz; return true;
}
__device__ __forceinline__ bool static_next(int i, int G, int c, int nM, int nN, int& pm, int& pn) { return static_map((long)i * G + c, nM, nN, pm, pn); }
template <bool FP8_, bool I8_ = false> struct DenseSched {
    static constexpr bool GATHER = false, FP8 = FP8_, I8 = I8_; static constexpr int ES = (FP8_ || I8_) ? 1 : 2;
    const char* A; const char* B; int nM, nN, K, G, c; int sw, sa;
    __device__ __forceinline__ int scale_w() const { return sw; } __device__ __forceinline__ int scale_a() const { return sa; }
    __device__ __forceinline__ bool next(int i, Unit& u) const { u.e = 0; u.pos0 = 0; u.cnt = 0; return static_next(i, G, c, nM, nN, u.pm, u.pn); }
    __device__ __forceinline__ const char* a_tile(const Unit& u) const { return A + (size_t)u.pm * 256 * K * ES; }
    __device__ __forceinline__ unsigned a_row_off(const Unit&, int r) const { return (unsigned)r * (unsigned)K * (unsigned)ES; }
    __device__ __forceinline__ const char* b_tile(const Unit& u) const { return B + (size_t)u.pn * 256 * K * ES; }
};
#ifndef MK_NTSTORE
#define MK_NTSTORE 1
#endif
__device__ __forceinline__ void st16(bf16_t* p, const u32x4 v) {
#if MK_NTSTORE
    __builtin_nontemporal_store(v, (u32x4*)p);
#else
    *(u32x4*)p = v;
#endif
}
template <bool FP8_> struct QkvSched {
    static constexpr bool GATHER = false, FP8 = FP8_, I8 = false; static constexpr int ES = FP8_ ? 1 : 2;
    const char* A; const char* B; int K, G, c; int sw, sa;
    __device__ __forceinline__ int scale_w() const { return sw; } __device__ __forceinline__ int scale_a() const { return sa; }
    __device__ __forceinline__ bool next(int i, Unit& u) const {
        u.pos0 = 0; u.cnt = 0; const long L = (long)i * G + c; constexpr int n1 = (NLAT / 256) * 24;
        if (L < n1) { u.e = 0; return static_map(L, NLAT / 256, 24, u.pm, u.pn); }
        u.e = 1; return static_map(L - n1, NCTX / 256, 16, u.pm, u.pn);
    }
    __device__ __forceinline__ const char* a_tile(const Unit& u) const { return A + ((size_t)(u.e ? NLAT : 0) + (size_t)u.pm * 256) * K * ES; }
    __device__ __forceinline__ unsigned a_row_off(const Unit&, int r) const { return (unsigned)r * (unsigned)K * (unsigned)ES; }
    __device__ __forceinline__ const char* b_tile(const Unit& u) const { return B + ((size_t)(u.e ? 2048 : 0) + (size_t)u.pn * 256) * K * ES; }
};
template <bool GATHER_> struct MoeSched {
    static constexpr bool GATHER = GATHER_, FP8 = true, I8 = false;
    const char* A; const char* B; size_t estride; const LAS int* pre; const LAS int* cnt; const int* list; int K, G, c; int sw, sa;
    __device__ __forceinline__ int scale_w() const { return sw; } __device__ __forceinline__ int scale_a() const { return sa; }
    __device__ __forceinline__ bool next(int i, Unit& u) const {
        const int MT = pre[16]; if (!static_next(i, G, c, MT, 8, u.pm, u.pn)) return false;
        int e = 0;
#pragma unroll
        for (int j = 1; j < 16; ++j) e += (u.pm >= pre[j]) ? 1 : 0;
        u.e = e; u.pos0 = (u.pm - pre[e]) * 256; u.cnt = cnt[e]; return true;
    }
    __device__ __forceinline__ const char* a_tile(const Unit& u) const { return GATHER ? A : A + (size_t)u.pm * 256 * K; }
    __device__ __forceinline__ unsigned a_row_off(const Unit& u, int r) const {
        if (!GATHER) return (unsigned)r * (unsigned)K;
        const int pos = u.pos0 + r; const int t2 = pos < u.cnt ? list[(size_t)u.e * NTOK + pos] : 0;
        return (unsigned)(t2 >> 1) * (unsigned)K;
    }
    __device__ __forceinline__ const char* b_tile(const Unit& u) const { return B + (size_t)u.e * estride + (size_t)u.pn * 256 * K; }
};

typedef int i32x4v __attribute__((ext_vector_type(4)));
typedef int i32x8v __attribute__((ext_vector_type(8)));
__device__ __forceinline__ i32x8v cat8(bf16x8 a, bf16x8 b) { const i32x4v x = __builtin_bit_cast(i32x4v, a), y = __builtin_bit_cast(i32x4v, b); return __builtin_shufflevector(x, y, 0, 1, 2, 3, 4, 5, 6, 7); }
__device__ __forceinline__ void mfma8(f32x4& acc, const i32x8v w, const i32x8v a, const int sw, const int sa) {
    asm volatile("v_mfma_scale_f32_16x16x128_f8f6f4 %0, %1, %2, %0, %3, %4 op_sel_hi:[0,0,0]" : "+v"(acc) : "v"(w), "v"(a), "v"(sw), "v"(sa));
}
template <class Epi, class Sched>
__device__ __forceinline__ void gemm_phase(LAS unsigned char* lds, const int wave_in, const int K, const Sched& S, const Epi& E) {
    const int tid = tid_rebuild(wave_in), wid = wave_in, lane = tid & 63, wr = wid >> 2, wc = wid & 3, fr = lane & 15, fq = lane >> 4;
    constexpr bool F8 = Sched::FP8;
    constexpr bool I8 = Sched::I8;
    constexpr int ES = (F8 || I8) ? 1 : 2;
    const int nt = K * ES / (BK * 2);
    constexpr bool GA = Sched::GATHER;
    unsigned voffB[2];
#pragma unroll
    for (int i = 0; i < 2; ++i) { int R, C; stage_rc(tid * 16 + i * 8192, R, C); const int Rb = (R & ~31) + perm32(R & 31); voffB[i] = (unsigned)(Rb * K * ES + C * 2); }
#define PG8_AOFF(u, h, i, dst) do { int R_, C_; stage_rc(tid * 16 + (i) * 8192, R_, C_); dst = S.a_row_off(u, (h) * 128 + R_) + (unsigned)C_ * 2u; } while (0)
    const size_t kstep = (size_t)(BK * 2);
    const size_t hstep = (size_t)HALF * K * ES;
    const unsigned ldsw = (unsigned)wid * 1024u;
    const int aoff = lds_byte(wr * 64 + fr, fq * 8), boff = lds_byte(wc * 32 + fr, fq * 8);
#define PG8_SA(b, h) (((b) * 2 + (h)) * HTB)
#define PG8_SB(b, h) ((4 + (b) * 2 + (h)) * HTB)
#define PG8_STAGE(bufoff, gbase, voff) do { _Pragma("unroll") for (int _i = 0; _i < 2; ++_i) \
        __builtin_amdgcn_global_load_lds((const unsigned*)((const char*)(gbase) + (voff)[_i]), (LAS unsigned*)(lds + (bufoff) + ldsw + _i * 8192), 16, 0, 0); } while (0)
#define PG8_LDA(dst, b, h) do { _Pragma("unroll") for (int m = 0; m < 4; ++m) _Pragma("unroll") for (int k = 0; k < 2; ++k) dst[m][k] = *(const LAS bf16x8*)(lds + PG8_SA(b, h) + aoff + m * 2048 + k * 1024); } while (0)
#define PG8_LDB(dst, b, h) do { _Pragma("unroll") for (int n = 0; n < 2; ++n) _Pragma("unroll") for (int k = 0; k < 2; ++k) dst[n][k] = *(const LAS bf16x8*)(lds + PG8_SB(b, h) + boff + n * 2048 + k * 1024); } while (0)
#define PG8_MMA(ai, bj, At, Bt) do { __builtin_amdgcn_s_setprio(1); if constexpr (F8) { _Pragma("unroll") for (int m = 0; m < 4; ++m) _Pragma("unroll") for (int n = 0; n < 2; ++n) \
        mfma8(acc[ai][bj][m][n], cat8(Bt[n][0], Bt[n][1]), cat8(At[m][0], At[m][1]), S.scale_w(), S.scale_a()); } else if constexpr (I8) { \
        _Pragma("unroll") for (int m = 0; m < 4; ++m) _Pragma("unroll") for (int n = 0; n < 2; ++n) _Pragma("unroll") for (int k = 0; k < 2; ++k) \
        acc[ai][bj][m][n] = __builtin_bit_cast(f32x4, __builtin_amdgcn_mfma_i32_16x16x64_i8(__builtin_bit_cast(i32x4v, Bt[n][k]), __builtin_bit_cast(i32x4v, At[m][k]), __builtin_bit_cast(i32x4v, acc[ai][bj][m][n]), 0, 0, 0)); } else \
        _Pragma("unroll") for (int m = 0; m < 4; ++m) _Pragma("unroll") for (int n = 0; n < 2; ++n) _Pragma("unroll") for (int k = 0; k < 2; ++k) \
        acc[ai][bj][m][n] = __builtin_amdgcn_mfma_f32_16x16x32_bf16(Bt[n][k], At[m][k], acc[ai][bj][m][n], 0, 0, 0); __builtin_amdgcn_s_setprio(0); } while (0)
#define PG8_WAIT_V(n) asm volatile("s_waitcnt vmcnt(" #n ")" ::: "memory")
#define PG8_WAIT_L(n) asm volatile("s_waitcnt lgkmcnt(" #n ")" ::: "memory")
#define PG8_BAR __builtin_amdgcn_s_barrier()
#define PG8_SCHED __builtin_amdgcn_sched_barrier(0)
    Unit cur, nxt; int ui = 0;
    if (!S.next(0, cur)) return;
#if MK_STAGGER
    { const unsigned long long t0_ = __builtin_amdgcn_s_memrealtime(); const unsigned long long dl_ = (unsigned long long)((blockIdx.x >> 3) & 7) * MK_STAGGER;
      while (__builtin_amdgcn_s_memrealtime() - t0_ < dl_) __builtin_amdgcn_s_sleep(8); }
#endif
    f32x4 acc[2][2][4][2];
#pragma unroll
    for (int a = 0; a < 2; ++a)
#pragma unroll
        for (int b = 0; b < 2; ++b)
#pragma unroll
            for (int m = 0; m < 4; ++m)
#pragma unroll
                for (int n = 0; n < 2; ++n) acc[a][b][m][n] = (f32x4){0.f, 0.f, 0.f, 0.f};
    bf16x8 At[4][2], B0[2][2], B1[2][2];
    unsigned cvo0[2], cvo1[2];
#pragma unroll
    for (int i = 0; i < 2; ++i) { PG8_AOFF(cur, 0, i, cvo0[i]); if (GA) PG8_AOFF(cur, 1, i, cvo1[i]); else cvo1[i] = cvo0[i]; }
    LAS unsigned* toff = (LAS unsigned*)(lds + LX + 5120);
    const size_t ahs = GA ? (size_t)0 : hstep;
    const char* cA = S.a_tile(cur); const char* cB = S.b_tile(cur);
    PG8_STAGE(PG8_SB(0, 0), cB, voffB); PG8_STAGE(PG8_SA(0, 0), cA, cvo0); PG8_STAGE(PG8_SB(0, 1), cB + hstep, voffB); PG8_STAGE(PG8_SA(0, 1), cA + ahs, cvo1);
    if (wr == 1) PG8_BAR;
#if MK_8PHASE
    PG8_WAIT_V(4); PG8_BAR;
#else
    PG8_WAIT_V(0); PG8_BAR;
#endif
    PG8_STAGE(PG8_SB(1, 0), cB + kstep, voffB); PG8_STAGE(PG8_SA(1, 0), cA + kstep, cvo0); PG8_STAGE(PG8_SB(1, 1), cB + hstep + kstep, voffB);
    PG8_WAIT_V(6); PG8_BAR;
    for (;;) {
        const bool has_next = S.next(ui + 1, nxt);
        const char* nA = has_next ? S.a_tile(nxt) : cA; const char* nB = has_next ? S.b_tile(nxt) : cB;
        if (GA && has_next && tid < 256) toff[((ui + 1) & 1) * 256 + tid] = S.a_row_off(nxt, tid);
        for (int t = 0; t < nt; t += 2) {
            const bool last = (t == nt - 2);
            const char* a1 = cA + (size_t)(t + 1) * kstep;
            const char* a2 = last ? nA : cA + (size_t)(t + 2) * kstep; const char* b2 = last ? nB : cB + (size_t)(t + 2) * kstep;
            const char* a3 = a2 + kstep; const char* b3 = b2 + kstep;
#if MK_8PHASE
            PG8_LDB(B0, 0, 0); PG8_SCHED; PG8_LDA(At, 0, 0); PG8_STAGE(PG8_SA(1, 1), a1 + ahs, cvo1);
            PG8_WAIT_L(8); PG8_BAR; PG8_WAIT_L(0); PG8_MMA(0, 0, At, B0); PG8_BAR; PG8_SCHED;
            if (GA && last && has_next) {
#pragma unroll
                for (int i = 0; i < 2; ++i) { int R_, C_; stage_rc(tid * 16 + i * 8192, R_, C_); const int tb_ = ((ui + 1) & 1) * 256; cvo0[i] = toff[tb_ + R_] + (unsigned)C_ * 2u; cvo1[i] = toff[tb_ + 128 + R_] + (unsigned)C_ * 2u; } }
            PG8_LDB(B1, 0, 1); PG8_STAGE(PG8_SB(0, 0), b2, voffB);
            PG8_BAR; PG8_WAIT_L(0); PG8_MMA(0, 1, At, B1); PG8_BAR;
            PG8_LDA(At, 0, 1); PG8_STAGE(PG8_SA(0, 0), a2, cvo0);
            PG8_BAR; PG8_WAIT_L(0); PG8_MMA(1, 0, At, B0); PG8_BAR; PG8_SCHED;
            PG8_STAGE(PG8_SB(0, 1), b2 + hstep, voffB);
            PG8_WAIT_V(6); PG8_BAR; PG8_MMA(1, 1, At, B1); PG8_BAR;
            PG8_LDB(B0, 1, 0); PG8_SCHED; PG8_LDA(At, 1, 0); PG8_STAGE(PG8_SA(0, 1), a2 + ahs, cvo1);
            PG8_WAIT_L(8); PG8_BAR; PG8_WAIT_L(0); PG8_MMA(0, 0, At, B0); PG8_BAR; PG8_SCHED;
            PG8_LDB(B1, 1, 1); PG8_STAGE(PG8_SB(1, 0), b3, voffB);
            PG8_BAR; PG8_WAIT_L(0); PG8_MMA(0, 1, At, B1); PG8_BAR;
            PG8_LDA(At, 1, 1); PG8_STAGE(PG8_SA(1, 0), a3, cvo0);
            PG8_BAR; PG8_WAIT_L(0); PG8_MMA(1, 0, At, B0); PG8_BAR; PG8_SCHED;
            PG8_STAGE(PG8_SB(1, 1), b3 + hstep, voffB);
            PG8_WAIT_V(6); PG8_BAR; PG8_MMA(1, 1, At, B1); PG8_BAR;
#else
            PG8_LDB(B0, 0, 0); PG8_LDB(B1, 0, 1); PG8_SCHED; PG8_LDA(At, 0, 0); PG8_STAGE(PG8_SA(1, 1), a1 + ahs, cvo1);
            PG8_WAIT_L(0); PG8_BAR; PG8_MMA(0, 0, At, B0); PG8_MMA(0, 1, At, B1); PG8_BAR; PG8_SCHED;
            if (GA && last && has_next) {
#pragma unroll
                for (int i = 0; i < 2; ++i) { int R_, C_; stage_rc(tid * 16 + i * 8192, R_, C_); const int tb_ = ((ui + 1) & 1) * 256; cvo0[i] = toff[tb_ + R_] + (unsigned)C_ * 2u; cvo1[i] = toff[tb_ + 128 + R_] + (unsigned)C_ * 2u; } }
            PG8_LDA(At, 0, 1); PG8_STAGE(PG8_SB(0, 0), b2, voffB); PG8_STAGE(PG8_SA(0, 0), a2, cvo0); PG8_STAGE(PG8_SB(0, 1), b2 + hstep, voffB);
            PG8_WAIT_V(6); PG8_WAIT_L(0); PG8_BAR; PG8_MMA(1, 0, At, B0); PG8_MMA(1, 1, At, B1); PG8_BAR; PG8_SCHED;
            PG8_LDB(B0, 1, 0); PG8_LDB(B1, 1, 1); PG8_SCHED; PG8_LDA(At, 1, 0); PG8_STAGE(PG8_SA(0, 1), a2 + ahs, cvo1);
            PG8_WAIT_L(0); PG8_BAR; PG8_MMA(0, 0, At, B0); PG8_MMA(0, 1, At, B1); PG8_BAR; PG8_SCHED;
            PG8_LDA(At, 1, 1); PG8_STAGE(PG8_SB(1, 0), b3, voffB); PG8_STAGE(PG8_SA(1, 0), a3, cvo0); PG8_STAGE(PG8_SB(1, 1), b3 + hstep, voffB);
            PG8_WAIT_V(6); PG8_WAIT_L(0); PG8_BAR; PG8_MMA(1, 0, At, B0); PG8_MMA(1, 1, At, B1); PG8_BAR; PG8_SCHED;
#endif
        }
        if constexpr (F8) asm volatile("s_nop 15\n\ts_nop 15" : "+v"(acc[1][1][0][0]), "+v"(acc[1][1][0][1]), "+v"(acc[1][1][1][0]), "+v"(acc[1][1][1][1]), "+v"(acc[1][1][2][0]), "+v"(acc[1][1][2][1]), "+v"(acc[1][1][3][0]), "+v"(acc[1][1][3][1]) :: "memory");
        int lane_e = lane_id(); asm volatile("" : "+v"(lane_e));
        const int fr_e = lane_e & 15, fq_e = lane_e >> 4;
        bool vt_done = false;
        if constexpr (Epi::VT) {
            if (E.is_v(cur)) {
                const int col_v = wc * 32 + 8 * fq_e;
#pragma unroll
                for (int ai = 0; ai < 2; ++ai) { unsigned w[16];
#pragma unroll
                    for (int n = 0; n < 2; ++n)
#pragma unroll
                        for (int j = 0; j < 4; ++j) {
                            w[4 * n + j] = pack_fp8x4(clamp8(acc[ai][0][0][n][j]), clamp8(acc[ai][0][1][n][j]), clamp8(acc[ai][0][2][n][j]), clamp8(acc[ai][0][3][n][j]));
                            w[8 + 4 * n + j] = pack_fp8x4(clamp8(acc[ai][1][0][n][j]), clamp8(acc[ai][1][1][n][j]), clamp8(acc[ai][1][2][n][j]), clamp8(acc[ai][1][3][n][j])); }
                    E.vstore(cur, ai * HALF + wr * 64, fr_e, col_v, w); }
                vt_done = true;
            }
        }
        if (!vt_done) {
            const int col_e = wc * 32 + 8 * fq_e;
            typename Epi::UPre up; E.upre(cur, col_e, up);
#pragma unroll
            for (int b0 = 0; b0 < 8; b0 += Epi::EB) {
                typename Epi::Pre pre[Epi::EB];
#pragma unroll
                for (int q = 0; q < Epi::EB; ++q) { const int ai = (b0 + q) >> 2, m = (b0 + q) & 3; E.pre(cur, ai * HALF + wr * 64 + m * 16 + fr_e, col_e, pre[q]); }
#pragma unroll
                for (int q = 0; q < Epi::EB; ++q) { const int ai = (b0 + q) >> 2, m = (b0 + q) & 3;
                    float lo[8], hi[8];
#pragma unroll
                    for (int n = 0; n < 2; ++n)
#pragma unroll
                        for (int j = 0; j < 4; ++j) {
                            if constexpr (I8) { lo[4 * n + j] = (float)__float_as_int(acc[ai][0][m][n][j]); hi[4 * n + j] = (float)__float_as_int(acc[ai][1][m][n][j]); }
                            else { lo[4 * n + j] = acc[ai][0][m][n][j]; hi[4 * n + j] = acc[ai][1][m][n][j]; } }
                    E.put(cur, ai * HALF + wr * 64 + m * 16 + fr_e, col_e, lo, hi, pre[q], up);
                }
                asm volatile("" ::: "memory");
            }
        }
        if (!has_next) break;
#pragma unroll
        for (int a = 0; a < 2; ++a)
#pragma unroll
            for (int b = 0; b < 2; ++b)
#pragma unroll
                for (int m = 0; m < 4; ++m)
#pragma unroll
                    for (int n = 0; n < 2; ++n) acc[a][b][m][n] = (f32x4){0.f, 0.f, 0.f, 0.f};
        cur = nxt; cA = nA; cB = nB; ++ui;
    }
    PG8_WAIT_V(0);
    if (wr == 0) PG8_BAR;
    PG8_BAR;
#undef PG8_AOFF
#undef PG8_SA
#undef PG8_SB
#undef PG8_STAGE
#undef PG8_LDA
#undef PG8_LDB
#undef PG8_MMA
#undef PG8_WAIT_V
#undef PG8_WAIT_L
#undef PG8_BAR
#undef PG8_SCHED
}

template <class Epi, class Sched>
__device__ __forceinline__ void gemm_naive(const int K, const Sched& S, const Epi& E) {
    Unit u;
    for (int i = 0; S.next(i, u); ++i) {
        const char* At = S.a_tile(u); const char* Bt = S.b_tile(u);
        for (int item = threadIdx.x; item < 4096; item += 512) {
            const int r = item & 255, c = (item >> 8) * 8;
            const bf16_t* a = (const bf16_t*)(At + S.a_row_off(u, r));
            float lo[8], hi[8];
#pragma unroll
            for (int j = 0; j < 8; ++j) { lo[j] = 0.f; hi[j] = 0.f; }
            for (int k = 0; k < K; k += 8) {
                float av[8]; unpack8(*(const u32x4*)(a + k), av);
#pragma unroll
                for (int j = 0; j < 8; ++j) { float bv[8];
                    unpack8(*(const u32x4*)((const bf16_t*)Bt + (size_t)(c + j) * K + k), bv);
#pragma unroll
                    for (int q = 0; q < 8; ++q) lo[j] += av[q] * bv[q];
                    unpack8(*(const u32x4*)((const bf16_t*)Bt + (size_t)(128 + c + j) * K + k), bv);
#pragma unroll
                    for (int q = 0; q < 8; ++q) hi[j] += av[q] * bv[q]; }
            }
            { typename Epi::UPre up; E.upre(u, c, up); typename Epi::Pre pr; E.pre(u, r, c, pr); E.put(u, r, c, lo, hi, pr, up); }
        }
    }
}
template <class Epi, class Sched>
__device__ __forceinline__ void gemm_run(LAS unsigned char* lds, const int wave_in, const int K, const Sched& S, const Epi& E) {
#if MK_NAIVE
    (void)wave_in; gemm_naive<Epi, Sched>(K, S, E);
#else
    gemm_phase<Epi, Sched>(lds, wave_in, K, S, E);
#endif
}

struct EpiIn0 {
    static constexpr int EB = 8; static constexpr bool VT = false; struct Pre { float rs; }; struct UPre {};
    bf16_t* P; bf16_t* GB; bf16_t* GY; bf16_t* XB; const float* asc;
    __device__ __forceinline__ void upre(const Unit&, int, UPre&) const {}
    __device__ __forceinline__ void pre(const Unit& u, int r, int, Pre& p) const { p.rs = I8_G1 ? asc[(size_t)u.pm * 256 + r] * W1DQ : 1.0f; }
    __device__ __forceinline__ void put(const Unit& u, int r, int c, const float (&lo_)[8], const float (&hi_)[8], const Pre& p, const UPre&) const {
        const size_t t = (size_t)u.pm * 256 + r;
        float lo[8], hi[8];
#pragma unroll
        for (int j = 0; j < 8; ++j) { lo[j] = I8_G1 ? lo_[j] * p.rs : lo_[j]; hi[j] = I8_G1 ? hi_[j] * p.rs : hi_[j]; }
        if (u.pn < 8) { float v[8];
#pragma unroll
            for (int j = 0; j < 8; ++j) v[j] = lo[j] * hi[j];
            st16((P + t * 1024 + u.pn * 128 + c), pack8(v)); }
        else if (u.pn < 12) { bf16_t* d = GB + t * 1024 + (u.pn - 8) * 256 + c; st16(d, pack8(lo)); st16((d + 128), pack8(hi)); }
        else if (u.pn < 16) { float a[8], b[8];
#pragma unroll
            for (int j = 0; j < 8; ++j) { a[j] = fgelu_tanh(lo[j]); b[j] = fgelu_tanh(hi[j]); }
            bf16_t* d = GY + t * 1024 + (u.pn - 12) * 256 + c; st16(d, pack8(a)); st16((d + 128), pack8(b)); }
        else { bf16_t* d = XB + t * 1024 + (u.pn - 16) * 256 + c; st16(d, pack8(lo)); st16((d + 128), pack8(hi)); }
    }
};
template <bool F32BASE> struct EpiRes {
    static constexpr int EB = 4; static constexpr bool VT = false;
    struct UPre { f32x4 g[4]; };
    struct Pre { u32x4 x[F32BASE ? 4 : 2]; };
    const float* base_lat; const float* base_ctx; bf16_t* XR; const float* g1;
    __device__ __forceinline__ void upre(const Unit& u, int c, UPre& up) const {
        const float* gp = g1 + (size_t)modrow_of(u.pm * 256) * MODW + u.pn * 256 + c;
        up.g[0] = *(const f32x4*)gp; up.g[1] = *(const f32x4*)(gp + 4); up.g[2] = *(const f32x4*)(gp + 128); up.g[3] = *(const f32x4*)(gp + 132);
    }
    __device__ __forceinline__ void pre(const Unit& u, int r, int c, Pre& p) const {
        const int t0 = u.pm * 256, col = u.pn * 256 + c;
        if (F32BASE) { const float* bp = t0 < NLAT ? base_lat + (size_t)(t0 + r) * D + col : base_ctx + (size_t)(t0 - NLAT + r) * D + col;
            p.x[0] = *(const u32x4*)bp; p.x[1] = *(const u32x4*)(bp + 4); p.x[2] = *(const u32x4*)(bp + 128); p.x[3] = *(const u32x4*)(bp + 132); }
        else { const bf16_t* dp = XR + (size_t)(t0 + r) * D + col; p.x[0] = *(const u32x4*)dp; p.x[1] = *(const u32x4*)(dp + 128); }
    }
    __device__ __forceinline__ void put(const Unit& u, int r, int c, const float (&lo)[8], const float (&hi)[8], const Pre& p, const UPre& up) const {
        const int t0 = u.pm * 256, col = u.pn * 256 + c;
        float xl[8], xh[8];
        if (F32BASE) {
#pragma unroll
            for (int j = 0; j < 4; ++j) { xl[j] = __uint_as_float(p.x[0][j]); xl[4 + j] = __uint_as_float(p.x[1][j]); xh[j] = __uint_as_float(p.x[2][j]); xh[4 + j] = __uint_as_float(p.x[3][j]); } }
        else { unpack8(p.x[0], xl); unpack8(p.x[1], xh); }
#pragma unroll
        for (int j = 0; j < 4; ++j) { xl[j] += up.g[0][j] * lo[j]; xl[4 + j] += up.g[1][j] * lo[4 + j]; xh[j] += up.g[2][j] * hi[j]; xh[4 + j] += up.g[3][j] * hi[4 + j]; }
        bf16_t* dp = XR + (size_t)(t0 + r) * D + col;
        st16(dp, pack8(xl)); st16((dp + 128), pack8(xh));
    }
};
struct EpiGU {
    static constexpr int EB = 8; static constexpr bool VT = false; struct Pre {}; struct UPre {};
    unsigned char* hid;
    __device__ __forceinline__ void upre(const Unit&, int, UPre&) const {}
    __device__ __forceinline__ void pre(const Unit&, int, int, Pre&) const {}
    __device__ __forceinline__ void put(const Unit& u, int r, int c, const float (&lo)[8], const float (&hi)[8], const Pre&, const UPre&) const {
        float v[8];
#pragma unroll
        for (int j = 0; j < 8; ++j) v[j] = clamp8(lo[j] * __builtin_amdgcn_rcpf(1.0f + __builtin_amdgcn_exp2f(-lo[j])) * hi[j]);
        u32x2 w; w.x = pack_fp8x4(v[0], v[1], v[2], v[3]); w.y = pack_fp8x4(v[4], v[5], v[6], v[7]);
        *(u32x2*)(hid + ((size_t)u.pm * 256 + r) * FF + u.pn * 128 + c) = w;
    }
};
struct EpiDN {
    static constexpr int EB = 8; static constexpr bool VT = false; struct Pre { int t2; float g; }; struct UPre {};
    bf16_t* Y; const int* list; const float* listg;
    __device__ __forceinline__ void upre(const Unit&, int, UPre&) const {}
    __device__ __forceinline__ void pre(const Unit& u, int r, int, Pre& p) const {
        const int pos = u.pos0 + r;
        const int t2 = list[(size_t)u.e * NTOK + pos]; p.g = listg[(size_t)u.e * NTOK + pos]; p.t2 = pos < u.cnt ? t2 : -1;
    }
    __device__ __forceinline__ void put(const Unit& u, int r, int c, const float (&lo)[8], const float (&hi)[8], const Pre& p, const UPre&) const {
        const int t2 = p.t2; const float g = p.g; if (t2 < 0) return;
        float a[8], b[8];
#if F8_Y
        const float g8 = g * Y8_SCALE;
#pragma unroll
        for (int j = 0; j < 8; ++j) { a[j] = clamp8(g8 * lo[j]); b[j] = clamp8(g8 * hi[j]); }
        unsigned char* d = (unsigned char*)Y + ((size_t)(t2 & 1) * NTOK + (t2 >> 1)) * D + u.pn * 256 + 2 * c;
        u32x4 w; w.x = pack_fp8x4(a[0], a[1], a[2], a[3]); w.y = pack_fp8x4(a[4], a[5], a[6], a[7]); w.z = pack_fp8x4(b[0], b[1], b[2], b[3]); w.w = pack_fp8x4(b[4], b[5], b[6], b[7]);
        *(u32x4*)d = w;
#else
#pragma unroll
        for (int j = 0; j < 8; ++j) { a[j] = g * lo[j]; b[j] = g * hi[j]; }
        bf16_t* d = Y + ((size_t)(t2 & 1) * NTOK + (t2 >> 1)) * D + u.pn * 256 + c;
        st16(d, pack8(a)); st16((d + 128), pack8(b));
#endif
    }
};
struct EpiQKV {
    static constexpr int EB = 2; static constexpr bool VT = F8_PV != 0; struct Pre { f32x4 c0, c1, s0, s1; }; struct UPre {};
    bf16_t* Q; bf16_t* Kb; bf16_t* Vb; const float* ropec; const float* ropes;
    __device__ __forceinline__ bool is_v(const Unit& u) const { return u.pn + 8 * u.e >= 16; }
    __device__ __forceinline__ void vstore(const Unit& u, int r0, int fr, int c, const unsigned (&w)[16]) const {
        const int ctx = u.e, t0 = u.pm * 256 + r0, png = u.pn + 8 * ctx;
        const int b = ctx ? (t0 >> 8) : (t0 >> 11), kv0 = ctx ? (t0 & 255) : CTXL + (t0 & 2047);
        unsigned char* vt = (unsigned char*)Vb + ((size_t)(b * 8 + (png - 16)) * 256 + c) * KVL + kv0 + 4 * fr;
#pragma unroll
        for (int j = 0; j < 8; ++j) { *(unsigned*)(vt + (size_t)j * KVL) = w[j]; *(unsigned*)(vt + (size_t)(128 + j) * KVL) = w[8 + j]; }
    }
    __device__ __forceinline__ void upre(const Unit&, int, UPre&) const {}
    __device__ __forceinline__ void pre(const Unit& u, int r, int c, Pre& p) const {
        { const int s = (u.pm * 256 + r) & 2047, a = (c >> 5) & 1, j0 = c & 31, pos = a ? (s & 63) : (s >> 6);
            p.c0 = *(const f32x4*)(ropec + pos * 32 + j0); p.c1 = *(const f32x4*)(ropec + pos * 32 + j0 + 4); p.s0 = *(const f32x4*)(ropes + pos * 32 + j0); p.s1 = *(const f32x4*)(ropes + pos * 32 + j0 + 4); }
    }
    __device__ __forceinline__ void put(const Unit& u, int r, int c, const float (&lo)[8], const float (&hi)[8], const Pre& p, const UPre&) const {
        const int ctx = u.e, t = u.pm * 256 + r, png = u.pn + 8 * ctx;
        int b, s; size_t kvrow;
        if (ctx) { b = t >> 8; s = t & 255; kvrow = (size_t)b * KVL + s; } else { b = t >> 11; s = t & 2047; kvrow = (size_t)b * KVL + CTXL + s; }
        if (png < 16) {
            const int head = png & 7, m = c >> 6, a = (c >> 5) & 1, j0 = c & 31;
            float ol[8], oh[8];
            if (!ctx) { const f32x4 c0 = p.c0, c1 = p.c1, s0 = p.s0, s1 = p.s1;
#pragma unroll
                for (int j = 0; j < 8; ++j) { const float cs = j < 4 ? c0[j & 3] : c1[j & 3], sn = j < 4 ? s0[j & 3] : s1[j & 3]; ol[j] = lo[j] * cs - hi[j] * sn; oh[j] = hi[j] * cs + lo[j] * sn; } }
            else {
#pragma unroll
                for (int j = 0; j < 8; ++j) { ol[j] = lo[j]; oh[j] = hi[j]; } }
#if F8_QK
            unsigned char* d = (png < 8 ? (unsigned char*)Q + (size_t)t * D : (unsigned char*)Kb + kvrow * D) + head * 256 + m * 128 + a * 64 + (j0 >> 3) * 16;
            u32x4 w; w.x = pack_fp8x4(clamp8(ol[0]), clamp8(ol[1]), clamp8(ol[2]), clamp8(ol[3])); w.y = pack_fp8x4(clamp8(ol[4]), clamp8(ol[5]), clamp8(ol[6]), clamp8(ol[7]));
            w.z = pack_fp8x4(clamp8(oh[0]), clamp8(oh[1]), clamp8(oh[2]), clamp8(oh[3])); w.w = pack_fp8x4(clamp8(oh[4]), clamp8(oh[5]), clamp8(oh[6]), clamp8(oh[7]));
            *(u32x4*)d = w;
#else
            bf16_t* d = (png < 8 ? Q + (size_t)t * D : Kb + kvrow * D) + head * 256 + m * 128 + a * 64 + j0;
            st16(d, pack8(ol)); st16((d + 32), pack8(oh));
#endif
        } else {
#if F8_PV
            unsigned char* vt = (unsigned char*)Vb + ((size_t)(b * 8 + (png - 16)) * 256 + c) * KVL + (kvrow - (size_t)b * KVL);
#pragma unroll
            for (int j = 0; j < 8; ++j) { vt[(size_t)j * KVL] = (unsigned char)pack_fp8x1(clamp8(lo[j])); vt[(size_t)(128 + j) * KVL] = (unsigned char)pack_fp8x1(clamp8(hi[j])); }
#else
            bf16_t* d = Vb + kvrow * D + (png - 16) * 256 + c; st16(d, pack8(lo)); st16((d + 128), pack8(hi));
#endif
        }
    }
};
}

__device__ __forceinline__ void scan_phase(const Frame& F, const Params& p) {
    unsigned char* ws = F.ws;
    const bf16_t* P = (const bf16_t*)(ws + WS_R1); const bf16_t* GB = P + (size_t)NTOK * 1024; const bf16_t* GY = GB + (size_t)NTOK * 1024; const bf16_t* XB = GY + (size_t)NTOK * 1024;
    bf16_t* A3 = (bf16_t*)(ws + WS_HB);
    float* HS = (float*)(ws + WS_HID);
    const int tid = F.tid, lane = F.lane, w = F.wave;
    {
        const float* cw = inptr(p, 10);
        for (int it = F.bx * 512 + tid; it < NTOK * 128; it += F.G * 512) {
            const int t = it >> 7, ch = (it & 127) * 8;
            int s, len; if (t < NLAT) { s = t & 2047; len = SEQ; } else { s = (t - NLAT) & 255; len = CTXL; }
            float pm[8], pc[8], pp[8], gb[8], o[8];
            unpack8(*(const u32x4*)(P + (size_t)t * 1024 + ch), pc);
            if (s >= 1) unpack8(*(const u32x4*)(P + (size_t)(t - 1) * 1024 + ch), pm); else {
#pragma unroll
                for (int j = 0; j < 8; ++j) pm[j] = 0.f; }
            if (s + 1 < len) unpack8(*(const u32x4*)(P + (size_t)(t + 1) * 1024 + ch), pp); else {
#pragma unroll
                for (int j = 0; j < 8; ++j) pp[j] = 0.f; }
            unpack8(*(const u32x4*)(GB + (size_t)t * 1024 + ch), gb);
#pragma unroll
            for (int j = 0; j < 8; ++j) o[j] = gb[j] * (cw[ch + j] * pm[j] + cw[1024 + ch + j] * pc[j] + cw[2048 + ch + j] * pp[j]);
            if (F8_G3) { u32x2 w8; w8.x = pack_fp8x4(clamp8(A8_SCALE * o[0]), clamp8(A8_SCALE * o[1]), clamp8(A8_SCALE * o[2]), clamp8(A8_SCALE * o[3])); w8.y = pack_fp8x4(clamp8(A8_SCALE * o[4]), clamp8(A8_SCALE * o[5]), clamp8(A8_SCALE * o[6]), clamp8(A8_SCALE * o[7]));
                *(u32x2*)((unsigned char*)A3 + (size_t)t * D + ch) = w8; }
            else *(u32x4*)(A3 + (size_t)t * D + ch) = pack8(o);
        }
    }
    LAS unsigned char* lds = F.lds;
    LAS bf16_t* Ush = (LAS bf16_t*)lds;
    LAS bf16_t* Gsh = (LAS bf16_t*)(lds + 34816);
    LAS float* Ash = (LAS float*)(lds + 69632); LAS float* Bsh = (LAS float*)(lds + 102400);
    LAS float* SA = (LAS float*)(lds + 135168); LAS float* SB = (LAS float*)(lds + 137216); LAS float* carry = (LAS float*)(lds + 139264);
    for (int unit = F.bx; unit < 256; unit += F.G) {
        const int b = unit >> 4, hd = (unit >> 1) & 7, half = unit & 1;
        const int cg = (tid & 15) * 8, chg = hd * 128 + cg;
        LAS float* cwl = (LAS float*)(lds + 139520);
        { const float* cbw = inptr(p, 11); const float* cbb = inptr(p, 12);
          __syncthreads();
          cwl[tid] = cbw[(tid >> 7) * 1024 + hd * 128 + (tid & 127)]; if (tid < 128) cwl[512 + tid] = cbb[hd * 128 + tid];
          __syncthreads(); }
        const int tb = w & 3, cbk = w >> 2, r32 = lane & 31, hi = lane >> 5;
        const int chl = cbk * 32 + r32, chglob = hd * 128 + half * 64 + chl;
        const int sch = tid & 63, chunk = tid >> 6, schglob = hd * 128 + half * 64 + sch;
        for (int dir = 0; dir < 2; ++dir) {
            const bf16_t* gw = (const bf16_t*)(ws + WS_GW) + ((size_t)((dir * 8 + hd) * 2 + half) * 128) * 128;
            __syncthreads();
#pragma unroll
            for (int it = 0; it < 4; ++it) { const int q = tid + 512 * it, row = q >> 4, pc = q & 15; *(LAS u32x4*)(Gsh + row * 136 + pc * 8) = *(const u32x4*)(gw + (size_t)row * 128 + pc * 8); }
            const float ba = inptr(p, 14)[dir * 1024 + chglob], bi = inptr(p, 16)[dir * 1024 + chglob];
            const float cl = 8.0f * log1pf(expf(-(inptr(p, 17)[dir * 1024 + chglob])));
            if (tid < 64) carry[tid] = 0.f;
            __syncthreads();
            for (int ti = 0; ti < 18; ++ti) {
                int seg_ctx, s0;
                if (ti < 2) { seg_ctx = 1; s0 = dir == 0 ? ti * 128 : (1 - ti) * 128; } else { seg_ctx = 0; s0 = dir == 0 ? (ti - 2) * 128 : (17 - ti) * 128; }
                const int len = seg_ctx ? CTXL : SEQ; const size_t row0 = seg_ctx ? (size_t)NLAT + b * CTXL : (size_t)b * SEQ;
                {
                    const int g4 = (tid >> 4) * 4;
                    u32x4 xp[7];
#pragma unroll
                    for (int r = 0; r < 7; ++r) { const int sq = s0 + g4 + r - 2; xp[r] = (u32x4){0u, 0u, 0u, 0u};
                        if (sq >= 0 && sq < len) xp[r] = *(const u32x4*)(XB + (row0 + sq) * 1024 + chg); }
                    float uacc[4][8];
                    { const f32x4 b0 = *(const LAS f32x4*)(cwl + 512 + cg), b1 = *(const LAS f32x4*)(cwl + 512 + cg + 4);
#pragma unroll
                      for (int i = 0; i < 4; ++i)
#pragma unroll
                        for (int j = 0; j < 4; ++j) { uacc[i][j] = b0[j]; uacc[i][4 + j] = b1[j]; } }
#pragma unroll
                    for (int r = 0; r < 7; ++r) { float xv[8]; unpack8(xp[r], xv);
#pragma unroll
                        for (int i = 0; i < 4; ++i) { const int q = r - i;
                            if (q >= 0 && q < 4) { const f32x4 w0 = *(const LAS f32x4*)(cwl + q * 128 + cg), w1 = *(const LAS f32x4*)(cwl + q * 128 + cg + 4);
#pragma unroll
                                for (int j = 0; j < 4; ++j) { uacc[i][j] += w0[j] * xv[j]; uacc[i][4 + j] += w1[j] * xv[4 + j]; } } } }
#pragma unroll
                    for (int i = 0; i < 4; ++i) *(LAS u32x4*)(Ush + (g4 + i) * 136 + cg) = pack8(uacc[i]);
                }
                __syncthreads();
                f32x16 ar = {}, ai = {};
#pragma unroll
                for (int ks = 0; ks < 8; ++ks) { const bf16x8 af = *(const LAS bf16x8*)(Ush + (tb * 32 + r32) * 136 + ks * 16 + hi * 8);
                    const bf16x8 br = *(const LAS bf16x8*)(Gsh + (cbk * 32 + r32) * 136 + ks * 16 + hi * 8), bi8 = *(const LAS bf16x8*)(Gsh + (64 + cbk * 32 + r32) * 136 + ks * 16 + hi * 8);
                    ar = __builtin_amdgcn_mfma_f32_32x32x16_bf16(af, br, ar, 0, 0, 0); ai = __builtin_amdgcn_mfma_f32_32x32x16_bf16(af, bi8, ai, 0, 0, 0); }
#pragma unroll
                for (int rg = 0; rg < 16; ++rg) { const int tok = tb * 32 + (rg & 3) + 8 * (rg >> 2) + 4 * hi;
                    const float rr = fsigmoid(ar[rg] + ba), ii = fsigmoid(ai[rg] + bi);
                    const float la = -cl * rr, a = __expf(la);
                    const float om = 1.0f - a * a;
                    const float uu = bf2f(Ush[tok * 136 + half * 64 + chl]);
                    Ash[tok * 64 + chl] = a; Bsh[tok * 64 + chl] = __builtin_amdgcn_sqrtf(om) * ii * uu; }
                __syncthreads();
                {
                    const int tile_id = seg_ctx ? (s0 >> 7) : 2 + (s0 >> 7);
                    float* hsp = HS + (((size_t)unit * 18 + tile_id) * 512 + tid) * 16;
                    const size_t rowc = row0 + s0 + chunk * 16;
                    f32x4 hf4[4]; unsigned short gyv[16];
                    if (dir == 1) {
#pragma unroll
                        for (int q = 0; q < 4; ++q) hf4[q] = *(const f32x4*)(hsp + 4 * q);
#pragma unroll
                        for (int i = 0; i < 16; ++i) gyv[i] = GY[(rowc + i) * 1024 + schglob];
                    }
                    float av[16], bv[16];
#pragma unroll
                    for (int i = 0; i < 16; ++i) { av[i] = Ash[(chunk * 16 + i) * 64 + sch]; bv[i] = Bsh[(chunk * 16 + i) * 64 + sch]; }
                    float Aa = 1.f, Hh = 0.f;
                    if (dir == 0) {
#pragma unroll
                        for (int i = 0; i < 16; ++i) { Hh = av[i] * Hh + bv[i]; Aa *= av[i]; } }
                    else {
#pragma unroll
                        for (int i = 15; i >= 0; --i) { Hh = av[i] * Hh + bv[i]; Aa *= av[i]; } }
                    SA[chunk * 64 + sch] = Aa; SB[chunk * 64 + sch] = Hh;
                    __syncthreads();
                    float c = carry[sch];
                    if (dir == 0) { for (int j = 0; j < chunk; ++j) c = SA[j * 64 + sch] * c + SB[j * 64 + sch]; }
                    else { for (int j = 7; j > chunk; --j) c = SA[j * 64 + sch] * c + SB[j * 64 + sch]; }
                    __syncthreads();
                    if (chunk == (dir == 0 ? 7 : 0)) carry[sch] = Aa * c + Hh;
                    float h = c;
                    if (dir == 0) {
                        float hv[16];
#pragma unroll
                        for (int i = 0; i < 16; ++i) { h = av[i] * h + bv[i]; hv[i] = h; }
#pragma unroll
                        for (int q = 0; q < 4; ++q) *(f32x4*)(hsp + 4 * q) = (f32x4){hv[4 * q], hv[4 * q + 1], hv[4 * q + 2], hv[4 * q + 3]};
                    } else {
#pragma unroll
                        for (int i = 15; i >= 0; --i) { h = av[i] * h + bv[i];
                            const float yv = bf2f(gyv[i]) * (hf4[i >> 2][i & 3] + h);
                            if (F8_G3) ((unsigned char*)A3)[(rowc + i) * D + 1024 + schglob] = (unsigned char)pack_fp8x1(clamp8(A8_SCALE * yv));
                            else A3[(rowc + i) * D + 1024 + schglob] = (bf16_t)(cvt_pk_bf16(yv, 0.f) & 0xffffu); }
                    }
                }
            }
            __syncthreads();
        }
    }
}

namespace att {
constexpr int DH = 128, NW = 8, QBLK = 32, KVBLK = 64, LDQ = 2048, LDK = 2048, LDO = 2048, KVL8 = 2304;
constexpr float SCALE = 0.088388347648318440f;
constexpr float THR = F8_PV ? 6.f : 8.f;
#ifndef ATT_SDEPTH
#define ATT_SDEPTH 1
#endif
constexpr int SDEPTH = ATT_SDEPTH;
constexpr int SHM_V = KVBLK * DH * 2, SHM_K = KVBLK * DH * 2;
constexpr int SHM_ATTN = 2 * SHM_V + 2 * SHM_K + NW * 64 * 4 + NW * 32 * 4;
#define KSWZ(row, colB) ((row) * 256 + ((colB) ^ (((row) & 7) << 4)))
#define SBAR() __builtin_amdgcn_sched_barrier(0)
__device__ __forceinline__ int crow(int r, int hi) { return (r & 3) + 8 * (r >> 2) + 4 * hi; }
__device__ __forceinline__ unsigned cvtpk(float lo, float hi) { unsigned r; asm volatile("v_cvt_pk_bf16_f32 %0, %1, %2" : "=v"(r) : "v"(lo), "v"(hi)); return r; }
__device__ __forceinline__ void partialSM(f32x16& p0, f32x16& p1, float& m_reg, float& mn, float& alpha) {
  constexpr float C = SCALE * 1.4426950408889634f;
  float pmax = p0[0]; for (int r = 1; r < 16; ++r) pmax = fmaxf(pmax, p0[r]); for (int r = 0; r < 16; ++r) pmax = fmaxf(pmax, p1[r]);
  { auto rr = __builtin_amdgcn_permlane32_swap(__float_as_uint(pmax), __float_as_uint(pmax), false, false);
    pmax = fmaxf(__uint_as_float(rr[0]), __uint_as_float(rr[1])); }
  if (__builtin_expect(__all(pmax - m_reg <= THR / SCALE), 1)) { mn = m_reg; alpha = 1.f; }
  else { mn = fmaxf(m_reg, pmax); alpha = __builtin_amdgcn_exp2f((m_reg - mn) * C); m_reg = mn; }
  float mnC = -mn * C;
  for (int r = 0; r < 16; ++r) p0[r] = fmaf(p0[r], C, mnC); for (int r = 0; r < 16; ++r) p1[r] = fmaf(p1[r], C, mnC);
  for (int r = 0; r < 16; ++r) p0[r] = __builtin_amdgcn_exp2f(p0[r]);
}
__device__ __forceinline__ void finishSM(f32x16& p0, f32x16& p1, float alpha, float& l_reg, bf16x8& pa0, bf16x8& pa1, bf16x8& pa2, bf16x8& pa3) {
  for (int r = 0; r < 16; ++r) p1[r] = __builtin_amdgcn_exp2f(p1[r]);
  float ps = 0; for (int r = 0; r < 16; ++r) ps += p0[r]; for (int r = 0; r < 16; ++r) ps += p1[r];
  { auto rr = __builtin_amdgcn_permlane32_swap(__float_as_uint(ps), __float_as_uint(ps), false, false);
    ps = __uint_as_float(rr[0]) + __uint_as_float(rr[1]); }
  l_reg = l_reg * alpha + ps;
#define PK4(P, BASE, OUT) do { unsigned a0 = cvtpk(P[BASE + 0], P[BASE + 1]), a1 = cvtpk(P[BASE + 2], P[BASE + 3]);   \
    unsigned b0 = cvtpk(P[BASE + 4], P[BASE + 5]), b1 = cvtpk(P[BASE + 6], P[BASE + 7]);                              \
    auto r0 = __builtin_amdgcn_permlane32_swap(a0, b0, false, false); auto r1 = __builtin_amdgcn_permlane32_swap(a1, b1, false, false); \
    u32x4 w = {r0[0], r1[0], r0[1], r1[1]}; OUT = *reinterpret_cast<bf16x8*>(&w); } while (0)
  PK4(p0, 0, pa0); PK4(p0, 8, pa1); PK4(p1, 0, pa2); PK4(p1, 8, pa3);
#undef PK4
}
__device__ __forceinline__ void qkt(f32x16& p0, f32x16& p1, const bf16_t* Ks, const bf16x8* qr, int r32, int hi) {
  p0 = f32x16{}; p1 = f32x16{};
  for (int d0 = 0; d0 < 8; ++d0) { int cb = (d0 * 16 + hi * 8) * 2;
    bf16x8 b0 = *reinterpret_cast<const bf16x8*>((const char*)Ks + KSWZ(r32, cb));
    bf16x8 b1 = *reinterpret_cast<const bf16x8*>((const char*)Ks + KSWZ(32 + r32, cb));
    p0 = __builtin_amdgcn_mfma_f32_32x32x16_bf16(b0, qr[d0], p0, 0, 0, 0);
    p1 = __builtin_amdgcn_mfma_f32_32x32x16_bf16(b1, qr[d0], p1, 0, 0, 0); }
}
__device__ __forceinline__ int v_st(int k, int c) { const int kk = (k & ~0xC) | ((k & 4) << 1) | ((k & 8) >> 1); return ((kk >> 3) * 4 + (c >> 5)) * 512 + ((kk & 7) * 32 + (c & 31)) * 2; }
__device__ __forceinline__ int v_rd_base(int lane) { return ((lane & 3) << 3) | (((lane >> 2) & 3) << 6) | (((lane >> 4) & 1) << 5) | (((lane >> 5) & 1) << 8); }
constexpr int v_rd_off(int d0, int ks, int half) { return d0 * 512 + ks * 4096 + half * 2048; }
template <int OFF> __device__ __forceinline__ s16x4 tr_read(int vb) {
  s16x4 r; asm volatile("ds_read_b64_tr_b16 %0, %1 offset:%2" : "=&v"(r) : "v"(vb), "i"(OFF) : "memory"); return r;
}
template <int D0> __device__ __forceinline__ void pv_one(f32x16& od, int vb, bf16x8 pa0, bf16x8 pa1, bf16x8 pa2, bf16x8 pa3) {
  const s16x4 l0 = tr_read<v_rd_off(D0, 0, 0)>(vb), h0 = tr_read<v_rd_off(D0, 0, 1)>(vb), l1 = tr_read<v_rd_off(D0, 1, 0)>(vb), h1 = tr_read<v_rd_off(D0, 1, 1)>(vb);
  const s16x4 l2 = tr_read<v_rd_off(D0, 2, 0)>(vb), h2 = tr_read<v_rd_off(D0, 2, 1)>(vb), l3 = tr_read<v_rd_off(D0, 3, 0)>(vb), h3 = tr_read<v_rd_off(D0, 3, 1)>(vb);
  asm volatile("s_waitcnt lgkmcnt(0)" ::: "memory"); SBAR();
#define PK(L, H) (bf16x8){L[0], L[1], L[2], L[3], H[0], H[1], H[2], H[3]}
  od = __builtin_amdgcn_mfma_f32_32x32x16_bf16(pa0, PK(l0, h0), od, 0, 0, 0);
  od = __builtin_amdgcn_mfma_f32_32x32x16_bf16(pa1, PK(l1, h1), od, 0, 0, 0);
  od = __builtin_amdgcn_mfma_f32_32x32x16_bf16(pa2, PK(l2, h2), od, 0, 0, 0);
  od = __builtin_amdgcn_mfma_f32_32x32x16_bf16(pa3, PK(l3, h3), od, 0, 0, 0);
#undef PK
}
__device__ __forceinline__ void pv_d0(f32x16* o, int vb, bf16x8 pa0, bf16x8 pa1, bf16x8 pa2, bf16x8 pa3) {
  pv_one<0>(o[0], vb, pa0, pa1, pa2, pa3); pv_one<1>(o[1], vb, pa0, pa1, pa2, pa3); pv_one<2>(o[2], vb, pa0, pa1, pa2, pa3); pv_one<3>(o[3], vb, pa0, pa1, pa2, pa3);
}
__device__ __forceinline__ void attn_pass(const bf16_t* __restrict__ Qb, const bf16_t* __restrict__ Kh, const bf16_t* __restrict__ Vh, bf16_t* __restrict__ Ob,
                                          float* __restrict__ scr, const int wave_in, const int pass, const float lam, const float onem, const float* __restrict__ subg, int seq, char* lds) {
  const int tid = tid_rebuild(wave_in), wid = wave_in;
  const int lane = tid & 63, r32 = lane & 31, hi = lane >> 5;
  bf16_t* V_lds = (bf16_t*)lds; bf16_t* K_lds = (bf16_t*)(lds + 2 * SHM_V);
  float* wsl = (float*)(lds + 2 * SHM_V + 2 * SHM_K) + wid * 64; float* li_l = wsl; float* al_l = wsl + 32;
  float* rq = (float*)(lds + 2 * SHM_V + 2 * SHM_K + NW * 64 * 4) + wid * 32;
  float m_reg = -1e30f, l_reg = 0; f32x16 o[4] = {}; bf16x8 qr[8];
  const bf16_t* Qw = Qb + (long)(wid * QBLK + r32) * LDQ + hi * 8;
#pragma unroll
  for (int d0 = 0; d0 < 8; ++d0) qr[d0] = *reinterpret_cast<const bf16x8*>(Qw + d0 * 16);
  const int sr = tid >> 4, sc = (tid & 15) * 8, vst0 = v_st(sr, sc), vst1 = v_st(32 + sr, sc);
  const int vb0 = (int)(uintptr_t)V_lds + v_rd_base(lane);
  struct { bf16x8 vs0, vs1, ks0, ks1; } sr_[SDEPTH];
#define SLOAD(i, k0) do { sr_[i].vs0 = *reinterpret_cast<const bf16x8*>(&Vh[(long)((k0) + sr) * LDK + sc]); sr_[i].vs1 = *reinterpret_cast<const bf16x8*>(&Vh[(long)((k0) + 32 + sr) * LDK + sc]); \
    sr_[i].ks0 = *reinterpret_cast<const bf16x8*>(&Kh[(long)((k0) + sr) * LDK + sc]); sr_[i].ks1 = *reinterpret_cast<const bf16x8*>(&Kh[(long)((k0) + 32 + sr) * LDK + sc]); } while (0)
#define SWRITE(b, i) do { *(bf16x8*)((char*)V_lds + (b) * SHM_V + vst0) = sr_[i].vs0;          \
    *(bf16x8*)((char*)V_lds + (b) * SHM_V + vst1) = sr_[i].vs1; int kc = sc * 2;               \
    *(bf16x8*)((char*)K_lds + (b) * SHM_K + KSWZ(sr, kc)) = sr_[i].ks0;                       \
    *(bf16x8*)((char*)K_lds + (b) * SHM_K + KSWZ(32 + sr, kc)) = sr_[i].ks1; } while (0)
#define SWAIT() do { if constexpr (SDEPTH == 2) asm volatile("s_waitcnt vmcnt(4)" ::: "memory"); else asm volatile("s_waitcnt vmcnt(0)" ::: "memory"); } while (0)
#define RESC(a) do { if (__any((a) < 1.f)) { if (hi == 0) al_l[r32] = (a); asm volatile("s_waitcnt lgkmcnt(0)" ::: "memory"); \
    for (int d = 0; d < 4; ++d) for (int r = 0; r < 16; ++r) o[d][r] *= al_l[crow(r, hi)]; } } while (0)
  f32x16 pA0, pA1, pB0, pB1; float mnA, mnB, alA, alB; bf16x8 pa0, pa1, pa2, pa3; const int NT = seq / KVBLK;
  constexpr int SE = 0, SO = SDEPTH - 1;
  SLOAD(SE, 0); asm volatile("s_waitcnt vmcnt(0)" ::: "memory"); SWRITE(0, SE); __syncthreads();
  qkt(pA0, pA1, K_lds, qr, r32, hi); partialSM(pA0, pA1, m_reg, mnA, alA);
  SLOAD(SO, KVBLK); if constexpr (SDEPTH == 2) { if (2 < NT) SLOAD(SE, 2 * KVBLK); }
  SWAIT(); SWRITE(1, SO); __syncthreads();
  for (int j = 1; j + 1 < NT; j += 2) {
    SBAR(); qkt(pB0, pB1, (bf16_t*)((char*)K_lds + SHM_K), qr, r32, hi);
    finishSM(pA0, pA1, alA, l_reg, pa0, pa1, pa2, pa3); SBAR();
    SLOAD(SO, (j + SDEPTH) * KVBLK); SBAR();
    pv_d0(o, vb0, pa0, pa1, pa2, pa3); partialSM(pB0, pB1, m_reg, mnB, alB);
    __syncthreads(); SWAIT(); SWRITE(0, SE);
    RESC(alB); __syncthreads();
    SBAR(); qkt(pA0, pA1, K_lds, qr, r32, hi);
    finishSM(pB0, pB1, alB, l_reg, pa0, pa1, pa2, pa3); SBAR();
    if (SDEPTH == 1 || j + 3 < NT) SLOAD(SE, (j + 1 + SDEPTH) * KVBLK); SBAR();
    pv_d0(o, vb0 + (int)SHM_V, pa0, pa1, pa2, pa3); partialSM(pA0, pA1, m_reg, mnA, alA);
    __syncthreads(); SWAIT(); SWRITE(1, SO);
    RESC(alA); __syncthreads();
  }
  SBAR(); qkt(pB0, pB1, (bf16_t*)((char*)K_lds + SHM_K), qr, r32, hi);
  finishSM(pA0, pA1, alA, l_reg, pa0, pa1, pa2, pa3); SBAR();
  pv_d0(o, vb0, pa0, pa1, pa2, pa3); partialSM(pB0, pB1, m_reg, mnB, alB);
  __syncthreads(); RESC(alB);
  finishSM(pB0, pB1, alB, l_reg, pa0, pa1, pa2, pa3); SBAR();
  pv_d0(o, vb0 + (int)SHM_V, pa0, pa1, pa2, pa3);
  if (hi == 0) li_l[r32] = l_reg; asm volatile("s_waitcnt lgkmcnt(0)" ::: "memory");
  float rli[16];
#pragma unroll
  for (int r = 0; r < 16; ++r) rli[r] = __builtin_amdgcn_rcpf(li_l[crow(r, hi)]);
  typedef __attribute__((address_space(1))) float gf32; typedef __attribute__((address_space(1))) bf16_t gbf16;
  gf32* scr_l = (gf32*)scr; gbf16* Ob_l = (gbf16*)Ob; int lane_e = lane; asm volatile("" : "+s"(scr_l), "+s"(Ob_l), "+v"(lane_e));
  const int r32e = lane_e & 31, hie = lane_e >> 5;
  gf32* S = scr_l + (size_t)wid * 4096 + lane_e + (pass >= 2 ? 32768 : 0);
#define ATT_BASE(ptr, d0) gf32* ptr = S + (d0) * 1024; asm volatile("" : "+v"(ptr))
  if (pass == 0 || pass == 2) {
#pragma unroll
    for (int d0 = 0; d0 < 4; ++d0) { ATT_BASE(dst, d0);
#pragma unroll
      for (int r = 0; r < 16; ++r) dst[r * 64] = o[d0][r] * rli[r]; }
  } else {
    float q[16];
#pragma unroll
    for (int d0 = 0; d0 < 4; ++d0) { ATT_BASE(srcp, d0);
#pragma unroll
      for (int r = 0; r < 16; ++r) { const float c = srcp[r * 64] - lam * o[d0][r] * rli[r]; o[d0][r] = c; q[r] = d0 == 0 ? c * c : q[r] + c * c; }
      asm volatile("" ::: "memory"); }
#pragma unroll
    for (int r = 0; r < 16; ++r) {
#pragma unroll
      for (int off = 1; off <= 16; off <<= 1) q[r] += shfl_xor_l(q[r], off, lane_e); }
    if (pass == 1) {
#pragma unroll
      for (int d0 = 0; d0 < 4; ++d0) { ATT_BASE(dst, d0);
#pragma unroll
        for (int r = 0; r < 16; ++r) dst[r * 64] = o[d0][r]; }
      if (r32e == 0) {
#pragma unroll
        for (int r = 0; r < 16; ++r) rq[hie * 16 + r] = q[r]; }
    } else {
      if (r32e == 0) {
#pragma unroll
        for (int r = 0; r < 16; ++r) rq[hie * 16 + r] = onem * __builtin_amdgcn_rsqf((q[r] + rq[hie * 16 + r]) * (1.0f / 256.0f) + EPS); }
      asm volatile("s_waitcnt lgkmcnt(0)" ::: "memory");
      float g0[4], g1[4];
#pragma unroll
      for (int d0 = 0; d0 < 4; ++d0) { g0[d0] = subg[d0 * 32 + r32e]; g1[d0] = subg[128 + d0 * 32 + r32e]; }
      S = scr_l + (size_t)wid * 4096 + lane_e;
      ATT_BASE(s0a, 0); ATT_BASE(s0b, 1); ATT_BASE(s0c, 2); ATT_BASE(s0d, 3);
#pragma unroll
      for (int r = 0; r < 16; ++r) { const float rs = rq[hie * 16 + r];
        gbf16* orow = Ob_l + (long)(wid * QBLK + crow(r, hie)) * LDO + r32e; asm volatile("" : "+v"(orow) :: "memory");
        const float h0 = s0a[r * 64], h1 = s0b[r * 64], h2 = s0c[r * 64], h3 = s0d[r * 64];
        orow[128 +  0] = (bf16_t)(cvtpk(o[0][r] * rs * g1[0], 0.f) & 0xffffu); orow[128 + 32] = (bf16_t)(cvtpk(o[1][r] * rs * g1[1], 0.f) & 0xffffu);
        orow[128 + 64] = (bf16_t)(cvtpk(o[2][r] * rs * g1[2], 0.f) & 0xffffu); orow[128 + 96] = (bf16_t)(cvtpk(o[3][r] * rs * g1[3], 0.f) & 0xffffu);
        orow[ 0] = (bf16_t)(cvtpk(h0 * rs * g0[0], 0.f) & 0xffffu); orow[32] = (bf16_t)(cvtpk(h1 * rs * g0[1], 0.f) & 0xffffu);
        orow[64] = (bf16_t)(cvtpk(h2 * rs * g0[2], 0.f) & 0xffffu); orow[96] = (bf16_t)(cvtpk(h3 * rs * g0[3], 0.f) & 0xffffu); }
    }
  }
#undef ATT_BASE
#undef SLOAD
#undef SWRITE
#undef SWAIT
#undef RESC
}

constexpr int A2_V = 0, A2_K = 65536, A2_PEX = 98304, A2_MEX = 114688, A2_LEX = 115712, A2_RQ = 117760, A2_LDS = 118784;
#define A2_TR4(D0, l0, h0, l1, h1) const s16x4 l0 = tr_read<v_rd_off(D0, 0, 0)>(vbk), h0 = tr_read<v_rd_off(D0, 0, 1)>(vbk), l1 = tr_read<v_rd_off(D0, 1, 0)>(vbk), h1 = tr_read<v_rd_off(D0, 1, 1)>(vbk)
#define A2_PK(L, H) (bf16x8){L[0], L[1], L[2], L[3], H[0], H[1], H[2], H[3]}
#define A2_MM(od, l0, h0, l1, h1) do { od = __builtin_amdgcn_mfma_f32_32x32x16_bf16(pa, A2_PK(l0, h0), od, 0, 0, 0); od = __builtin_amdgcn_mfma_f32_32x32x16_bf16(pb, A2_PK(l1, h1), od, 0, 0, 0); } while (0)
__device__ __forceinline__ void pv_half(f32x16* o, int vb, int kh, bf16x8 pa, bf16x8 pb) {
  const int vbk = vb + kh * 8192;
  A2_TR4(0, a0, b0, a1, b1); A2_TR4(1, c0, d0, c1, d1);
  asm volatile("s_waitcnt lgkmcnt(4)" ::: "memory"); SBAR(); A2_MM(o[0], a0, b0, a1, b1); SBAR();
  A2_TR4(2, e0, f0, e1, f1);
  asm volatile("s_waitcnt lgkmcnt(4)" ::: "memory"); SBAR(); A2_MM(o[1], c0, d0, c1, d1); SBAR();
  A2_TR4(3, g0, h0, g1, h1);
  asm volatile("s_waitcnt lgkmcnt(4)" ::: "memory"); SBAR(); A2_MM(o[2], e0, f0, e1, f1); SBAR();
  asm volatile("s_waitcnt lgkmcnt(0)" ::: "memory"); SBAR(); A2_MM(o[3], g0, h0, g1, h1);
}
#undef A2_TR4
#undef A2_PK
#undef A2_MM
__device__ __forceinline__ void attn_pass2(const bf16_t* __restrict__ Qb, const bf16_t* __restrict__ Kh, const bf16_t* __restrict__ Vh, bf16_t* __restrict__ Ob,
                                           float* __restrict__ scr, const int wave_in, const int pass, const float lam, const float onem, const float* __restrict__ subg, int seq, char* lds) {
  constexpr float C = SCALE * 1.4426950408889634f;
  const int tid = tid_rebuild(wave_in), wid = wave_in;
  const int lane = tid & 63, r32 = lane & 31, hi = lane >> 5, pair = wid >> 1, rho = wid & 1;
  char* V_lds = lds + A2_V; char* K_lds = lds + A2_K;
  char* pex_own = lds + A2_PEX + wid * 2048; char* pex_par = lds + A2_PEX + (wid ^ 1) * 2048;
  float* mex_own = (float*)(lds + A2_MEX) + wid * 32; float* mex_par = (float*)(lds + A2_MEX) + (wid ^ 1) * 32;
  float* lex = (float*)(lds + A2_LEX) + wid * 64; float* lex_par = (float*)(lds + A2_LEX) + (wid ^ 1) * 64; float* al_l = lex + 32;
  float* rq = (float*)(lds + A2_RQ) + wid * 32; float* rq_par = (float*)(lds + A2_RQ) + (wid ^ 1) * 32;
  float m_reg = -1e30f, l_reg = 0; f32x16 o[4] = {};
#if F8_QK
  pg8::i32x8v q8[2];
  { const unsigned char* Q8w = (const unsigned char*)Qb + (long)(pair * QBLK + r32) * LDQ + hi * 32;
#pragma unroll
    for (int st = 0; st < 2; ++st) q8[st] = pg8::cat8(*reinterpret_cast<const bf16x8*>(Q8w + st * 64), *reinterpret_cast<const bf16x8*>(Q8w + st * 64 + 16)); }
  const int krow8 = tid >> 3, kch8 = tid & 7, krowp8 = F8_PV ? 4 * (krow8 & 15) + (krow8 >> 4) : krow8;
#define K8OFF(row, ch) ((row) * 128 + ((((ch)) ^ (((row) >> 1) & 7)) << 4))
#else
  bf16x8 qr[8];
  const bf16_t* Qw = Qb + (long)(pair * QBLK + r32) * LDQ + hi * 8;
#pragma unroll
  for (int d0 = 0; d0 < 8; ++d0) qr[d0] = *reinterpret_cast<const bf16x8*>(Qw + d0 * 16);
#endif
  const int sr = tid >> 4, sc = (tid & 15) * 8, vst0 = v_st(sr, sc), vst1 = v_st(32 + sr, sc);
  const int vrb = (int)(uintptr_t)V_lds + v_rd_base(lane) + rho * 16384;
  struct Stg { bf16x8 ks0, ks1, v00, v10, v01, v11; } sA, sB;
#if F8_QK
#define SLOADK(T, k0) T.ks0 = *reinterpret_cast<const bf16x8*>((const unsigned char*)Kh + (long)((k0) + krow8) * LDK + kch8 * 16)
#if F8_PV
#define SLN "3"
#else
#define SLN "5"
#endif
#else
#define SLOADK(T, k0) T.ks0 = *reinterpret_cast<const bf16x8*>(&Kh[(long)((k0) + sr) * LDK + sc]); T.ks1 = *reinterpret_cast<const bf16x8*>(&Kh[(long)((k0) + 32 + sr) * LDK + sc])
#define SLN "6"
#endif
#if F8_PV
  const int vrow0 = tid >> 2, vch = tid & 3;
#define V8OFF(row, ch) ((row) * 64 + ((((ch)) ^ (((row) >> 2) & 3)) << 4))
#define SLOAD2(T, k0) do { SLOADK(T, k0); \
    T.v00 = *reinterpret_cast<const bf16x8*>((const unsigned char*)Vh + (long)vrow0 * KVL8 + (k0) + vch * 16); T.v10 = *reinterpret_cast<const bf16x8*>((const unsigned char*)Vh + (long)(128 + vrow0) * KVL8 + (k0) + vch * 16); } while (0)
#else
#define SLOAD2(T, k0) do { SLOADK(T, k0); \
    T.v00 = *reinterpret_cast<const bf16x8*>(&Vh[(long)((k0) + sr) * LDK + sc]); T.v10 = *reinterpret_cast<const bf16x8*>(&Vh[(long)((k0) + 32 + sr) * LDK + sc]); \
    T.v01 = *reinterpret_cast<const bf16x8*>(&Vh[(long)((k0) + sr) * LDK + 128 + sc]); T.v11 = *reinterpret_cast<const bf16x8*>(&Vh[(long)((k0) + 32 + sr) * LDK + 128 + sc]); } while (0)
#endif
#if F8_QK
#define SWRITE_K(T, b) do { *(bf16x8*)(K_lds + (b) * 16384 + K8OFF(krowp8, kch8)) = T.ks0; } while (0)
#else
#define SWRITE_K(T, b) do { const int kc_ = sc * 2; *(bf16x8*)(K_lds + (b) * 16384 + KSWZ(sr, kc_)) = T.ks0; *(bf16x8*)(K_lds + (b) * 16384 + KSWZ(32 + sr, kc_)) = T.ks1; } while (0)
#endif
#if F8_PV
#define SWRITE_V(T, b) do { *(bf16x8*)(V_lds + (b) * 16384 + V8OFF(vrow0, vch)) = T.v00; *(bf16x8*)(V_lds + (b) * 16384 + V8OFF(128 + vrow0, vch)) = T.v10; } while (0)
#define PUB8(P, alpha, pown) do { \
    float ps_ = 0.f; _Pragma("unroll") for (int r = 0; r < 16; ++r) ps_ += P[r]; \
    { auto rr_ = __builtin_amdgcn_permlane32_swap(__float_as_uint(ps_), __float_as_uint(ps_), false, false); ps_ = __uint_as_float(rr_[0]) + __uint_as_float(rr_[1]); } \
    l_reg = l_reg * (alpha) + ps_; \
    { const unsigned d0_ = pack_fp8x4(P[0], P[1], P[2], P[3]), d1_ = pack_fp8x4(P[4], P[5], P[6], P[7]), d2_ = pack_fp8x4(P[8], P[9], P[10], P[11]), d3_ = pack_fp8x4(P[12], P[13], P[14], P[15]); \
      auto r0 = __builtin_amdgcn_permlane32_swap(d0_, d0_, false, false); auto r1 = __builtin_amdgcn_permlane32_swap(d1_, d1_, false, false); \
      auto r2 = __builtin_amdgcn_permlane32_swap(d2_, d2_, false, false); auto r3 = __builtin_amdgcn_permlane32_swap(d3_, d3_, false, false); \
      pown = (pg8::i32x8v){(int)r0[0], (int)r0[1], (int)r1[0], (int)r1[1], (int)r2[0], (int)r2[1], (int)r3[0], (int)r3[1]}; \
      if (hi == 0) { *(u32x4*)(pex_own + r32 * 16) = (u32x4){r0[0], r0[1], r1[0], r1[1]}; *(u32x4*)(pex_own + 512 + r32 * 16) = (u32x4){r2[0], r2[1], r3[0], r3[1]}; } } } while (0)
#define PV8(b, pown) do { const u32x4 qa_ = *(const u32x4*)(pex_par + r32 * 16), qb_ = *(const u32x4*)(pex_par + 512 + r32 * 16); \
    const pg8::i32x8v ppar_ = {(int)qa_[0], (int)qa_[1], (int)qa_[2], (int)qa_[3], (int)qb_[0], (int)qb_[1], (int)qb_[2], (int)qb_[3]}; \
    pg8::i32x8v pA_; _Pragma("unroll") for (int e = 0; e < 8; ++e) pA_[e] = (hi == rho) ? pown[e] : ppar_[e]; \
    _Pragma("unroll") for (int d0 = 0; d0 < 4; ++d0) { const int vr_ = 128 * rho + 32 * d0 + r32; \
      const pg8::i32x8v vf_ = pg8::cat8(*reinterpret_cast<const bf16x8*>(V_lds + (b) * 16384 + V8OFF(vr_, 2 * hi)), *reinterpret_cast<const bf16x8*>(V_lds + (b) * 16384 + V8OFF(vr_, 2 * hi + 1))); \
      o[d0] = __builtin_amdgcn_mfma_scale_f32_32x32x64_f8f6f4(pA_, vf_, o[d0], 0, 0, 0, 0x7f7f7f7f, 0, 0x7f7f7f7f); } } while (0)
#else
#define SWRITE_V(T, b) do { *(bf16x8*)(V_lds + (b) * 32768 + vst0) = T.v00; *(bf16x8*)(V_lds + (b) * 32768 + vst1) = T.v10; \
    *(bf16x8*)(V_lds + (b) * 32768 + 16384 + vst0) = T.v01; *(bf16x8*)(V_lds + (b) * 32768 + 16384 + vst1) = T.v11; } while (0)
#endif
#if F8_QK
#define KFRAG8(b, st) pg8::cat8(*reinterpret_cast<const bf16x8*>(K_lds + (b) * 16384 + K8OFF(32 * rho + r32, 4 * (st) + 2 * hi)), *reinterpret_cast<const bf16x8*>(K_lds + (b) * 16384 + K8OFF(32 * rho + r32, 4 * (st) + 2 * hi + 1)))
#define MFMA8(kf, st, Pin) __builtin_amdgcn_mfma_scale_f32_32x32x64_f8f6f4(kf, q8[st], Pin, 0, 0, 0, 0x7f7f7f7f, 0, 0x7f7f7f7f)
#define QKT2(P, b) do { const pg8::i32x8v k0_ = KFRAG8(b, 0), k1_ = KFRAG8(b, 1); P = MFMA8(k0_, 0, f32x16{}); P = MFMA8(k1_, 1, P); } while (0)
#define QKT2X(P, b, PP, mref) do { const float mnC_ = -(mref) * C; const pg8::i32x8v k0_ = KFRAG8(b, 0), k1_ = KFRAG8(b, 1); \
    SBAR(); _Pragma("unroll") for (int r = 0; r < 8; ++r) PP[r] = __builtin_amdgcn_exp2f(fmaf(PP[r], C, mnC_)); SBAR(); \
    P = MFMA8(k0_, 0, f32x16{}); SBAR(); \
    _Pragma("unroll") for (int r = 8; r < 16; ++r) PP[r] = __builtin_amdgcn_exp2f(fmaf(PP[r], C, mnC_)); SBAR(); \
    P = MFMA8(k1_, 1, P); SBAR(); } while (0)
#else
#define QKT2(P, b) do { P = f32x16{}; _Pragma("unroll") for (int d0 = 0; d0 < 8; ++d0) { const int cb_ = (d0 * 16 + hi * 8) * 2; \
    const bf16x8 kf_ = *reinterpret_cast<const bf16x8*>(K_lds + (b) * 16384 + KSWZ(32 * rho + r32, cb_)); P = __builtin_amdgcn_mfma_f32_32x32x16_bf16(kf_, qr[d0], P, 0, 0, 0); } } while (0)
#define KFRAG2(b, d0) (*reinterpret_cast<const bf16x8*>(K_lds + (b) * 16384 + KSWZ(32 * rho + r32, ((d0) * 16 + hi * 8) * 2)))
#define QKT2X(P, b, PP, mref) do { const float mnC_ = -(mref) * C; bf16x8 kfa_ = KFRAG2(b, 0), kfb_ = KFRAG2(b, 1); P = f32x16{}; \
    _Pragma("unroll") for (int d0 = 0; d0 < 8; d0 += 2) { \
      SBAR(); PP[2 * d0] = __builtin_amdgcn_exp2f(fmaf(PP[2 * d0], C, mnC_)); PP[2 * d0 + 1] = __builtin_amdgcn_exp2f(fmaf(PP[2 * d0 + 1], C, mnC_)); SBAR(); \
      P = __builtin_amdgcn_mfma_f32_32x32x16_bf16(kfa_, qr[d0], P, 0, 0, 0); SBAR(); if (d0 + 2 < 8) kfa_ = KFRAG2(b, d0 + 2); \
      SBAR(); PP[2 * d0 + 2] = __builtin_amdgcn_exp2f(fmaf(PP[2 * d0 + 2], C, mnC_)); PP[2 * d0 + 3] = __builtin_amdgcn_exp2f(fmaf(PP[2 * d0 + 3], C, mnC_)); SBAR(); \
      P = __builtin_amdgcn_mfma_f32_32x32x16_bf16(kfb_, qr[d0 + 1], P, 0, 0, 0); SBAR(); if (d0 + 3 < 8) kfb_ = KFRAG2(b, d0 + 3); } } while (0)
#endif
#define ROWMAX2(P, out) do { float pm_ = P[0]; _Pragma("unroll") for (int r = 1; r < 16; ++r) pm_ = fmaxf(pm_, P[r]); \
    auto rr_ = __builtin_amdgcn_permlane32_swap(__float_as_uint(pm_), __float_as_uint(pm_), false, false); out = fmaxf(__uint_as_float(rr_[0]), __uint_as_float(rr_[1])); } while (0)
#define DECIDE2(pm_own, alpha_out) do { const float pj_ = fmaxf(pm_own, mex_par[r32]); \
    if (__builtin_expect(__all(pj_ - m_reg <= THR / SCALE), 1)) { alpha_out = 1.f; } else { const float mn_ = fmaxf(m_reg, pj_); alpha_out = __builtin_amdgcn_exp2f((m_reg - mn_) * C); m_reg = mn_; } } while (0)
#define EXP2PUB(P, mref, alpha, pa_a, pa_b) do { const float mnC_ = -(mref) * C; _Pragma("unroll") for (int r = 0; r < 16; ++r) P[r] = __builtin_amdgcn_exp2f(fmaf(P[r], C, mnC_)); \
    float ps_ = 0.f; _Pragma("unroll") for (int r = 0; r < 16; ++r) ps_ += P[r]; \
    { auto rr_ = __builtin_amdgcn_permlane32_swap(__float_as_uint(ps_), __float_as_uint(ps_), false, false); ps_ = __uint_as_float(rr_[0]) + __uint_as_float(rr_[1]); } \
    l_reg = l_reg * (alpha) + ps_; \
    { unsigned a0 = cvtpk(P[0], P[1]), a1 = cvtpk(P[2], P[3]), b0 = cvtpk(P[4], P[5]), b1 = cvtpk(P[6], P[7]); \
      auto r0 = __builtin_amdgcn_permlane32_swap(a0, b0, false, false); auto r1 = __builtin_amdgcn_permlane32_swap(a1, b1, false, false); u32x4 w_ = {r0[0], r1[0], r0[1], r1[1]}; pa_a = *reinterpret_cast<bf16x8*>(&w_); } \
    { unsigned a0 = cvtpk(P[8], P[9]), a1 = cvtpk(P[10], P[11]), b0 = cvtpk(P[12], P[13]), b1 = cvtpk(P[14], P[15]); \
      auto r0 = __builtin_amdgcn_permlane32_swap(a0, b0, false, false); auto r1 = __builtin_amdgcn_permlane32_swap(a1, b1, false, false); u32x4 w_ = {r0[0], r1[0], r0[1], r1[1]}; pa_b = *reinterpret_cast<bf16x8*>(&w_); } \
    *(bf16x8*)(pex_own + lane * 16) = pa_a; *(bf16x8*)(pex_own + 1024 + lane * 16) = pa_b; } while (0)
#define PUB2(P, alpha, pa_a, pa_b) do { \
    float ps_ = 0.f; _Pragma("unroll") for (int r = 0; r < 16; ++r) ps_ += P[r]; \
    { auto rr_ = __builtin_amdgcn_permlane32_swap(__float_as_uint(ps_), __float_as_uint(ps_), false, false); ps_ = __uint_as_float(rr_[0]) + __uint_as_float(rr_[1]); } \
    l_reg = l_reg * (alpha) + ps_; \
    { unsigned a0 = cvtpk(P[0], P[1]), a1 = cvtpk(P[2], P[3]), b0 = cvtpk(P[4], P[5]), b1 = cvtpk(P[6], P[7]); \
      auto r0 = __builtin_amdgcn_permlane32_swap(a0, b0, false, false); auto r1 = __builtin_amdgcn_permlane32_swap(a1, b1, false, false); u32x4 w_ = {r0[0], r1[0], r0[1], r1[1]}; pa_a = *reinterpret_cast<bf16x8*>(&w_); } \
    { unsigned a0 = cvtpk(P[8], P[9]), a1 = cvtpk(P[10], P[11]), b0 = cvtpk(P[12], P[13]), b1 = cvtpk(P[14], P[15]); \
      auto r0 = __builtin_amdgcn_permlane32_swap(a0, b0, false, false); auto r1 = __builtin_amdgcn_permlane32_swap(a1, b1, false, false); u32x4 w_ = {r0[0], r1[0], r0[1], r1[1]}; pa_b = *reinterpret_cast<bf16x8*>(&w_); } \
    *(bf16x8*)(pex_own + lane * 16) = pa_a; *(bf16x8*)(pex_own + 1024 + lane * 16) = pa_b; } while (0)
#define RESC2(a) do { if (__any((a) < 1.f)) { if (hi == 0) al_l[r32] = (a); asm volatile("s_waitcnt lgkmcnt(0)" ::: "memory"); \
    for (int d = 0; d < 4; ++d) for (int r = 0; r < 16; ++r) o[d][r] *= al_l[crow(r, hi)]; } } while (0)
  const int NT = seq / KVBLK;
  f32x16 pc, pp; float pm_c, al_p = 1.f, al_c; bf16x8 pa_a, pa_b; pg8::i32x8v pown;
  SLOAD2(sA, 0); asm volatile("s_waitcnt vmcnt(0)" ::: "memory"); SWRITE_K(sA, 0); SWRITE_V(sA, 0);
  SLOAD2(sB, KVBLK); if (2 < NT) SLOAD2(sA, 2 * KVBLK);
  __syncthreads();
  QKT2(pp, 0); ROWMAX2(pp, pm_c); if (hi == 0) mex_own[r32] = pm_c;
  if (2 < NT) asm volatile("s_waitcnt vmcnt(" SLN ")" ::: "memory"); else asm volatile("s_waitcnt vmcnt(0)" ::: "memory");
  SWRITE_K(sB, 1); SWRITE_V(sB, 1); __syncthreads();
  DECIDE2(pm_c, al_p);
  float mref_p = m_reg;
  __syncthreads();
#if F8_PV
#define ATT2_MID(j, L) PUB8(pp, al_p, pown); SBAR(); \
    if ((j) + 2 < NT) SLOAD2(L, ((j) + 2) * KVBLK); SBAR(); \
    ROWMAX2(pc, pm_c); if (hi == 0) mex_own[r32] = pm_c; \
    __syncthreads(); \
    PV8(bp, pown);
#else
#define ATT2_MID(j, L) PUB2(pp, al_p, pa_a, pa_b); SBAR(); \
    if ((j) + 2 < NT) SLOAD2(L, ((j) + 2) * KVBLK); SBAR(); \
    pv_half(o, vrb + bp * 32768, rho, pa_a, pa_b); \
    ROWMAX2(pc, pm_c); if (hi == 0) mex_own[r32] = pm_c; \
    __syncthreads(); \
    { const bf16x8 qa = *(const bf16x8*)(pex_par + lane * 16), qb = *(const bf16x8*)(pex_par + 1024 + lane * 16); \
      pv_half(o, vrb + bp * 32768, rho ^ 1, qa, qb); }
#endif
#define ATT2_ITER(j, W, L) do { const int bj = (j) & 1, bp = bj ^ 1; \
    SBAR(); QKT2X(pc, bj, pp, mref_p); \
    ATT2_MID(j, L) \
    DECIDE2(pm_c, al_c); \
    if ((j) + 1 < NT) { if ((j) + 2 < NT) asm volatile("s_waitcnt vmcnt(" SLN ")" ::: "memory"); else asm volatile("s_waitcnt vmcnt(0)" ::: "memory"); SWRITE_K(W, bp); } \
    RESC2(al_c); \
    __syncthreads(); \
    if ((j) + 1 < NT) SWRITE_V(W, bp); \
    pp = pc; mref_p = m_reg; al_p = al_c; } while (0)
#pragma unroll 1
  for (int j = 1; j + 1 < NT; j += 2) { ATT2_ITER(j, sA, sB); ATT2_ITER(j + 1, sB, sA); }
  ATT2_ITER(NT - 1, sA, sB);
#undef ATT2_ITER
#undef ATT2_MID
  { const int bp = (NT - 1) & 1;
#if F8_PV
    { const float mnC_ = -mref_p * C;
#pragma unroll
      for (int r = 0; r < 16; ++r) pp[r] = __builtin_amdgcn_exp2f(fmaf(pp[r], C, mnC_)); }
    PUB8(pp, al_p, pown); SBAR();
    __syncthreads();
    PV8(bp, pown);
#else
    EXP2PUB(pp, mref_p, al_p, pa_a, pa_b); SBAR();
    pv_half(o, vrb + bp * 32768, rho, pa_a, pa_b);
    __syncthreads();
    { const bf16x8 qa = *(const bf16x8*)(pex_par + lane * 16), qb = *(const bf16x8*)(pex_par + 1024 + lane * 16);
      pv_half(o, vrb + bp * 32768, rho ^ 1, qa, qb); }
#endif
  }
  typedef __attribute__((address_space(1))) float gf32; typedef __attribute__((address_space(1))) bf16_t gbf16;
  gf32* scr_l = (gf32*)scr; gbf16* Ob_l = (gbf16*)Ob; int lane_e = lane; asm volatile("" : "+s"(scr_l), "+s"(Ob_l), "+v"(lane_e));
  const int r32e = lane_e & 31, hie = lane_e >> 5;
  if (hie == 0) lex[r32e] = l_reg;
  __syncthreads();
  float rli[16];
#pragma unroll
  for (int r = 0; r < 16; ++r) rli[r] = __builtin_amdgcn_rcpf(lex[crow(r, hie)] + lex_par[crow(r, hie)]);
  gf32* S = scr_l + (size_t)wid * 4096 + lane_e;
#define ATT_BASE(ptr, d0) gf32* ptr = S + (d0) * 1024; asm volatile("" : "+v"(ptr))
  if (pass == 0) {
#pragma unroll
    for (int d0 = 0; d0 < 4; ++d0) { ATT_BASE(dst, d0);
#pragma unroll
      for (int r = 0; r < 16; ++r) dst[r * 64] = o[d0][r] * rli[r]; }
  } else {
    float q[16];
    const float lam_e = *(const float*)(lds + LX_MISC + 256);
#pragma unroll
    for (int d0 = 0; d0 < 4; ++d0) { ATT_BASE(srcp, d0);
#pragma unroll
      for (int r = 0; r < 16; ++r) { const float c = srcp[r * 64] - lam_e * o[d0][r] * rli[r]; o[d0][r] = c; q[r] = d0 == 0 ? c * c : q[r] + c * c; }
      asm volatile("" ::: "memory"); }
#pragma unroll
    for (int r = 0; r < 16; ++r) {
#pragma unroll
      for (int off = 1; off <= 16; off <<= 1) q[r] += shfl_xor_l(q[r], off, lane_e); }
    if (r32e == 0) {
#pragma unroll
      for (int r = 0; r < 16; ++r) rq[hie * 16 + r] = q[r]; }
    __syncthreads();
    float g1[4];
#pragma unroll
    for (int d0 = 0; d0 < 4; ++d0) g1[d0] = subg[rho * 128 + d0 * 32 + r32e];
#pragma unroll
    for (int r = 0; r < 16; ++r) { const float rs = onem * __builtin_amdgcn_rsqf((rq[hie * 16 + r] + rq_par[hie * 16 + r]) * (1.0f / 256.0f) + EPS);
#if F8_WO
      typedef __attribute__((address_space(1))) unsigned char gu8;
      gu8* orow = (gu8*)Ob_l + (long)(pair * QBLK + crow(r, hie)) * LDO + rho * 128 + r32e; asm volatile("" : "+v"(orow) :: "memory");
      const float rs8 = rs * A8_SCALE;
      orow[ 0] = (unsigned char)pack_fp8x1(clamp8(o[0][r] * rs8 * g1[0])); orow[32] = (unsigned char)pack_fp8x1(clamp8(o[1][r] * rs8 * g1[1]));
      orow[64] = (unsigned char)pack_fp8x1(clamp8(o[2][r] * rs8 * g1[2])); orow[96] = (unsigned char)pack_fp8x1(clamp8(o[3][r] * rs8 * g1[3])); }
#else
      gbf16* orow = Ob_l + (long)(pair * QBLK + crow(r, hie)) * LDO + rho * 128 + r32e; asm volatile("" : "+v"(orow) :: "memory");
      orow[ 0] = (bf16_t)(cvtpk(o[0][r] * rs * g1[0], 0.f) & 0xffffu); orow[32] = (bf16_t)(cvtpk(o[1][r] * rs * g1[1], 0.f) & 0xffffu);
      orow[64] = (bf16_t)(cvtpk(o[2][r] * rs * g1[2], 0.f) & 0xffffu); orow[96] = (bf16_t)(cvtpk(o[3][r] * rs * g1[3], 0.f) & 0xffffu); }
#endif
  }
#undef ATT_BASE
#undef SLOAD2
#undef SWRITE_K
#undef SWRITE_V
#undef QKT2
#undef ROWMAX2
#undef DECIDE2
#undef EXP2PUB
#undef PUB2
#undef QKT2X
#undef KFRAG2
#undef RESC2
}
}

__device__ __forceinline__ void attn_phase(const Frame& F, const Params& p) {
    unsigned char* ws = F.ws;
    const bf16_t* Q = (const bf16_t*)(ws + WS_HID); const bf16_t* Kb = (const bf16_t*)(ws + WS_R1); const bf16_t* Vb = Kb + (size_t)NB * KVL * D;
    bf16_t* O = (bf16_t*)(ws + WS_HB);
    float* scr = (float*)(ws + WS_ATTSCR) + (size_t)F.bx * 65536;
    const float* q1 = inptr(p, 20); const float* k1 = inptr(p, 21); const float* q2 = inptr(p, 22); const float* k2 = inptr(p, 23); const float* subg = inptr(p, 24);
    float d1 = q1[F.lane] * k1[F.lane] + q1[64 + F.lane] * k1[64 + F.lane];
    float d2 = q2[F.lane] * k2[F.lane] + q2[64 + F.lane] * k2[64 + F.lane];
#pragma unroll
    for (int o = 32; o >= 1; o >>= 1) { d1 += shfl_xor_l(d1, o, F.lane); d2 += shfl_xor_l(d2, o, F.lane); }
    const float lam_init = 0.8f - 0.6f * 0.7408182206817179f;
    const float lam = expf(d1) - expf(d2) + lam_init, onem = 1.0f - lam_init;
    if (F.tid == 0) *(LAS float*)(F.lds + LX_MISC + 256) = lam;
    const int vcu = (F.G % 8 == 0) ? (F.bx % 8) * (F.G / 8) + F.bx / 8 : F.bx;
#if MK_ATT2
#pragma unroll 1
    for (int U = vcu; U < NB * 8 * 16; U += F.G) {
        const int bh = U >> 4, b = bh >> 3, h = bh & 7, qb = U & 15;
#if F8_QK
        const bf16_t* Qb = (const bf16_t*)((const unsigned char*)Q + ((size_t)b * SEQ + qb * 128) * D + h * 256);
        const bf16_t* Kh = (const bf16_t*)((const unsigned char*)Kb + (size_t)b * KVL * D + h * 256);
#else
        const bf16_t* Qb = Q + ((size_t)b * SEQ + qb * 128) * D + h * 256;
        const bf16_t* Kh = Kb + (size_t)b * KVL * D + h * 256;
#endif
#if F8_PV
        const bf16_t* Vh = (const bf16_t*)((const unsigned char*)Vb + ((size_t)(b * 8 + h) * 256) * KVL);
#else
        const bf16_t* Vh = Vb + (size_t)b * KVL * D + h * 256;
#endif
        bf16_t* Ob = F8_WO ? (bf16_t*)((unsigned char*)O + ((size_t)b * SEQ + qb * 128) * D + h * 256) : O + ((size_t)b * SEQ + qb * 128) * D + h * 256;
#pragma unroll 1
        for (int pass = 0; pass < 2; ++pass) {
            __syncthreads();
#if F8_QK
            att::attn_pass2((const bf16_t*)((const unsigned char*)Qb + pass * 128), (const bf16_t*)((const unsigned char*)Kh + pass * 128), Vh, Ob, scr, F.wave, pass, lam, onem, subg, KVL, (char*)F.lds);
#else
            att::attn_pass2(Qb + pass * 128, Kh + pass * 128, Vh, Ob, scr, F.wave, pass, lam, onem, subg, KVL, (char*)F.lds);
#endif
        }
    }
#else
#pragma unroll 1
    for (int U = vcu; U < NB * 8 * 8; U += F.G) {
        const int bh = U >> 3, b = bh >> 3, h = bh & 7, qb = U & 7;
        const bf16_t* Qb = Q + ((size_t)b * SEQ + qb * 256) * D + h * 256;
        const bf16_t* Kh = Kb + (size_t)b * KVL * D + h * 256;
        const bf16_t* Vh = Vb + (size_t)b * KVL * D + h * 256;
        bf16_t* Ob = O + ((size_t)b * SEQ + qb * 256) * D + h * 256;
#pragma unroll 1
        for (int pass = 0; pass < 4; ++pass) {
            const int m = pass & 1, vh = pass >> 1;
            __syncthreads();
            att::attn_pass(Qb + m * 128, Kh + m * 128, Vh + vh * 128, Ob, scr, F.wave, pass, lam, onem, subg, KVL, (char*)F.lds);
        }
    }
#endif
    __syncthreads();
}

__device__ __forceinline__ void moe_setup(const Frame& F, int l) {
    LAS int* pre = (LAS int*)(F.lds + LX_PRE); LAS int* cnt = (LAS int*)(F.lds + LX_CNT);
    __syncthreads();
    if (F.tid == 0) {
        const unsigned* cntg = (const unsigned*)(F.ws + WS_CTL) + CW_CNT + l * 64; int acc = 0;
        for (int e = 0; e < 16; ++e) { const int c = (int)__hip_atomic_load(cntg + e, __ATOMIC_RELAXED, __HIP_MEMORY_SCOPE_AGENT); cnt[e] = c; pre[e] = acc; acc += (c + 255) >> 8; }
        pre[16] = acc;
    }
    __syncthreads();
}

__global__ void __launch_bounds__(512, 2) mega_fwd(Params p) {
    extern __shared__ __attribute__((aligned(16))) unsigned char lds_raw[];
    Frame F;
    F.lds = (LAS unsigned char*)lds_raw;
    F.wave = __builtin_amdgcn_readfirstlane(threadIdx.x >> 6); refresh(F);
    F.G = gridDim.x; F.bx = blockIdx.x; F.ws = p.ws; F.out = p.out;
    if (F.tid < 4) ((LAS unsigned*)(F.lds + LX_BAR))[F.tid] = 0u;
    __syncthreads();
    XcdBarrier bar = xcd_barrier_post((unsigned*)(p.ws + WS_CTL) + CW_BAR, (volatile LAS unsigned*)(F.lds + LX_BAR));
    const int lo = p.ph_lo, hi = p.ph_hi, stop = p.stop;
#define PHR(v) ({ int _v = (v); asm volatile("" : "+s"(_v)); _v; })
    unsigned char* ws = p.ws;
    const float* mod = (const float*)(ws + WS_MOD);
    int ph = 0;
#ifndef MK_MASK
#define MK_MASK 0x1ffff
#endif
#define RUN(k) (((MK_MASK >> (k)) & 1) && PHR(lo) <= (k) && (k) < PHR(hi) && ((k) < PHR(stop) || (k) == NPHASE - 1))
#define REP(k) for (int rep_ = 0; rep_ <= ((MK_REPEAT >> (k)) & 1); ++rep_)
#define SEAM(k) do { if ((k) + 1 < PHR(hi)) xcd_barrier(bar); } while (0)

    if (RUN(0)) { refresh(F); REP(0) p0_prologue(F, p); } if (PHR(lo) <= 0 && 0 < PHR(hi)) SEAM(0);
    if (false) { refresh(F); p1_modreduce(F, p);
#ifdef MK_XBAR
        for (int xb_ = 0; xb_ < MK_XBAR; ++xb_) xcd_barrier(bar);
#endif
    }
    if (RUN(2)) { refresh(F); REP(2) row_phase<0>(F, p, 0, 0); } if (PHR(lo) <= 2 && 2 < PHR(hi)) SEAM(2);
    ph = 3;
    if (RUN(3)) { refresh(F);
        pg8::DenseSched<F8_G1 != 0, I8_G1 != 0> S{(const char*)(ws + WS_HB), (const char*)(ws + WS_W1), NTOK / 256, 5120 / 256, 2048, F.G, F.bx, 0x79797979, 0x7f7f7f7f};
        bf16_t* g1o = (bf16_t*)(ws + WS_R1);
        pg8::EpiIn0 E{g1o, g1o + (size_t)NTOK * 1024, g1o + (size_t)2 * NTOK * 1024, g1o + (size_t)3 * NTOK * 1024, (const float*)(ws + WS_ASC)};
        REP(3) pg8::gemm_run(F.lds, F.wave, 2048, S, E);
#if MK_TAILFILL
        refresh(F); tail_fill(F, p, 0, 0, false);
#endif
    } if (PHR(lo) <= 3 && 3 < PHR(hi)) SEAM(3);
    if (RUN(4)) { refresh(F); REP(4) scan_phase(F, p); } if (PHR(lo) <= 4 && 4 < PHR(hi)) SEAM(4);
    if (RUN(5)) { refresh(F);
        pg8::DenseSched<F8_G3 != 0> S{(const char*)(ws + WS_HB), (const char*)(ws + WS_W3), NTOK / 256, 2048 / 256, 2048, F.G, F.bx, 0x79797979, 0x7c7c7c7c};
        pg8::EpiRes<true> E{inptr(p, 0), inptr(p, 2), (bf16_t*)(ws + WS_XR), mod + 4096};
        REP(5) pg8::gemm_run(F.lds, F.wave, 2048, S, E);
#if MK_TAILFILL
        refresh(F); tail_fill(F, p, 0, 1, false);
#endif
    } if (PHR(lo) <= 5 && 5 < PHR(hi)) SEAM(5);
    for (int l = 0; l < 2; ++l) {
        const int base = l == 0 ? 6 : 13;
        if (l == 1) {
            if (RUN(10)) { refresh(F);
                pg8::EpiQKV E{(bf16_t*)(ws + WS_HID), (bf16_t*)(ws + WS_R1), (bf16_t*)(ws + WS_R1) + (size_t)NB * KVL * D, (const float*)(ws + WS_ROPE), (const float*)(ws + WS_ROPE) + 2048};
                pg8::QkvSched<F8_QKV != 0> S{(const char*)(ws + WS_HB), (const char*)(ws + WS_WQKV), 2048, F.G, F.bx, 0x79797979, 0x7f7f7f7f};
                REP(10) pg8::gemm_run(F.lds, F.wave, 2048, S, E);
            } if (PHR(lo) <= 10 && 10 < PHR(hi)) SEAM(10);
            if (RUN(11)) { refresh(F); REP(11) attn_phase(F, p); } if (PHR(lo) <= 11 && 11 < PHR(hi)) SEAM(11);
            if (RUN(12)) { refresh(F);
                pg8::DenseSched<F8_WO != 0> S{(const char*)(ws + WS_HB), (const char*)(ws + WS_WO), NLAT / 256, 2048 / 256, 2048, F.G, F.bx, 0x79797979, 0x7c7c7c7c};
                pg8::EpiRes<false> E{nullptr, nullptr, (bf16_t*)(ws + WS_XR), mod + (size_t)17 * MODW + 4096};
                pg8::gemm_run(F.lds, F.wave, 2048, S, E);
            } if (PHR(lo) <= 12 && 12 < PHR(hi)) SEAM(12);
        }
        if (RUN(base)) { refresh(F);
#if MK_TAILFILL
            tail_fill(F, p, l, 0, true); refresh(F);
#endif
            row_phase<1>(F, p, l, 0); } if (PHR(lo) <= base && base < PHR(hi)) SEAM(base);
        if (RUN(base + 1)) { refresh(F);
            moe_setup(F, l);
            pg8::MoeSched<true> S{(const char*)(ws + WS_HB), (const char*)(ws + WS_WGU) + (size_t)l * WGU_LSTRIDE, (size_t)2048 * 2048,
                                  (const LAS int*)(F.lds + LX_PRE), (const LAS int*)(F.lds + LX_CNT), (const int*)(ws + WS_LIST), 2048, F.G, F.bx, 0x79797979, 0x7f7f7f7f};
            pg8::EpiGU E{ws + WS_HID};
            REP(7) pg8::gemm_run(F.lds, F.wave, 2048, S, E);
#if MK_TAILFILL
            if (l == 0) { refresh(F); tail_fill(F, p, 1, 2, false); }
#endif
        } if (PHR(lo) <= base + 1 && base + 1 < PHR(hi)) SEAM(base + 1);
        if (RUN(base + 2)) { refresh(F);
            moe_setup(F, l);
            pg8::MoeSched<false> S{(const char*)(ws + WS_HID), (const char*)(ws + WS_WD) + (size_t)l * WD_LSTRIDE, (size_t)2048 * 1024,
                                   (const LAS int*)(F.lds + LX_PRE), (const LAS int*)(F.lds + LX_CNT), (const int*)(ws + WS_LIST), 1024, F.G, F.bx, 0x79797979, 0x7d7d7d7d};
            pg8::EpiDN E{(bf16_t*)(ws + WS_R1), (const int*)(ws + WS_LIST), (const float*)(ws + WS_LISTG)};
            REP(8) pg8::gemm_run(F.lds, F.wave, 1024, S, E);
#if MK_TAILFILL
#endif
        } if (PHR(lo) <= base + 2 && base + 2 < PHR(hi)) SEAM(base + 2);
        if (l == 0) { if (RUN(9)) { refresh(F); row_phase<2>(F, p, 0, 0); } if (PHR(lo) <= 9 && 9 < PHR(hi)) SEAM(9); }
        else { if (RUN(16)) { refresh(F); REP(16) row_phase<3>(F, p, 1, p.fin_mode); } }
    }
    (void)ph;
#undef RUN
#undef SEAM
}

extern "C" void kernel_launch(void* const* d_in, const int* in_sizes, int n_in, void* d_out, int out_size, void* d_ws, size_t ws_size, hipStream_t stream) {
    static int grid = 0;
    if (grid == 0) {
        if (n_in != 31 || in_sizes[0] != NLAT * D || out_size != NLAT * D || ws_size < WS_END) {
            fprintf(stderr, "kernel_launch: shape/workspace mismatch: n_in %d in0 %d out %d ws %zu (need %zu)\n", n_in, n_in > 0 ? in_sizes[0] : -1, out_size, ws_size, (size_t)WS_END); grid = -1; return; }
        int dev = 0, cus = 0, per_cu = 0;
        if (hipGetDevice(&dev) != hipSuccess || hipDeviceGetAttribute(&cus, hipDeviceAttributeMultiprocessorCount, dev) != hipSuccess) { grid = -1; return; }
        if (hipFuncSetAttribute((const void*)mega_fwd, hipFuncAttributeMaxDynamicSharedMemorySize, LDS_BYTES) != hipSuccess) { fprintf(stderr, "kernel_launch: hipFuncSetAttribute failed\n"); grid = -1; return; }
        if (hipOccupancyMaxActiveBlocksPerMultiprocessor(&per_cu, (const void*)mega_fwd, 512, LDS_BYTES) != hipSuccess || per_cu < 1)
            fprintf(stderr, "kernel_launch: occupancy query reports %d blocks per CU\n", per_cu);
        (void)hipGetLastError();
        grid = cus;
    }
    if (grid < 0) return;
    (void)hipMemsetAsync((char*)d_ws + WS_CTL, 0, CTL_BYTES, stream);
    Params p{};
    for (int i = 0; i < 31; ++i) p.in[i] = (const float*)d_in[i];
    p.out = (float*)d_out; p.ws = (unsigned char*)d_ws;
    p.stop = MK_STOP;
    p.fin_mode = (MK_STOP >= NPHASE - 1) ? 0 : (MK_STOP <= 5 ? 2 : 1);
#if MK_LAUNCHES
    for (int ph = 0; ph < NPHASE; ++ph) {
        if (!(ph < MK_STOP || ph == NPHASE - 1)) continue;
        p.ph_lo = ph; p.ph_hi = ph + 1;
        hipLaunchKernelGGL(mega_fwd, dim3(grid), dim3(512), LDS_BYTES, stream, p);
    }
#else
    p.ph_lo = 0; p.ph_hi = NPHASE;
    hipLaunchKernelGGL(mega_fwd, dim3(grid), dim3(512), LDS_BYTES, stream, p);
#endif
    const hipError_t le = hipPeekAtLastError();
    if (le != hipSuccess) fprintf(stderr, "kernel_launch: launch failed: %s\n", hipGetErrorName(le));
}
```

```cpp
#include <hip/hip_runtime.h>
#include <cstdio>
#include <cstdint>

#ifndef F8_G1
#define F8_G1 0
#endif
#ifndef I8_G1
#define I8_G1 1
#endif
#ifndef F8_G3
#define F8_G3 0
#endif
#ifndef F8_QKV
#define F8_QKV 1
#endif
#ifndef F8_WO
#define F8_WO 1
#endif
#ifndef F8_QK
#define F8_QK 1
#endif
#ifndef F8_PV
#define F8_PV 1
#endif
#ifndef F8_Y
#define F8_Y 1
#endif
#ifndef MK_8PHASE
#define MK_8PHASE 0
#endif
#ifndef MK_TAILFILL
#define MK_TAILFILL 1
#endif
#ifndef MK_LAUNCHES
#define MK_LAUNCHES 0
#endif
#ifndef MK_STOP
#define MK_STOP 99
#endif
#ifndef MK_REPEAT
#define MK_REPEAT 0
#endif
#ifndef MK_STAGGER
#define MK_STAGGER 0
#endif
#ifndef MK_P0PIPE
#define MK_P0PIPE 0
#endif
#ifndef MK_ATT2
#define MK_ATT2 1
#endif
#ifndef MK_NAIVE
#define MK_NAIVE 0
#endif

#define LAS __attribute__((address_space(3)))
typedef unsigned short bf16_t;
typedef short bf16x8 __attribute__((ext_vector_type(8)));
typedef short s16x4 __attribute__((ext_vector_type(4)));
typedef float f32x4 __attribute__((ext_vector_type(4)));
typedef float f32x2 __attribute__((ext_vector_type(2)));
typedef float f32x16 __attribute__((ext_vector_type(16)));
typedef unsigned u32x4 __attribute__((ext_vector_type(4)));
typedef unsigned u32x2 __attribute__((ext_vector_type(2)));

constexpr int D = 2048, NB = 16, SEQ = 2048, CTXL = 256;
constexpr int NLAT = NB * SEQ, NCTX = NB * CTXL, NTOK = NLAT + NCTX;
constexpr int NE = 16, FF = 1024, KVL = CTXL + SEQ;
constexpr int MODW = 6 * D;
constexpr float EPS = 1e-6f;
constexpr int NPHASE = 17;

constexpr size_t al256(size_t x) { return (x + 255) & ~(size_t)255; }
constexpr size_t WS_CTL = 0, CTL_BYTES = 65536;
constexpr int CW_BAR = 0, CW_CNT = 4096, CW_FILL = 6144, CW_DONE = 6160;
constexpr size_t WS_MOD = WS_CTL + CTL_BYTES;
constexpr size_t WS_ROPE = WS_MOD + al256((size_t)2 * 17 * MODW * 4);
constexpr size_t WS_GW = WS_ROPE + 16384;
constexpr size_t WS_W1 = WS_GW + (size_t)2 * 8 * 2 * 128 * 128 * 2;
constexpr size_t WS_W3 = WS_W1 + (size_t)5120 * 2048 * 2;
constexpr size_t WS_WQKV = WS_W3 + (size_t)2048 * 2048 * 2;
constexpr size_t WS_WO = WS_WQKV + (size_t)6144 * 2048 * 2;
constexpr size_t WS_WGU = WS_WO + (size_t)2048 * 2048 * 2;
constexpr size_t WS_WD = WS_WGU + (size_t)32 * 2048 * 2048 * 2;
constexpr size_t WS_XR = WS_WD + (size_t)32 * 2048 * 1024 * 2;
constexpr size_t WS_HB = WS_XR + (size_t)NTOK * D * 2;
constexpr size_t WS_R1 = WS_HB + (size_t)NTOK * D * 2;
constexpr size_t R1_BYTES = (size_t)2 * NTOK * D * 2;
constexpr size_t WS_HID = WS_R1 + R1_BYTES;
constexpr size_t HID_ROWS = 77824, HID_BYTES = HID_ROWS * FF * 2;
constexpr size_t WS_LIST = WS_HID + HID_BYTES;
constexpr size_t WS_LISTG = WS_LIST + (size_t)NE * NTOK * 4;
constexpr size_t WS_ASC = WS_LISTG + (size_t)NE * NTOK * 4;
constexpr size_t WS_END = WS_ASC + (size_t)NTOK * 4;
constexpr size_t WS_ATTSCR = WS_WGU;
static_assert((size_t)NTOK * 1024 * 4 <= HID_BYTES && (size_t)NLAT * D * 2 <= HID_BYTES && (size_t)2 * 16 * 17 * MODW * 4 <= HID_BYTES, "HID aliases");
static_assert((size_t)256 * 65536 * 4 <= (size_t)16 * 2048 * 2048 * 2, "attention scratch fits in layer-0 expert weights");

constexpr int STAGE_BYTES = 131072;
constexpr int LX = 147456;
constexpr int LX_BAR = LX + 0;
constexpr int LX_PRE = LX + 64;
constexpr int LX_CNT = LX + 192;
constexpr int LX_LCNT = LX + 256;
constexpr int LX_LBASE = LX + 320;
constexpr int LX_REC = LX + 512;
constexpr int LX_RECG = LX + 2048;
constexpr int LX_MISC = LX + 4096;
constexpr int LDS_BYTES = LX + 8192;
constexpr int ROWCH = 192;

struct Params { const float* in[31]; float* out; unsigned char* ws; int ph_lo, ph_hi; int fin_mode, stop; };

__device__ __forceinline__ const float* inptr(const Params& p, int i) { asm volatile("" : "+s"(i)); return p.in[i]; }
__device__ __forceinline__ unsigned cvt_pk_bf16(float lo, float hi) { unsigned r; asm("v_cvt_pk_bf16_f32 %0, %1, %2" : "=v"(r) : "v"(lo), "v"(hi)); return r; }
__device__ __forceinline__ float bflo(unsigned w) { return __uint_as_float(w << 16); }
__device__ __forceinline__ float bfhi(unsigned w) { return __uint_as_float(w & 0xffff0000u); }
__device__ __forceinline__ float bf2f(bf16_t b) { return __uint_as_float(((unsigned)b) << 16); }
__device__ __forceinline__ float fsigmoid(float x) { return __builtin_amdgcn_rcpf(1.0f + __expf(-x)); }
__device__ __forceinline__ float fsilu(float x) { return x * fsigmoid(x); }
__device__ __forceinline__ float fgelu_tanh(float x) { const float z = 1.5957691216057308f * (x + 0.044715f * x * x * x); return x * fsigmoid(z); }
__device__ __forceinline__ float clamp8(float x) { return __builtin_fminf(__builtin_fmaxf(x, -448.0f), 448.0f); }
__device__ __forceinline__ unsigned pack_fp8x1(float a) { return (unsigned)__builtin_amdgcn_cvt_pk_fp8_f32(a, 0.f, 0, false) & 0xffu; }
__device__ __forceinline__ unsigned pack_i8x4(float a, float b, float c, float d) {
    const int qa = (int)__builtin_rintf(__builtin_fminf(__builtin_fmaxf(a, -127.f), 127.f)), qb = (int)__builtin_rintf(__builtin_fminf(__builtin_fmaxf(b, -127.f), 127.f));
    const int qc = (int)__builtin_rintf(__builtin_fminf(__builtin_fmaxf(c, -127.f), 127.f)), qd = (int)__builtin_rintf(__builtin_fminf(__builtin_fmaxf(d, -127.f), 127.f));
    return (unsigned)(qa & 255) | ((unsigned)(qb & 255) << 8) | ((unsigned)(qc & 255) << 16) | ((unsigned)qd << 24);
}
__device__ __forceinline__ unsigned pack_fp8x4(float a, float b, float c, float d) { int w = __builtin_amdgcn_cvt_pk_fp8_f32(a, b, 0, false); w = __builtin_amdgcn_cvt_pk_fp8_f32(c, d, w, true); return (unsigned)w; }
__device__ __forceinline__ u32x4 pack8(const float (&v)[8]) { u32x4 w; w.x = cvt_pk_bf16(v[0], v[1]); w.y = cvt_pk_bf16(v[2], v[3]); w.z = cvt_pk_bf16(v[4], v[5]); w.w = cvt_pk_bf16(v[6], v[7]); return w; }
__device__ __forceinline__ void unpack8(const u32x4 w, float (&v)[8]) { v[0] = bflo(w.x); v[1] = bfhi(w.x); v[2] = bflo(w.y); v[3] = bfhi(w.y); v[4] = bflo(w.z); v[5] = bfhi(w.z); v[6] = bflo(w.w); v[7] = bfhi(w.w); }

#define XB_TMO      128
#define XB_XCNT(j)  (256  + 64 * (j))
#define XB_XSUB(j)  (1280 + 64 * (j))
#define XB_XGEN(j)  (2304 + 64 * (j))
#define XB_TOP      3328
#define XB_TOPGEN   3392
#define XCD_BAR_WORDS 3456
#define XB_SPIN_CAP (1u << 18)
__device__ __forceinline__ unsigned xb_ld(unsigned* p)              { return __hip_atomic_load(p, __ATOMIC_RELAXED, __HIP_MEMORY_SCOPE_AGENT); }
__device__ __forceinline__ unsigned xb_add(unsigned* p, unsigned v) { return __hip_atomic_fetch_add(p, v, __ATOMIC_RELAXED, __HIP_MEMORY_SCOPE_AGENT); }
__device__ __forceinline__ unsigned xb_xcc_id() { return (unsigned)__builtin_amdgcn_s_getreg((3 << 11) | 20) & 0xFu; }
#define XB_SPIN(cond, bar) do { unsigned _sp = 0; while (cond) { __builtin_amdgcn_s_sleep(1); \
    if ((++_sp & 255u) == 0u) { if (xb_ld(&(bar)[XB_TMO])) break; if (_sp > XB_SPIN_CAP) { atomicAdd(&(bar)[XB_TMO], 1u); break; } } } } while (0)
struct XcdBarrier { unsigned* bar; unsigned x; volatile LAS unsigned* st; };
__device__ __forceinline__ XcdBarrier xcd_barrier_post(unsigned* bar, volatile LAS unsigned* st) {
    XcdBarrier b; b.bar = bar; b.x = xb_xcc_id(); b.st = st;
    if (threadIdx.x == 0) (void)xb_add(&bar[XB_XCNT(b.x)], 1u);
    return b;
}
__device__ __forceinline__ void xcd_barrier_complete(unsigned* bar, unsigned x, unsigned& nloc, unsigned& nx) {
    const unsigned G = gridDim.x * gridDim.y * gridDim.z;
    unsigned sum, cnt, mine, sp = 0u;
    for (;;) {
        sum = 0u; cnt = 0u; mine = 0u;
#pragma unroll
        for (unsigned j = 0; j < 16; ++j) { const unsigned c = xb_ld(&bar[XB_XCNT(j)]); sum += c; cnt += (c > 0u) ? 1u : 0u; mine = (j == x) ? c : mine; }
        if (sum == G) break;
        __builtin_amdgcn_s_sleep(1);
        if ((++sp & 255u) == 0u) { if (xb_ld(&bar[XB_TMO])) break; if (sp > XB_SPIN_CAP) { atomicAdd(&bar[XB_TMO], 1u); break; } }
    }
    nloc = mine > 0u ? mine : 1u; nx = cnt > 0u ? cnt : 1u;
}
__device__ __forceinline__ void xcd_barrier(const XcdBarrier& b) {
    asm volatile("s_waitcnt vmcnt(0)" ::: "memory");
    __syncthreads();
    if (threadIdx.x == 0) {
        unsigned* bar = b.bar;
        __builtin_amdgcn_s_waitcnt(0);
        unsigned nloc = b.st[0], nx = b.st[1];
        if (nloc == 0u) { xcd_barrier_complete(bar, b.x, nloc, nx); b.st[0] = nloc; b.st[1] = nx; }
        const unsigned old = xb_add(&bar[XB_XSUB(b.x)], 1u);
        const unsigned gen = old / nloc;
        if (old + 1u == (gen + 1u) * nloc) {
            __builtin_amdgcn_fence(__ATOMIC_RELEASE, "agent");
            asm volatile("s_waitcnt vmcnt(0)" ::: "memory");
            const unsigned og = xb_add(&bar[XB_TOP], 1u);
            const unsigned tg = og / nx;
            if (og + 1u == (tg + 1u) * nx) xb_add(&bar[XB_TOPGEN], 1u);
            else XB_SPIN(xb_ld(&bar[XB_TOPGEN]) == tg, bar);
            __builtin_amdgcn_fence(__ATOMIC_ACQUIRE, "agent");
            xb_add(&bar[XB_XGEN(b.x)], 1u);
            asm volatile("s_waitcnt vmcnt(0)" ::: "memory");
        } else {
            XB_SPIN(xb_ld(&bar[XB_XGEN(b.x)]) == gen, bar);
            __builtin_amdgcn_fence(__ATOMIC_ACQUIRE, "agent");
            asm volatile("s_waitcnt vmcnt(0)" ::: "memory");
        }
    }
    __syncthreads();
}

struct Frame {
    LAS unsigned char* lds;
    int tid, lane, wave, G, bx;
    unsigned char* ws;
    float* out;
};
__device__ __forceinline__ int lane_id() { int l; asm volatile("v_mbcnt_lo_u32_b32 %0, -1, 0\n\tv_mbcnt_hi_u32_b32 %0, -1, %0" : "=v"(l)); return l; }
__device__ __forceinline__ float shfl_xor_l(float v, int off, int lane_l) { return __uint_as_float((unsigned)__builtin_amdgcn_ds_bpermute((lane_l ^ off) << 2, (int)__float_as_uint(v))); }
template <int CTRL> __device__ __forceinline__ float dpp_mov_f(float v) { return __int_as_float(__builtin_amdgcn_update_dpp(0, __float_as_int(v), CTRL, 0xf, 0xf, false)); }
__device__ __forceinline__ float wave_allsum(float v) {
    v += dpp_mov_f<0x128>(v); v += dpp_mov_f<0x124>(v); v += dpp_mov_f<0x122>(v); v += dpp_mov_f<0x121>(v);
    v += __int_as_float(__builtin_amdgcn_ds_swizzle(__float_as_int(v), 0x401F));
    const auto r = __builtin_amdgcn_permlane32_swap(__float_as_uint(v), __float_as_uint(v), false, false);
    return __uint_as_float(r[0]) + __uint_as_float(r[1]);
}
__device__ __forceinline__ float wave_allmax(float v) {
    v = fmaxf(v, dpp_mov_f<0x128>(v)); v = fmaxf(v, dpp_mov_f<0x124>(v)); v = fmaxf(v, dpp_mov_f<0x122>(v)); v = fmaxf(v, dpp_mov_f<0x121>(v));
    v = fmaxf(v, __int_as_float(__builtin_amdgcn_ds_swizzle(__float_as_int(v), 0x401F)));
    const auto r = __builtin_amdgcn_permlane32_swap(__float_as_uint(v), __float_as_uint(v), false, false);
    return fmaxf(__uint_as_float(r[0]), __uint_as_float(r[1]));
}
__device__ __forceinline__ int tid_rebuild(int wave) { int t = wave * 64 + lane_id(); asm volatile("" : "+v"(t)); return t; }
__device__ __forceinline__ void refresh(Frame& F) { const int t = tid_rebuild(F.wave); F.tid = t; F.lane = t & 63; }
__device__ __forceinline__ int modrow_of(int t) { return t < NLAT ? (t >> 11) : 16; }

constexpr int XT_W1 = (F8_G1 || I8_G1) ? 0 : 20 * 32, XT_W3 = F8_G3 ? 0 : 8 * 32, XT_WQKV = F8_QKV ? 0 : 24 * 32, XT_WO = F8_WO ? 0 : 8 * 32;
constexpr int XT_BF = XT_W1 + XT_W3 + XT_WQKV + XT_WO;
constexpr int XT8_W1 = (F8_G1 || I8_G1) ? 20 * 16 : 0, XT8_W3 = F8_G3 ? 8 * 16 : 0, XT8_WQKV = F8_QKV ? 24 * 16 : 0, XT8_WO = F8_WO ? 8 * 16 : 0;
constexpr int XT8_WGU = 32 * 8 * 16, XT8_WD = 32 * 8 * 8, XT8_TOTAL = XT8_W1 + XT8_W3 + XT8_WQKV + XT8_WO + XT8_WGU + XT8_WD;
constexpr float Y8_SCALE = 16.0f;
constexpr float A8_SCALE = 8.0f;
constexpr int XT8_DENSE = XT8_W1 + XT8_W3 + XT8_WQKV + XT8_WO;
constexpr int XT_TOTAL = XT_BF + XT8_TOTAL;
constexpr float GU_GATE_K = 1.4426950408889634f, GU_UP_K = 4.0f / 1.4426950408889634f;
constexpr float W1Q = 127.0f / 0.09375f, W1DQ = 0.09375f / 127.0f;
constexpr float W8_SCALE = 64.0f;
constexpr float H8_SCALE = 4.0f;
constexpr size_t WGU_LSTRIDE = (size_t)16 * 2048 * 2048 * 2, WD_LSTRIDE = (size_t)16 * 2048 * 1024 * 2;
constexpr int ADA_UNITS = 0;
constexpr int P0_UNITS = XT_TOTAL + ADA_UNITS + 1 + 16;

struct XTile { const float* src; bf16_t* dst; int ld, K, rb, kb; };
__device__ __forceinline__ int col0_w1(const int rb, const int gi) {
    return rb < 8 ? (gi < 4 ? 1024 + rb * 128 + gi * 32 : 2048 + rb * 128 + (gi - 4) * 32) : rb < 12 ? (rb - 8) * 256 + gi * 32 : rb < 16 ? 3072 + (rb - 12) * 256 + gi * 32 : 4096 + (rb - 16) * 256 + gi * 32; }
__device__ __forceinline__ int col0_wqkv(const int rb, const int gi) {
    if (rb < 16) { const int part = rb >> 3, head = rb & 7, g4 = gi & 3, m = g4 >> 1, a = g4 & 1; return part * 2048 + head * 256 + m * 128 + a * 64 + (gi >= 4 ? 32 : 0); }
    return 4096 + (rb - 16) * 256 + gi * 32; }
__device__ __forceinline__ XTile xt_decode(int T, const int gi, const Params& p, unsigned char* ws) {
    XTile x; int col0;
    if (T < XT_W1) { x.rb = T >> 5; x.kb = T & 31; x.K = 2048; x.ld = 5120; x.src = inptr(p, 9); x.dst = (bf16_t*)(ws + WS_W1); col0 = col0_w1(x.rb, gi); }
    else if ((T -= XT_W1) < XT_W3) { x.rb = T >> 5; x.kb = T & 31; x.K = 2048; x.ld = 2048; x.src = inptr(p, 18); x.dst = (bf16_t*)(ws + WS_W3); col0 = x.rb * 256 + gi * 32; }
    else if ((T -= XT_W3) < XT_WQKV) { x.rb = T >> 5; x.kb = T & 31; x.K = 2048; x.ld = 6144; x.src = inptr(p, 19); x.dst = (bf16_t*)(ws + WS_WQKV); col0 = col0_wqkv(x.rb, gi); }
    else { T -= XT_WQKV; x.rb = T >> 5; x.kb = T & 31; x.K = 2048; x.ld = 2048; x.src = inptr(p, 25); x.dst = (bf16_t*)(ws + WS_WO); col0 = x.rb * 256 + gi * 32; }
    x.src += col0; return x;
}
struct XRegs { f32x4 v0[4], v1[4]; };
__device__ __forceinline__ void xt_load(XRegs& R, const XTile& x, const int lane) {
    const int kq = lane >> 3, c4 = (lane & 7) * 4;
    const float* s = x.src + (size_t)(x.kb * 64 + 2 * kq) * x.ld + c4;
#pragma unroll
    for (int it = 0; it < 4; ++it) { R.v0[it] = *(const f32x4*)(s + (size_t)(16 * it) * x.ld); R.v1[it] = *(const f32x4*)(s + (size_t)(16 * it + 1) * x.ld); }
}
__device__ __forceinline__ void xt_store(const Frame& F, const XRegs& R, const XTile& x) {
    LAS unsigned* T = (LAS unsigned*)F.lds;
    const int l = F.lane, w = F.wave, kq = l >> 3, c4 = (l & 7) * 4;
#pragma unroll
    for (int it = 0; it < 4; ++it)
#pragma unroll
        for (int j = 0; j < 4; ++j) T[(w * 32 + c4 + j) * 36 + 8 * it + kq] = cvt_pk_bf16(R.v0[it][j], R.v1[it][j]);
    __syncthreads();
#pragma unroll
    for (int it = 0; it < 4; ++it) { const int q = F.tid + 512 * it, row = q >> 3, piece = q & 7;
        const u32x4 v = *(const LAS u32x4*)(T + row * 36 + piece * 4);
        *(u32x4*)(x.dst + (size_t)(x.rb * 256 + row) * x.K + x.kb * 64 + piece * 8) = v; }
    __syncthreads();
}

struct XTile8 { const float* src; unsigned char* dst; int ld, K, rb, kb, pair, i8, kperm; float scale; };
__device__ __forceinline__ XTile8 xt8_decode(int T, const int gi, const Params& p, unsigned char* ws) {
    XTile8 x; int col0; x.pair = 0; x.i8 = 0; x.kperm = 0; x.scale = W8_SCALE;
    if (T < XT8_W1) { x.rb = T >> 4; x.kb = T & 15; x.K = 2048; x.ld = 5120; x.src = inptr(p, 9); x.dst = ws + WS_W1; col0 = col0_w1(x.rb, gi); if (I8_G1) { x.i8 = 1; x.scale = W1Q; } }
    else if ((T -= XT8_W1) < XT8_W3) { x.rb = T >> 4; x.kb = T & 15; x.K = 2048; x.ld = 2048; x.src = inptr(p, 18); x.dst = ws + WS_W3; col0 = x.rb * 256 + gi * 32; }
    else if ((T -= XT8_W3) < XT8_WQKV) { x.rb = T >> 4; x.kb = T & 15; x.K = 2048; x.ld = 6144; x.src = inptr(p, 19); x.dst = ws + WS_WQKV; col0 = col0_wqkv(x.rb, gi); }
    else if ((T -= XT8_WQKV) < XT8_WO) { x.rb = T >> 4; x.kb = T & 15; x.K = 2048; x.ld = 2048; x.src = inptr(p, 25); x.dst = ws + WS_WO; col0 = x.rb * 256 + gi * 32; x.kperm = 1; }
    else if ((T -= XT8_WO) < XT8_WGU) { const int le = T >> 7; x.rb = (T >> 4) & 7; x.kb = T & 15; x.K = 2048; x.ld = 1024;
        x.src = (gi < 4 ? inptr(p, 28) : inptr(p, 29)) + (size_t)le * 2048 * 1024; col0 = x.rb * 128 + (gi & 3) * 32;
        x.scale = gi < 4 ? W8_SCALE * GU_GATE_K : W8_SCALE * GU_UP_K;
        x.dst = ws + WS_WGU + (size_t)(le >> 4) * WGU_LSTRIDE + (size_t)(le & 15) * 2048 * 2048; }
    else { T -= XT8_WGU; const int le = T >> 6; x.rb = (T >> 3) & 7; x.kb = T & 7; x.K = 1024; x.ld = 2048;
        x.src = inptr(p, 30) + (size_t)le * 1024 * 2048;
        if (F8_Y) { x.pair = 1; col0 = x.rb * 256 + (gi & 3) * 64 + (gi >> 2) * 8; }
        else col0 = x.rb * 256 + gi * 32;
        x.dst = ws + WS_WD + (size_t)(le >> 4) * WD_LSTRIDE + (size_t)(le & 15) * 2048 * 1024; }
    x.src += col0; return x;
}
struct XRegs8 { f32x4 v[4][4]; };
__device__ __forceinline__ void xt8_load(XRegs8& R, const XTile8& x, const int lane) {
    const int kq = lane >> 3, c4 = (lane & 7) * 4;
    const float* s = x.src + (size_t)(x.kb * 128 + 4 * kq) * x.ld + (x.pair ? 16 * (c4 >> 3) + (c4 & 7) : c4);
#pragma unroll
    for (int it = 0; it < 4; ++it)
#pragma unroll
        for (int j = 0; j < 4; ++j) R.v[it][j] = *(const f32x4*)(s + (long)(x.kperm ? 32 * j + 8 * it - 3 * kq : 32 * it + j) * x.ld);
}
__device__ __forceinline__ void xt8_store(const Frame& F, const XRegs8& R, const XTile8& x) {
    LAS unsigned* T = (LAS unsigned*)F.lds;
    const int l = F.lane, w = F.wave, kq = l >> 3, c4 = (l & 7) * 4;
#pragma unroll
    for (int it = 0; it < 4; ++it)
#pragma unroll
        for (int c = 0; c < 4; ++c) T[(w * 32 + c4 + c) * 36 + 8 * it + kq] = x.i8 ? pack_i8x4(x.scale * R.v[it][0][c], x.scale * R.v[it][1][c], x.scale * R.v[it][2][c], x.scale * R.v[it][3][c])
                                                                          : pack_fp8x4(x.scale * R.v[it][0][c], x.scale * R.v[it][1][c], x.scale * R.v[it][2][c], x.scale * R.v[it][3][c]);
    __syncthreads();
#pragma unroll
    for (int it = 0; it < 4; ++it) { const int q = F.tid + 512 * it, row = q >> 3, piece = q & 7;
        const u32x4 v = *(const LAS u32x4*)(T + row * 36 + piece * 4);
        *(u32x4*)(x.dst + (size_t)(x.rb * 256 + row) * x.K + x.kb * 128 + piece * 16) = v; }
    __syncthreads();
}

__device__ __forceinline__ void p0_prologue(const Frame& F, const Params& p) {
    unsigned char* ws = F.ws;
    {
        for (int u = F.bx; u < XT_BF; u += F.G) { XRegs cur; const XTile xc = xt_decode(u, F.wave, p, ws); xt_load(cur, xc, F.lane); xt_store(F, cur, xc); }
        for (int u = F.bx; u < (MK_TAILFILL ? XT8_DENSE : XT8_TOTAL); u += F.G) { XRegs8 cur; const XTile8 xc = xt8_decode(u, F.wave, p, ws); xt8_load(cur, xc, F.lane); xt8_store(F, cur, xc); }
    }
    {
        LAS float* sS = (LAS float*)F.lds;
        const float* cin = inptr(p, 1); const float* cctx = inptr(p, 3); const float* adaw = inptr(p, 4); const float* adab = inptr(p, 5);
        float* mod = (float*)(ws + WS_MOD);
        for (int cbk = F.bx; cbk < 256; cbk += F.G) {
            __syncthreads();
            for (int i = F.tid; i < 17 * 2048; i += 512) { const int r = i >> 11, k = i & 2047; const float cv = r < 16 ? cin[r * D + k] : cctx[k]; sS[i] = cv / (1.0f + expf(-cv)); }
            __syncthreads();
            const int colg = cbk * 96, l = colg / MODW, n0 = colg % MODW;
            const int c = F.tid % 24, kl = F.tid / 24;
            f32x4 acc[17];
#pragma unroll
            for (int r = 0; r < 17; ++r) acc[r] = (f32x4){0.f, 0.f, 0.f, 0.f};
            if (kl < 21) {
                const float* wp = adaw + ((size_t)l * D) * MODW + n0 + c * 4;
#pragma unroll 1
                for (int k0 = kl; k0 < 2048; k0 += 21 * 8) {
                    f32x4 wv[8];
#pragma unroll
                    for (int j = 0; j < 8; ++j) { const int k = k0 + 21 * j; wv[j] = k < 2048 ? *(const f32x4*)(wp + (size_t)k * MODW) : (f32x4){0.f, 0.f, 0.f, 0.f}; }
#pragma unroll
                    for (int j = 0; j < 8; ++j) { const int k = min(k0 + 21 * j, 2047);
#pragma unroll
                        for (int r = 0; r < 17; ++r) acc[r] += sS[r * 2048 + k] * wv[j]; }
                }
            }
            __syncthreads();
            if (kl < 21) {
#pragma unroll
                for (int r = 0; r < 17; ++r) *(LAS f32x4*)(sS + (kl * 17 + r) * 96 + c * 4) = acc[r];
            }
            __syncthreads();
            for (int o = F.tid; o < 17 * 96; o += 512) { const int r = o / 96, cc = o % 96; float sum = adab[(size_t)l * MODW + n0 + cc];
#pragma unroll
                for (int q = 0; q < 21; ++q) sum += sS[(q * 17 + r) * 96 + cc];
                mod[((size_t)l * 17 + r) * MODW + n0 + cc] = sum; }
        }
        __syncthreads();
    }
    const int first = XT_TOTAL + ((F.bx - XT_TOTAL % F.G) % F.G + F.G) % F.G;
    for (int u = first; u < P0_UNITS; u += F.G) {
        if (false) {
        } else if (u == XT_TOTAL + ADA_UNITS) {
            float* rc = (float*)(ws + WS_ROPE); float* rs = rc + 2048;
            for (int i = F.tid; i < 2048; i += 512) { const int pos = i >> 5, j = i & 31;
                const float inv = exp2f(-(float)(2 * j) * (13.287712379549449f / 64.0f)); const float ang = (float)pos * inv;
                rc[i] = cosf(ang); rs[i] = sinf(ang); }
        } else {
            const int q = u - (XT_TOTAL + ADA_UNITS + 1), d = q >> 3, h = q & 7;
            bf16_t* gw = (bf16_t*)(ws + WS_GW) + (size_t)(d * 8 + h) * 2 * 128 * 128;
            const float* wa = inptr(p, 13) + (size_t)(d * 8 + h) * 128 * 128; const float* wi = inptr(p, 15) + (size_t)(d * 8 + h) * 128 * 128;
            for (int i = F.tid; i < 128 * 128; i += 512) { const int k = i >> 7, j = i & 127, half = j >> 6, o = j & 63;
                gw[(size_t)(half * 128 + o) * 128 + k] = (bf16_t)(cvt_pk_bf16(wa[i], 0.f) & 0xffffu);
                gw[(size_t)(half * 128 + 64 + o) * 128 + k] = (bf16_t)(cvt_pk_bf16(wi[i], 0.f) & 0xffffu); }
        }
    }
}

__device__ __forceinline__ void moe_tile(const Frame& F, const Params& p, const int layer, const int i) {
    const int T = XT8_DENSE + (i < 2048 ? layer * 2048 + i : XT8_WGU + layer * 1024 + (i - 2048));
    XRegs8 cur; const XTile8 xc = xt8_decode(T, F.wave, p, F.ws); xt8_load(cur, xc, F.lane); xt8_store(F, cur, xc);
}
__device__ __forceinline__ void tail_fill(const Frame& F, const Params& p, const int layer, const int done_slot, const bool exhaust) {
    unsigned* ctl = (unsigned*)(F.ws + WS_CTL);
    LAS int* slot = (LAS int*)(F.lds + LX_MISC + 512);
    __syncthreads();
    if (F.tid == 0 && !exhaust) __hip_atomic_fetch_add(ctl + CW_DONE + done_slot, 1u, __ATOMIC_RELAXED, __HIP_MEMORY_SCOPE_AGENT);
#pragma unroll 1
    for (;;) {
        if (F.tid == 0) { int t = -1;
            const bool go = exhaust || __hip_atomic_load(ctl + CW_DONE + done_slot, __ATOMIC_RELAXED, __HIP_MEMORY_SCOPE_AGENT) < (unsigned)F.G;
            if (go) { const unsigned c = __hip_atomic_fetch_add(ctl + CW_FILL + layer, 1u, __ATOMIC_RELAXED, __HIP_MEMORY_SCOPE_AGENT); if (c < 3072u) t = (int)c; }
            *slot = t; }
        __syncthreads();
        const int t = *slot;
        if (t < 0) break;
        moe_tile(F, p, layer, t);
    }
    __syncthreads();
}

__device__ __forceinline__ void p1_modreduce(const Frame& F, const Params& p) {
    const float* part = (const float*)(F.ws + WS_HID); float* mod = (float*)(F.ws + WS_MOD);
    const int n4 = 2 * 17 * MODW / 4; const float* adab = inptr(p, 5);
    for (int i = F.bx * 512 + F.tid; i < n4; i += F.G * 512) {
        const int e = i * 4, l = e / (17 * MODW), rr = (e / MODW) % 17, n = e % MODW;
        f32x4 s = *(const f32x4*)(adab + (size_t)l * MODW + n);
#pragma unroll
        for (int kc = 0; kc < 16; ++kc) s += *(const f32x4*)(part + ((size_t)(l * 16 + kc) * 17 + rr) * MODW + n);
        *(f32x4*)(mod + e) = s;
    }
}

struct RowRegs { f32x4 x[8]; u32x2 y0[8], y1[8]; };
template <int MODE>
__device__ __forceinline__ void row_load(RowRegs& R, const int t, const int lane, const int fin_mode, const float* xin0, const float* xin2, const bf16_t* XR, const bf16_t* Y0, const bf16_t* Y1) {
    if (MODE == 0 || (MODE == 3 && fin_mode == 2)) {
        const float* src = t < NLAT ? xin0 + (size_t)t * D : xin2 + (size_t)(t - NLAT) * D;
#pragma unroll
        for (int j = 0; j < 8; ++j) R.x[j] = *(const f32x4*)(src + 256 * j + 4 * lane);
    } else {
#pragma unroll
        for (int j = 0; j < 8; ++j) { const u32x2 a = *(const u32x2*)(XR + (size_t)t * D + 256 * j + 4 * lane); R.x[j] = (f32x4){bflo(a.x), bfhi(a.x), bflo(a.y), bfhi(a.y)}; }
    }
    if (MODE == 2 || (MODE == 3 && fin_mode == 0)) {
#pragma unroll
        for (int j = 0; j < 8; ++j) {
#if F8_Y
            R.y0[j].x = *(const unsigned*)((const unsigned char*)Y0 + (size_t)t * D + 256 * j + 4 * lane); R.y1[j].x = *(const unsigned*)((const unsigned char*)Y0 + ((size_t)NTOK + t) * D + 256 * j + 4 * lane);
#else
            R.y0[j] = *(const u32x2*)(Y0 + (size_t)t * D + 256 * j + 4 * lane); R.y1[j] = *(const u32x2*)(Y1 + (size_t)t * D + 256 * j + 4 * lane);
#endif
        }
    }
}
__device__ __forceinline__ void router_logits2(const LAS float* wl, const int lane, const f32x4 (&va)[8], const f32x4 (&vb)[8], float (&pa)[16], float (&pb)[16]) {
#pragma unroll
    for (int e = 0; e < 16; ++e) { f32x2 sa = {0.f, 0.f}, sb = {0.f, 0.f};
#pragma unroll
        for (int j = 0; j < 8; ++j) { const f32x4 wv = *(const LAS f32x4*)(wl + e * 2048 + 256 * j + 4 * lane);
            const f32x2 w01 = {wv[0], wv[1]}, w23 = {wv[2], wv[3]};
            sa += (f32x2){va[j][0], va[j][1]} * w01; sa += (f32x2){va[j][2], va[j][3]} * w23;
            sb += (f32x2){vb[j][0], vb[j][1]} * w01; sb += (f32x2){vb[j][2], vb[j][3]} * w23; }
        pa[e] = wave_allsum(sa[0] + sa[1]); pb[e] = wave_allsum(sb[0] + sb[1]); }
}
__device__ __forceinline__ void router_pick(const float (&pe)[16], const LAS float* rbl, LAS int* lcnt, LAS int* rec, LAS float* recg, const int rl, const bool file) {
    float scv[16], sel[16];
#pragma unroll
    for (int e = 0; e < 16; ++e) { scv[e] = __builtin_amdgcn_rcpf(1.0f + __expf(-pe[e])); sel[e] = scv[e] + rbl[e]; }
    float best = -3.0e38f, bs1 = 0.f, bs2 = 0.f; int be1 = 0, be2 = 1;
#pragma unroll
    for (int g = 0; g < 4; ++g) {
        const float a0 = sel[4 * g], a1 = sel[4 * g + 1], a2 = sel[4 * g + 2], a3 = sel[4 * g + 3];
        const float c0 = scv[4 * g], c1 = scv[4 * g + 1], c2 = scv[4 * g + 2], c3 = scv[4 * g + 3];
        int i1 = 0; float m1 = a0, s1 = c0; if (a1 > m1) { m1 = a1; i1 = 1; s1 = c1; } if (a2 > m1) { m1 = a2; i1 = 2; s1 = c2; } if (a3 > m1) { m1 = a3; i1 = 3; s1 = c3; }
        int i2 = -1; float m2 = -3.0e38f, s2 = 0.f;
        if (i1 != 0 && a0 > m2) { m2 = a0; i2 = 0; s2 = c0; } if (i1 != 1 && a1 > m2) { m2 = a1; i2 = 1; s2 = c1; } if (i1 != 2 && a2 > m2) { m2 = a2; i2 = 2; s2 = c2; } if (i1 != 3 && a3 > m2) { m2 = a3; i2 = 3; s2 = c3; }
        const float gs = m1 + m2;
        if (gs > best) { best = gs; be1 = 4 * g + i1; be2 = 4 * g + i2; bs1 = s1; bs2 = s2; }
    }
    if (file) { const float inv = 1.0f / (bs1 + bs2);
        const int p1 = __hip_atomic_fetch_add(lcnt + be1, 1, __ATOMIC_RELAXED, __HIP_MEMORY_SCOPE_WORKGROUP), p2 = __hip_atomic_fetch_add(lcnt + be2, 1, __ATOMIC_RELAXED, __HIP_MEMORY_SCOPE_WORKGROUP);
        rec[rl * 2] = (be1 << 16) | p1; rec[rl * 2 + 1] = (be2 << 16) | p2; recg[rl * 2] = bs1 * inv; recg[rl * 2 + 1] = bs2 * inv; }
}
__device__ __forceinline__ void ffn_norm_row(const RowRegs& R, const int t, const int lane, const LAS float* cA, const LAS float* cB, unsigned char* HB8, f32x4 (&v)[8]) {
    float ss = 0.f;
#pragma unroll
    for (int j = 0; j < 8; ++j) { v[j] = R.x[j]; ss += v[j][0] * v[j][0] + v[j][1] * v[j][1] + v[j][2] * v[j][2] + v[j][3] * v[j][3]; }
    ss = wave_allsum(ss);
    const float rstd = 1.0f / sqrtf(ss * (1.0f / 2048.0f) + EPS);
#pragma unroll
    for (int j = 0; j < 8; ++j) { const int col = 256 * j + 4 * lane;
        const f32x4 ca = *(const LAS f32x4*)(cA + col), cb = *(const LAS f32x4*)(cB + col);
        v[j] = v[j] * rstd * ca + cb;
        *(unsigned*)(HB8 + (size_t)t * D + col) = pack_fp8x4(clamp8(v[j][0]), clamp8(v[j][1]), clamp8(v[j][2]), clamp8(v[j][3])); }
}
template <int MODE>
__device__ __forceinline__ void row_phase(const Frame& F, const Params& p, const int l, const int fin_mode) {
    unsigned char* ws = F.ws;
    const float* mod = (const float*)(ws + WS_MOD);
    bf16_t* HB = (bf16_t*)(ws + WS_HB); bf16_t* XR = (bf16_t*)(ws + WS_XR);
    const bf16_t* Y0 = (const bf16_t*)(ws + WS_R1); const bf16_t* Y1 = Y0 + (size_t)NTOK * D;
    const int nrows = (MODE == 3 || (MODE == 1 && l == 1)) ? NLAT : NTOK;
    const int chunk = (nrows + F.G - 1) / F.G, r_begin = F.bx * chunk, r_end = min(nrows, r_begin + chunk);
    const int lane = F.lane, w = F.wave;
    constexpr bool OUT8 = MODE == 1 || (MODE == 0 && F8_G1) || (MODE == 2 && F8_QKV);
    LAS float* wl = (LAS float*)F.lds;
    LAS float* cA = (LAS float*)(F.lds + 131072); LAS float* cB = cA + 2048;
    LAS int* lcnt = (LAS int*)(F.lds + LX_LCNT); LAS int* lbase = (LAS int*)(F.lds + LX_LBASE);
    LAS int* rec = (LAS int*)(F.lds + LX_REC); LAS float* recg = (LAS float*)(F.lds + LX_RECG);
    LAS float* rbl = (LAS float*)(F.lds + LX_MISC);
    if (MODE == 1) {
        const float* rw = inptr(p, 26);
        for (int i = F.tid; i < 2048 * 4; i += 512) { const int k = i >> 2, e4 = (i & 3) * 4; const f32x4 v = *(const f32x4*)(rw + k * 16 + e4);
#pragma unroll
            for (int j = 0; j < 4; ++j) wl[(e4 + j) * 2048 + k] = v[j]; }
        if (F.tid < 16) { lcnt[F.tid] = 0; rbl[F.tid] = inptr(p, 27)[F.tid]; }
    }
    const float* gain = MODE == 0 ? inptr(p, 6) : MODE == 1 ? inptr(p, 7) + (size_t)l * D : MODE == 2 ? inptr(p, 6) + D : inptr(p, 8);
    const int sh_off = (MODE == 1) ? 6144 : 0, sc_off = (MODE == 1) ? 8192 : 2048;
    const int lmod = (MODE == 2) ? 1 : l;
    const float* xin0 = inptr(p, 0); const float* xin2 = inptr(p, 2);
    for (int rs = r_begin; rs < r_end; rs += ROWCH) {
        const int re = min(r_end, rs + ROWCH);
        for (int sb = rs; sb < re;) {
            const int b = modrow_of(sb);
            const int bend = b < 16 ? (b + 1) * SEQ : NTOK, se = min(re, bend);
            __syncthreads();
            for (int c4 = F.tid; c4 < 512; c4 += 512) {
                const int col = c4 * 4; const f32x4 g = *(const f32x4*)(gain + col);
                if (MODE == 3) { *(LAS f32x4*)(cA + col) = g; }
                else { const f32x4 sc = *(const f32x4*)(mod + ((size_t)lmod * 17 + b) * MODW + sc_off + col), sh = *(const f32x4*)(mod + ((size_t)lmod * 17 + b) * MODW + sh_off + col);
                    *(LAS f32x4*)(cA + col) = g * (1.0f + sc); *(LAS f32x4*)(cB + col) = sh; }
                if (MODE == 2 || MODE == 3) *(LAS f32x4*)(wl + col) = *(const f32x4*)(mod + ((size_t)l * 17 + b) * MODW + 10240 + col) * (F8_Y ? 1.0f / Y8_SCALE : 1.0f);
            }
            __syncthreads();
            if (MODE == 1) {
                RowRegs c0, c1, n0, n1;
                int t = sb + w;
                if (t < se) row_load<1>(c0, t, lane, fin_mode, xin0, xin2, XR, Y0, Y1);
                if (t + 8 < se) row_load<1>(c1, t + 8, lane, fin_mode, xin0, xin2, XR, Y0, Y1);
#pragma unroll 1
                for (; t < se; t += 16) {
                    const bool has_b = t + 8 < se;
                    if (t + 16 < se) row_load<1>(n0, t + 16, lane, fin_mode, xin0, xin2, XR, Y0, Y1);
                    if (t + 24 < se) row_load<1>(n1, t + 24, lane, fin_mode, xin0, xin2, XR, Y0, Y1);
                    f32x4 va[8], vb[8];
                    ffn_norm_row(c0, t, lane, cA, cB, (unsigned char*)HB, va);
                    if (has_b) ffn_norm_row(c1, t + 8, lane, cA, cB, (unsigned char*)HB, vb);
                    else {
#pragma unroll
                        for (int j = 0; j < 8; ++j) vb[j] = va[j]; }
                    float pa[16], pb[16];
                    router_logits2(wl, lane, va, vb, pa, pb);
                    router_pick(pa, rbl, lcnt, rec, recg, t - rs, lane == 0);
                    router_pick(pb, rbl, lcnt, rec, recg, t + 8 - rs, lane == 0 && has_b);
#pragma unroll
                    for (int j = 0; j < 8; ++j) { c0.x[j] = n0.x[j]; c1.x[j] = n1.x[j]; }
                }
                sb = se; continue;
            }
            RowRegs cur, nxt;
            int t = sb + w;
            if (t < se) row_load<MODE>(cur, t, lane, fin_mode, xin0, xin2, XR, Y0, Y1);
            for (; t < se; t += 8) {
                const int tn = t + 8;
                if (tn < se) row_load<MODE>(nxt, tn, lane, fin_mode, xin0, xin2, XR, Y0, Y1);
                f32x4 v[8];
#pragma unroll
                for (int j = 0; j < 8; ++j) v[j] = cur.x[j];
                if (MODE == 2 || (MODE == 3 && fin_mode == 0)) {
#pragma unroll
                    for (int j = 0; j < 8; ++j) { const int col = 256 * j + 4 * lane; const f32x4 g = *(const LAS f32x4*)(wl + col); const u32x2 a = cur.y0[j], c = cur.y1[j];
#if F8_Y
                        const f32x2 a01 = __builtin_amdgcn_cvt_pk_f32_fp8((int)a.x, false), a23 = __builtin_amdgcn_cvt_pk_f32_fp8((int)a.x, true), c01 = __builtin_amdgcn_cvt_pk_f32_fp8((int)c.x, false), c23 = __builtin_amdgcn_cvt_pk_f32_fp8((int)c.x, true);
                        v[j][0] += g[0] * (a01[0] + c01[0]); v[j][1] += g[1] * (a01[1] + c01[1]);
                        v[j][2] += g[2] * (a23[0] + c23[0]); v[j][3] += g[3] * (a23[1] + c23[1]); }
#else
                        v[j][0] += g[0] * (bflo(a.x) + bflo(c.x)); v[j][1] += g[1] * (bfhi(a.x) + bfhi(c.x));
                        v[j][2] += g[2] * (bflo(a.y) + bflo(c.y)); v[j][3] += g[3] * (bfhi(a.y) + bfhi(c.y)); }
#endif
                    if (MODE == 2) {
#pragma unroll
                        for (int j = 0; j < 8; ++j) { u32x2 o; o.x = cvt_pk_bf16(v[j][0], v[j][1]); o.y = cvt_pk_bf16(v[j][2], v[j][3]); *(u32x2*)(XR + (size_t)t * D + 256 * j + 4 * lane) = o;
                            v[j] = (f32x4){bflo(o.x), bfhi(o.x), bflo(o.y), bfhi(o.y)}; }
                    }
                }
                float ss = 0.f;
#pragma unroll
                for (int j = 0; j < 8; ++j) ss += v[j][0] * v[j][0] + v[j][1] * v[j][1] + v[j][2] * v[j][2] + v[j][3] * v[j][3];
                ss = wave_allsum(ss);
                const float rstd = 1.0f / sqrtf(ss * (1.0f / 2048.0f) + EPS);
                if (MODE == 3) {
                    float* dst = F.out + (size_t)t * D;
#pragma unroll
                    for (int j = 0; j < 8; ++j) { const f32x4 g = *(const LAS f32x4*)(cA + 256 * j + 4 * lane); *(f32x4*)(dst + 256 * j + 4 * lane) = v[j] * rstd * g; }
                } else {
                    if (MODE == 0 && I8_G1) {
                        float am = 0.f;
#pragma unroll
                        for (int j = 0; j < 8; ++j) { const int col = 256 * j + 4 * lane;
                            const f32x4 ca = *(const LAS f32x4*)(cA + col), cb = *(const LAS f32x4*)(cB + col);
                            v[j] = v[j] * rstd * ca + cb;
                            am = fmaxf(am, fmaxf(fmaxf(fabsf(v[j][0]), fabsf(v[j][1])), fmaxf(fabsf(v[j][2]), fabsf(v[j][3])))); }
                        am = fmaxf(wave_allmax(am), 1e-20f);
                        const float qs = 127.0f * __builtin_amdgcn_rcpf(am);
#pragma unroll
                        for (int j = 0; j < 8; ++j) *(unsigned*)((unsigned char*)HB + (size_t)t * D + 256 * j + 4 * lane) = pack_i8x4(v[j][0] * qs, v[j][1] * qs, v[j][2] * qs, v[j][3] * qs);
                        if (lane == 0) ((float*)(ws + WS_ASC))[t] = am * (1.0f / 127.0f);
                    } else
#pragma unroll
                    for (int j = 0; j < 8; ++j) { const int col = 256 * j + 4 * lane;
                        const f32x4 ca = *(const LAS f32x4*)(cA + col), cb = *(const LAS f32x4*)(cB + col);
                        v[j] = v[j] * rstd * ca + cb;
                        if (OUT8) {
                            *(unsigned*)((unsigned char*)HB + (size_t)t * D + col) = pack_fp8x4(clamp8(v[j][0]), clamp8(v[j][1]), clamp8(v[j][2]), clamp8(v[j][3]));
                        } else {
                            u32x2 o; o.x = cvt_pk_bf16(v[j][0], v[j][1]); o.y = cvt_pk_bf16(v[j][2], v[j][3]);
                            *(u32x2*)(HB + (size_t)t * D + col) = o; } }
                }
                if (tn < se) {
#pragma unroll
                    for (int j = 0; j < 8; ++j) { cur.x[j] = nxt.x[j]; cur.y0[j] = nxt.y0[j]; cur.y1[j] = nxt.y1[j]; } }
            }
            sb = se;
        }
        if (MODE == 1) {
            __syncthreads();
            unsigned* cntg = (unsigned*)(ws + WS_CTL) + CW_CNT + l * 64;
            if (F.tid < 16) lbase[F.tid] = (int)__hip_atomic_fetch_add(cntg + F.tid, (unsigned)lcnt[F.tid], __ATOMIC_RELAXED, __HIP_MEMORY_SCOPE_AGENT);
            __syncthreads();
            int* list = (int*)(ws + WS_LIST); float* listg = (float*)(ws + WS_LISTG);
            const int nrec = (re - rs) * 2;
            for (int i = F.tid; i < nrec; i += 512) { const int rr = rec[i], e = rr >> 16, pos = lbase[e] + (rr & 0xffff); const int t = rs + (i >> 1);
                list[(size_t)e * NTOK + pos] = t * 2 + (i & 1); listg[(size_t)e * NTOK + pos] = recg[i]; }
            __syncthreads();
            if (F.tid < 16) lcnt[F.tid] = 0;
            __syncthreads();
        }
    }
}

namespace pg8 {
constexpr int BM = 256, BK = 64, HALF = 128, HTB = HALF * BK * 2, NXCD = 8, WGM = 8;
__host__ __device__ __forceinline__ int lds_byte(int r, int c) { const int st = (r >> 4) * 2 + (c >> 5), rr = r & 15, cc = c & 31, ob = rr * 64 + cc * 2; return st * 1024 + (ob ^ (((ob >> 9) & 1) << 5)); }
__host__ __device__ __forceinline__ void stage_rc(int b, int& R, int& C) { const int st = b / 1024, sb = b % 1024, swz = sb ^ (((sb >> 9) & 1) << 5); R = (st >> 1) * 16 + swz / 64; C = (st & 1) * 32 + (swz % 64) / 2; }
__host__ __device__ __forceinline__ int perm32(int rho) { const int n = rho >> 4, i = rho & 15; return 8 * (i >> 2) + 4 * n + (i & 3); }

struct Unit { int pm, pn, e, pos0, cnt; };

__device__ __forceinline__ bool static_map(long L, int nM, int nN, int& pm, int& pn) {
    const int nwg = nM * nN; if (L >= nwg) return false;
    int wgid = (int)L; { const int q = nwg / NXCD, r = nwg % NXCD, xcd = wgid % NXCD, off = wgid / NXCD; wgid = (xcd < r ? xcd * (q + 1) : r * (q + 1) + (xcd - r) * q) + off; }
    const int nig = WGM * nN, gid = wgid / nig, fm = gid * WGM, gsz = (nM - fm) < WGM ? (nM - fm) : WGM;
    pm = fm + ((wgid % nig) % gsz); pn = (wgid % nig) / gsz; return true;
}
__device__ __forceinline__ bool static_next(int i, int G, int c, int nM, int nN, int& pm, int& pn) { return static_map((long)i * G + c, nM, nN, pm, pn); }
template <bool FP8_, bool I8_ = false> struct DenseSched {
    static constexpr bool GATHER = false, FP8 = FP8_, I8 = I8_; static constexpr int ES = (FP8_ || I8_) ? 1 : 2;
    const char* A; const char* B; int nM, nN, K, G, c; int sw, sa;
    __device__ __forceinline__ int scale_w() const { return sw; } __device__ __forceinline__ int scale_a() const { return sa; }
    __device__ __forceinline__ bool next(int i, Unit& u) const { u.e = 0; u.pos0 = 0; u.cnt = 0; return static_next(i, G, c, nM, nN, u.pm, u.pn); }
    __device__ __forceinline__ const char* a_tile(const Unit& u) const { return A + (size_t)u.pm * 256 * K * ES; }
    __device__ __forceinline__ unsigned a_row_off(const Unit&, int r) const { return (unsigned)r * (unsigned)K * (unsigned)ES; }
    __device__ __forceinline__ const char* b_tile(const Unit& u) const { return B + (size_t)u.pn * 256 * K * ES; }
};
#ifndef MK_NTSTORE
#define MK_NTSTORE 1
#endif
__device__ __forceinline__ void st16(bf16_t* p, const u32x4 v) {
#if MK_NTSTORE
    __builtin_nontemporal_store(v, (u32x4*)p);
#else
    *(u32x4*)p = v;
#endif
}
template <bool FP8_> struct QkvSched {
    static constexpr bool GATHER = false, FP8 = FP8_, I8 = false; static constexpr int ES = FP8_ ? 1 : 2;
    const char* A; const char* B; int K, G, c; int sw, sa;
    __device__ __forceinline__ int scale_w() const { return sw; } __device__ __forceinline__ int scale_a() const { return sa; }
    __device__ __forceinline__ bool next(int i, Unit& u) const {
        u.pos0 = 0; u.cnt = 0; const long L = (long)i * G + c; constexpr int n1 = (NLAT / 256) * 24;
        if (L < n1) { u.e = 0; return static_map(L, NLAT / 256, 24, u.pm, u.pn); }
        u.e = 1; return static_map(L - n1, NCTX / 256, 16, u.pm, u.pn);
    }
    __device__ __forceinline__ const char* a_tile(const Unit& u) const { return A + ((size_t)(u.e ? NLAT : 0) + (size_t)u.pm * 256) * K * ES; }
    __device__ __forceinline__ unsigned a_row_off(const Unit&, int r) const { return (unsigned)r * (unsigned)K * (unsigned)ES; }
    __device__ __forceinline__ const char* b_tile(const Unit& u) const { return B + ((size_t)(u.e ? 2048 : 0) + (size_t)u.pn * 256) * K * ES; }
};
template <bool GATHER_> struct MoeSched {
    static constexpr bool GATHER = GATHER_, FP8 = true, I8 = false;
    const char* A; const char* B; size_t estride; const LAS int* pre; const LAS int* cnt; const int* list; int K, G, c; int sw, sa;
    __device__ __forceinline__ int scale_w() const { return sw; } __device__ __forceinline__ int scale_a() const { return sa; }
    __device__ __forceinline__ bool next(int i, Unit& u) const {
        const int MT = pre[16]; if (!static_next(i, G, c, MT, 8, u.pm, u.pn)) return false;
        int e = 0;
#pragma unroll
        for (int j = 1; j < 16; ++j) e += (u.pm >= pre[j]) ? 1 : 0;
        u.e = e; u.pos0 = (u.pm - pre[e]) * 256; u.cnt = cnt[e]; return true;
    }
    __device__ __forceinline__ const char* a_tile(const Unit& u) const { return GATHER ? A : A + (size_t)u.pm * 256 * K; }
    __device__ __forceinline__ unsigned a_row_off(const Unit& u, int r) const {
        if (!GATHER) return (unsigned)r * (unsigned)K;
        const int pos = u.pos0 + r; const int t2 = pos < u.cnt ? list[(size_t)u.e * NTOK + pos] : 0;
        return (unsigned)(t2 >> 1) * (unsigned)K;
    }
    __device__ __forceinline__ const char* b_tile(const Unit& u) const { return B + (size_t)u.e * estride + (size_t)u.pn * 256 * K; }
};

typedef int i32x4v __attribute__((ext_vector_type(4)));
typedef int i32x8v __attribute__((ext_vector_type(8)));
__device__ __forceinline__ i32x8v cat8(bf16x8 a, bf16x8 b) { const i32x4v x = __builtin_bit_cast(i32x4v, a), y = __builtin_bit_cast(i32x4v, b); return __builtin_shufflevector(x, y, 0, 1, 2, 3, 4, 5, 6, 7); }
__device__ __forceinline__ void mfma8(f32x4& acc, const i32x8v w, const i32x8v a, const int sw, const int sa) {
    asm volatile("v_mfma_scale_f32_16x16x128_f8f6f4 %0, %1, %2, %0, %3, %4 op_sel_hi:[0,0,0]" : "+v"(acc) : "v"(w), "v"(a), "v"(sw), "v"(sa));
}
template <class Epi, class Sched>
__device__ __forceinline__ void gemm_phase(LAS unsigned char* lds, const int wave_in, const int K, const Sched& S, const Epi& E) {
    const int tid = tid_rebuild(wave_in), wid = wave_in, lane = tid & 63, wr = wid >> 2, wc = wid & 3, fr = lane & 15, fq = lane >> 4;
    constexpr bool F8 = Sched::FP8;
    constexpr bool I8 = Sched::I8;
    constexpr int ES = (F8 || I8) ? 1 : 2;
    const int nt = K * ES / (BK * 2);
    constexpr bool GA = Sched::GATHER;
    unsigned voffB[2];
#pragma unroll
    for (int i = 0; i < 2; ++i) { int R, C; stage_rc(tid * 16 + i * 8192, R, C); const int Rb = (R & ~31) + perm32(R & 31); voffB[i] = (unsigned)(Rb * K * ES + C * 2); }
#define PG8_AOFF(u, h, i, dst) do { int R_, C_; stage_rc(tid * 16 + (i) * 8192, R_, C_); dst = S.a_row_off(u, (h) * 128 + R_) + (unsigned)C_ * 2u; } while (0)
    const size_t kstep = (size_t)(BK * 2);
    const size_t hstep = (size_t)HALF * K * ES;
    const unsigned ldsw = (unsigned)wid * 1024u;
    const int aoff = lds_byte(wr * 64 + fr, fq * 8), boff = lds_byte(wc * 32 + fr, fq * 8);
#define PG8_SA(b, h) (((b) * 2 + (h)) * HTB)
#define PG8_SB(b, h) ((4 + (b) * 2 + (h)) * HTB)
#define PG8_STAGE(bufoff, gbase, voff) do { _Pragma("unroll") for (int _i = 0; _i < 2; ++_i) \
        __builtin_amdgcn_global_load_lds((const unsigned*)((const char*)(gbase) + (voff)[_i]), (LAS unsigned*)(lds + (bufoff) + ldsw + _i * 8192), 16, 0, 0); } while (0)
#define PG8_LDA(dst, b, h) do { _Pragma("unroll") for (int m = 0; m < 4; ++m) _Pragma("unroll") for (int k = 0; k < 2; ++k) dst[m][k] = *(const LAS bf16x8*)(lds + PG8_SA(b, h) + aoff + m * 2048 + k * 1024); } while (0)
#define PG8_LDB(dst, b, h) do { _Pragma("unroll") for (int n = 0; n < 2; ++n) _Pragma("unroll") for (int k = 0; k < 2; ++k) dst[n][k] = *(const LAS bf16x8*)(lds + PG8_SB(b, h) + boff + n * 2048 + k * 1024); } while (0)
#define PG8_MMA(ai, bj, At, Bt) do { __builtin_amdgcn_s_setprio(1); if constexpr (F8) { _Pragma("unroll") for (int m = 0; m < 4; ++m) _Pragma("unroll") for (int n = 0; n < 2; ++n) \
        mfma8(acc[ai][bj][m][n], cat8(Bt[n][0], Bt[n][1]), cat8(At[m][0], At[m][1]), S.scale_w(), S.scale_a()); } else if constexpr (I8) { \
        _Pragma("unroll") for (int m = 0; m < 4; ++m) _Pragma("unroll") for (int n = 0; n < 2; ++n) _Pragma("unroll") for (int k = 0; k < 2; ++k) \
        acc[ai][bj][m][n] = __builtin_bit_cast(f32x4, __builtin_amdgcn_mfma_i32_16x16x64_i8(__builtin_bit_cast(i32x4v, Bt[n][k]), __builtin_bit_cast(i32x4v, At[m][k]), __builtin_bit_cast(i32x4v, acc[ai][bj][m][n]), 0, 0, 0)); } else \
        _Pragma("unroll") for (int m = 0; m < 4; ++m) _Pragma("unroll") for (int n = 0; n < 2; ++n) _Pragma("unroll") for (int k = 0; k < 2; ++k) \
        acc[ai][bj][m][n] = __builtin_amdgcn_mfma_f32_16x16x32_bf16(Bt[n][k], At[m][k], acc[ai][bj][m][n], 0, 0, 0); __builtin_amdgcn_s_setprio(0); } while (0)
#define PG8_WAIT_V(n) asm volatile("s_waitcnt vmcnt(" #n ")" ::: "memory")
#define PG8_WAIT_L(n) asm volatile("s_waitcnt lgkmcnt(" #n ")" ::: "memory")
#define PG8_BAR __builtin_amdgcn_s_barrier()
#define PG8_SCHED __builtin_amdgcn_sched_barrier(0)
    Unit cur, nxt; int ui = 0;
    if (!S.next(0, cur)) return;
#if MK_STAGGER
    { const unsigned long long t0_ = __builtin_amdgcn_s_memrealtime(); const unsigned long long dl_ = (unsigned long long)((blockIdx.x >> 3) & 7) * MK_STAGGER;
      while (__builtin_amdgcn_s_memrealtime() - t0_ < dl_) __builtin_amdgcn_s_sleep(8); }
#endif
    f32x4 acc[2][2][4][2];
#pragma unroll
    for (int a = 0; a < 2; ++a)
#pragma unroll
        for (int b = 0; b < 2; ++b)
#pragma unroll
            for (int m = 0; m < 4; ++m)
#pragma unroll
                for (int n = 0; n < 2; ++n) acc[a][b][m][n] = (f32x4){0.f, 0.f, 0.f, 0.f};
    bf16x8 At[4][2], B0[2][2], B1[2][2];
    unsigned cvo0[2], cvo1[2];
#pragma unroll
    for (int i = 0; i < 2; ++i) { PG8_AOFF(cur, 0, i, cvo0[i]); if (GA) PG8_AOFF(cur, 1, i, cvo1[i]); else cvo1[i] = cvo0[i]; }
    LAS unsigned* toff = (LAS unsigned*)(lds + LX + 5120);
    const size_t ahs = GA ? (size_t)0 : hstep;
    const char* cA = S.a_tile(cur); const char* cB = S.b_tile(cur);
    PG8_STAGE(PG8_SB(0, 0), cB, voffB); PG8_STAGE(PG8_SA(0, 0), cA, cvo0); PG8_STAGE(PG8_SB(0, 1), cB + hstep, voffB); PG8_STAGE(PG8_SA(0, 1), cA + ahs, cvo1);
    if (wr == 1) PG8_BAR;
#if MK_8PHASE
    PG8_WAIT_V(4); PG8_BAR;
#else
    PG8_WAIT_V(0); PG8_BAR;
#endif
    PG8_STAGE(PG8_SB(1, 0), cB + kstep, voffB); PG8_STAGE(PG8_SA(1, 0), cA + kstep, cvo0); PG8_STAGE(PG8_SB(1, 1), cB + hstep + kstep, voffB);
    PG8_WAIT_V(6); PG8_BAR;
    for (;;) {
        const bool has_next = S.next(ui + 1, nxt);
        const char* nA = has_next ? S.a_tile(nxt) : cA; const char* nB = has_next ? S.b_tile(nxt) : cB;
        if (GA && has_next && tid < 256) toff[((ui + 1) & 1) * 256 + tid] = S.a_row_off(nxt, tid);
        for (int t = 0; t < nt; t += 2) {
            const bool last = (t == nt - 2);
            const char* a1 = cA + (size_t)(t + 1) * kstep;
            const char* a2 = last ? nA : cA + (size_t)(t + 2) * kstep; const char* b2 = last ? nB : cB + (size_t)(t + 2) * kstep;
            const char* a3 = a2 + kstep; const char* b3 = b2 + kstep;
#if MK_8PHASE
            PG8_LDB(B0, 0, 0); PG8_SCHED; PG8_LDA(At, 0, 0); PG8_STAGE(PG8_SA(1, 1), a1 + ahs, cvo1);
            PG8_WAIT_L(8); PG8_BAR; PG8_WAIT_L(0); PG8_MMA(0, 0, At, B0); PG8_BAR; PG8_SCHED;
            if (GA && last && has_next) {
#pragma unroll
                for (int i = 0; i < 2; ++i) { int R_, C_; stage_rc(tid * 16 + i * 8192, R_, C_); const int tb_ = ((ui + 1) & 1) * 256; cvo0[i] = toff[tb_ + R_] + (unsigned)C_ * 2u; cvo1[i] = toff[tb_ + 128 + R_] + (unsigned)C_ * 2u; } }
            PG8_LDB(B1, 0, 1); PG8_STAGE(PG8_SB(0, 0), b2, voffB);
            PG8_BAR; PG8_WAIT_L(0); PG8_MMA(0, 1, At, B1); PG8_BAR;
            PG8_LDA(At, 0, 1); PG8_STAGE(PG8_SA(0, 0), a2, cvo0);
            PG8_BAR; PG8_WAIT_L(0); PG8_MMA(1, 0, At, B0); PG8_BAR; PG8_SCHED;
            PG8_STAGE(PG8_SB(0, 1), b2 + hstep, voffB);
            PG8_WAIT_V(6); PG8_BAR; PG8_MMA(1, 1, At, B1); PG8_BAR;
            PG8_LDB(B0, 1, 0); PG8_SCHED; PG8_LDA(At, 1, 0); PG8_STAGE(PG8_SA(0, 1), a2 + ahs, cvo1);
            PG8_WAIT_L(8); PG8_BAR; PG8_WAIT_L(0); PG8_MMA(0, 0, At, B0); PG8_BAR; PG8_SCHED;
            PG8_LDB(B1, 1, 1); PG8_STAGE(PG8_SB(1, 0), b3, voffB);
            PG8_BAR; PG8_WAIT_L(0); PG8_MMA(0, 1, At, B1); PG8_BAR;
            PG8_LDA(At, 1, 1); PG8_STAGE(PG8_SA(1, 0), a3, cvo0);
            PG8_BAR; PG8_WAIT_L(0); PG8_MMA(1, 0, At, B0); PG8_BAR; PG8_SCHED;
            PG8_STAGE(PG8_SB(1, 1), b3 + hstep, voffB);
            PG8_WAIT_V(6); PG8_BAR; PG8_MMA(1, 1, At, B1); PG8_BAR;
#else
            PG8_LDB(B0, 0, 0); PG8_LDB(B1, 0, 1); PG8_SCHED; PG8_LDA(At, 0, 0); PG8_STAGE(PG8_SA(1, 1), a1 + ahs, cvo1);
            PG8_WAIT_L(0); PG8_BAR; PG8_MMA(0, 0, At, B0); PG8_MMA(0, 1, At, B1); PG8_BAR; PG8_SCHED;
            if (GA && last && has_next) {
#pragma unroll
                for (int i = 0; i < 2; ++i) { int R_, C_; stage_rc(tid * 16 + i * 8192, R_, C_); const int tb_ = ((ui + 1) & 1) * 256; cvo0[i] = toff[tb_ + R_] + (unsigned)C_ * 2u; cvo1[i] = toff[tb_ + 128 + R_] + (unsigned)C_ * 2u; } }
            PG8_LDA(At, 0, 1); PG8_STAGE(PG8_SB(0, 0), b2, voffB); PG8_STAGE(PG8_SA(0, 0), a2, cvo0); PG8_STAGE(PG8_SB(0, 1), b2 + hstep, voffB);
            PG8_WAIT_V(6); PG8_WAIT_L(0); PG8_BAR; PG8_MMA(1, 0, At, B0); PG8_MMA(1, 1, At, B1); PG8_BAR; PG8_SCHED;
            PG8_LDB(B0, 1, 0); PG8_LDB(B1, 1, 1); PG8_SCHED; PG8_LDA(At, 1, 0); PG8_STAGE(PG8_SA(0, 1), a2 + ahs, cvo1);
            PG8_WAIT_L(0); PG8_BAR; PG8_MMA(0, 0, At, B0); PG8_MMA(0, 1, At, B1); PG8_BAR; PG8_SCHED;
            PG8_LDA(At, 1, 1); PG8_STAGE(PG8_SB(1, 0), b3, voffB); PG8_STAGE(PG8_SA(1, 0), a3, cvo0); PG8_STAGE(PG8_SB(1, 1), b3 + hstep, voffB);
            PG8_WAIT_V(6); PG8_WAIT_L(0); PG8_BAR; PG8_MMA(1, 0, At, B0); PG8_MMA(1, 1, At, B1); PG8_BAR; PG8_SCHED;
#endif
        }
        if constexpr (F8) asm volatile("s_nop 15\n\ts_nop 15" : "+v"(acc[1][1][0][0]), "+v"(acc[1][1][0][1]), "+v"(acc[1][1][1][0]), "+v"(acc[1][1][1][1]), "+v"(acc[1][1][2][0]), "+v"(acc[1][1][2][1]), "+v"(acc[1][1][3][0]), "+v"(acc[1][1][3][1]) :: "memory");
        int lane_e = lane_id(); asm volatile("" : "+v"(lane_e));
        const int fr_e = lane_e & 15, fq_e = lane_e >> 4;
        bool vt_done = false;
        if constexpr (Epi::VT) {
            if (E.is_v(cur)) {
                const int col_v = wc * 32 + 8 * fq_e;
#pragma unroll
                for (int ai = 0; ai < 2; ++ai) { unsigned w[16];
#pragma unroll
                    for (int n = 0; n < 2; ++n)
#pragma unroll
                        for (int j = 0; j < 4; ++j) {
                            w[4 * n + j] = pack_fp8x4(clamp8(acc[ai][0][0][n][j]), clamp8(acc[ai][0][1][n][j]), clamp8(acc[ai][0][2][n][j]), clamp8(acc[ai][0][3][n][j]));
                            w[8 + 4 * n + j] = pack_fp8x4(clamp8(acc[ai][1][0][n][j]), clamp8(acc[ai][1][1][n][j]), clamp8(acc[ai][1][2][n][j]), clamp8(acc[ai][1][3][n][j])); }
                    E.vstore(cur, ai * HALF + wr * 64, fr_e, col_v, w); }
                vt_done = true;
            }
        }
        if (!vt_done) {
            const int col_e = wc * 32 + 8 * fq_e;
            typename Epi::UPre up; E.upre(cur, col_e, up);
#pragma unroll
            for (int b0 = 0; b0 < 8; b0 += Epi::EB) {
                typename Epi::Pre pre[Epi::EB];
#pragma unroll
                for (int q = 0; q < Epi::EB; ++q) { const int ai = (b0 + q) >> 2, m = (b0 + q) & 3; E.pre(cur, ai * HALF + wr * 64 + m * 16 + fr_e, col_e, pre[q]); }
#pragma unroll
                for (int q = 0; q < Epi::EB; ++q) { const int ai = (b0 + q) >> 2, m = (b0 + q) & 3;
                    float lo[8], hi[8];
#pragma unroll
                    for (int n = 0; n < 2; ++n)
#pragma unroll
                        for (int j = 0; j < 4; ++j) {
                            if constexpr (I8) { lo[4 * n + j] = (float)__float_as_int(acc[ai][0][m][n][j]); hi[4 * n + j] = (float)__float_as_int(acc[ai][1][m][n][j]); }
                            else { lo[4 * n + j] = acc[ai][0][m][n][j]; hi[4 * n + j] = acc[ai][1][m][n][j]; } }
                    E.put(cur, ai * HALF + wr * 64 + m * 16 + fr_e, col_e, lo, hi, pre[q], up);
                }
                asm volatile("" ::: "memory");
            }
        }
        if (!has_next) break;
#pragma unroll
        for (int a = 0; a < 2; ++a)
#pragma unroll
            for (int b = 0; b < 2; ++b)
#pragma unroll
                for (int m = 0; m < 4; ++m)
#pragma unroll
                    for (int n = 0; n < 2; ++n) acc[a][b][m][n] = (f32x4){0.f, 0.f, 0.f, 0.f};
        cur = nxt; cA = nA; cB = nB; ++ui;
    }
    PG8_WAIT_V(0);
    if (wr == 0) PG8_BAR;
    PG8_BAR;
#undef PG8_AOFF
#undef PG8_SA
#undef PG8_SB
#undef PG8_STAGE
#undef PG8_LDA
#undef PG8_LDB
#undef PG8_MMA
#undef PG8_WAIT_V
#undef PG8_WAIT_L
#undef PG8_BAR
#undef PG8_SCHED
}

template <class Epi, class Sched>
__device__ __forceinline__ void gemm_naive(const int K, const Sched& S, const Epi& E) {
    Unit u;
    for (int i = 0; S.next(i, u); ++i) {
        const char* At = S.a_tile(u); const char* Bt = S.b_tile(u);
        for (int item = threadIdx.x; item < 4096; item += 512) {
            const int r = item & 255, c = (item >> 8) * 8;
            const bf16_t* a = (const bf16_t*)(At + S.a_row_off(u, r));
            float lo[8], hi[8];
#pragma unroll
            for (int j = 0; j < 8; ++j) { lo[j] = 0.f; hi[j] = 0.f; }
            for (int k = 0; k < K; k += 8) {
                float av[8]; unpack8(*(const u32x4*)(a + k), av);
#pragma unroll
                for (int j = 0; j < 8; ++j) { float bv[8];
                    unpack8(*(const u32x4*)((const bf16_t*)Bt + (size_t)(c + j) * K + k), bv);
#pragma unroll
                    for (int q = 0; q < 8; ++q) lo[j] += av[q] * bv[q];
                    unpack8(*(const u32x4*)((const bf16_t*)Bt + (size_t)(128 + c + j) * K + k), bv);
#pragma unroll
                    for (int q = 0; q < 8; ++q) hi[j] += av[q] * bv[q]; }
            }
            { typename Epi::UPre up; E.upre(u, c, up); typename Epi::Pre pr; E.pre(u, r, c, pr); E.put(u, r, c, lo, hi, pr, up); }
        }
    }
}
template <class Epi, class Sched>
__device__ __forceinline__ void gemm_run(LAS unsigned char* lds, const int wave_in, const int K, const Sched& S, const Epi& E) {
#if MK_NAIVE
    (void)wave_in; gemm_naive<Epi, Sched>(K, S, E);
#else
    gemm_phase<Epi, Sched>(lds, wave_in, K, S, E);
#endif
}

struct EpiIn0 {
    static constexpr int EB = 8; static constexpr bool VT = false; struct Pre { float rs; }; struct UPre {};
    bf16_t* P; bf16_t* GB; bf16_t* GY; bf16_t* XB; const float* asc;
    __device__ __forceinline__ void upre(const Unit&, int, UPre&) const {}
    __device__ __forceinline__ void pre(const Unit& u, int r, int, Pre& p) const { p.rs = I8_G1 ? asc[(size_t)u.pm * 256 + r] * W1DQ : 1.0f; }
    __device__ __forceinline__ void put(const Unit& u, int r, int c, const float (&lo_)[8], const float (&hi_)[8], const Pre& p, const UPre&) const {
        const size_t t = (size_t)u.pm * 256 + r;
        float lo[8], hi[8];
#pragma unroll
        for (int j = 0; j < 8; ++j) { lo[j] = I8_G1 ? lo_[j] * p.rs : lo_[j]; hi[j] = I8_G1 ? hi_[j] * p.rs : hi_[j]; }
        if (u.pn < 8) { float v[8];
#pragma unroll
            for (int j = 0; j < 8; ++j) v[j] = lo[j] * hi[j];
            st16((P + t * 1024 + u.pn * 128 + c), pack8(v)); }
        else if (u.pn < 12) { bf16_t* d = GB + t * 1024 + (u.pn - 8) * 256 + c; st16(d, pack8(lo)); st16((d + 128), pack8(hi)); }
        else if (u.pn < 16) { float a[8], b[8];
#pragma unroll
            for (int j = 0; j < 8; ++j) { a[j] = fgelu_tanh(lo[j]); b[j] = fgelu_tanh(hi[j]); }
            bf16_t* d = GY + t * 1024 + (u.pn - 12) * 256 + c; st16(d, pack8(a)); st16((d + 128), pack8(b)); }
        else { bf16_t* d = XB + t * 1024 + (u.pn - 16) * 256 + c; st16(d, pack8(lo)); st16((d + 128), pack8(hi)); }
    }
};
template <bool F32BASE> struct EpiRes {
    static constexpr int EB = 4; static constexpr bool VT = false;
    struct UPre { f32x4 g[4]; };
    struct Pre { u32x4 x[F32BASE ? 4 : 2]; };
    const float* base_lat; const float* base_ctx; bf16_t* XR; const float* g1;
    __device__ __forceinline__ void upre(const Unit& u, int c, UPre& up) const {
        const float* gp = g1 + (size_t)modrow_of(u.pm * 256) * MODW + u.pn * 256 + c;
        up.g[0] = *(const f32x4*)gp; up.g[1] = *(const f32x4*)(gp + 4); up.g[2] = *(const f32x4*)(gp + 128); up.g[3] = *(const f32x4*)(gp + 132);
    }
    __device__ __forceinline__ void pre(const Unit& u, int r, int c, Pre& p) const {
        const int t0 = u.pm * 256, col = u.pn * 256 + c;
        if (F32BASE) { const float* bp = t0 < NLAT ? base_lat + (size_t)(t0 + r) * D + col : base_ctx + (size_t)(t0 - NLAT + r) * D + col;
            p.x[0] = *(const u32x4*)bp; p.x[1] = *(const u32x4*)(bp + 4); p.x[2] = *(const u32x4*)(bp + 128); p.x[3] = *(const u32x4*)(bp + 132); }
        else { const bf16_t* dp = XR + (size_t)(t0 + r) * D + col; p.x[0] = *(const u32x4*)dp; p.x[1] = *(const u32x4*)(dp + 128); }
    }
    __device__ __forceinline__ void put(const Unit& u, int r, int c, const float (&lo)[8], const float (&hi)[8], const Pre& p, const UPre& up) const {
        const int t0 = u.pm * 256, col = u.pn * 256 + c;
        float xl[8], xh[8];
        if (F32BASE) {
#pragma unroll
            for (int j = 0; j < 4; ++j) { xl[j] = __uint_as_float(p.x[0][j]); xl[4 + j] = __uint_as_float(p.x[1][j]); xh[j] = __uint_as_float(p.x[2][j]); xh[4 + j] = __uint_as_float(p.x[3][j]); } }
        else { unpack8(p.x[0], xl); unpack8(p.x[1], xh); }
#pragma unroll
        for (int j = 0; j < 4; ++j) { xl[j] += up.g[0][j] * lo[j]; xl[4 + j] += up.g[1][j] * lo[4 + j]; xh[j] += up.g[2][j] * hi[j]; xh[4 + j] += up.g[3][j] * hi[4 + j]; }
        bf16_t* dp = XR + (size_t)(t0 + r) * D + col;
        st16(dp, pack8(xl)); st16((dp + 128), pack8(xh));
    }
};
struct EpiGU {
    static constexpr int EB = 8; static constexpr bool VT = false; struct Pre {}; struct UPre {};
    unsigned char* hid;
    __device__ __forceinline__ void upre(const Unit&, int, UPre&) const {}
    __device__ __forceinline__ void pre(const Unit&, int, int, Pre&) const {}
    __device__ __forceinline__ void put(const Unit& u, int r, int c, const float (&lo)[8], const float (&hi)[8], const Pre&, const UPre&) const {
        float v[8];
#pragma unroll
        for (int j = 0; j < 8; ++j) v[j] = clamp8(lo[j] * __builtin_amdgcn_rcpf(1.0f + __builtin_amdgcn_exp2f(-lo[j])) * hi[j]);
        u32x2 w; w.x = pack_fp8x4(v[0], v[1], v[2], v[3]); w.y = pack_fp8x4(v[4], v[5], v[6], v[7]);
        *(u32x2*)(hid + ((size_t)u.pm * 256 + r) * FF + u.pn * 128 + c) = w;
    }
};
struct EpiDN {
    static constexpr int EB = 8; static constexpr bool VT = false; struct Pre { int t2; float g; }; struct UPre {};
    bf16_t* Y; const int* list; const float* listg;
    __device__ __forceinline__ void upre(const Unit&, int, UPre&) const {}
    __device__ __forceinline__ void pre(const Unit& u, int r, int, Pre& p) const {
        const int pos = u.pos0 + r;
        const int t2 = list[(size_t)u.e * NTOK + pos]; p.g = listg[(size_t)u.e * NTOK + pos]; p.t2 = pos < u.cnt ? t2 : -1;
    }
    __device__ __forceinline__ void put(const Unit& u, int r, int c, const float (&lo)[8], const float (&hi)[8], const Pre& p, const UPre&) const {
        const int t2 = p.t2; const float g = p.g; if (t2 < 0) return;
        float a[8], b[8];
#if F8_Y
        const float g8 = g * Y8_SCALE;
#pragma unroll
        for (int j = 0; j < 8; ++j) { a[j] = clamp8(g8 * lo[j]); b[j] = clamp8(g8 * hi[j]); }
        unsigned char* d = (unsigned char*)Y + ((size_t)(t2 & 1) * NTOK + (t2 >> 1)) * D + u.pn * 256 + 2 * c;
        u32x4 w; w.x = pack_fp8x4(a[0], a[1], a[2], a[3]); w.y = pack_fp8x4(a[4], a[5], a[6], a[7]); w.z = pack_fp8x4(b[0], b[1], b[2], b[3]); w.w = pack_fp8x4(b[4], b[5], b[6], b[7]);
        *(u32x4*)d = w;
#else
#pragma unroll
        for (int j = 0; j < 8; ++j) { a[j] = g * lo[j]; b[j] = g * hi[j]; }
        bf16_t* d = Y + ((size_t)(t2 & 1) * NTOK + (t2 >> 1)) * D + u.pn * 256 + c;
        st16(d, pack8(a)); st16((d + 128), pack8(b));
#endif
    }
};
struct EpiQKV {
    static constexpr int EB = 2; static constexpr bool VT = F8_PV != 0; struct Pre { f32x4 c0, c1, s0, s1; }; struct UPre {};
    bf16_t* Q; bf16_t* Kb; bf16_t* Vb; const float* ropec; const float* ropes;
    __device__ __forceinline__ bool is_v(const Unit& u) const { return u.pn + 8 * u.e >= 16; }
    __device__ __forceinline__ void vstore(const Unit& u, int r0, int fr, int c, const unsigned (&w)[16]) const {
        const int ctx = u.e, t0 = u.pm * 256 + r0, png = u.pn + 8 * ctx;
        const int b = ctx ? (t0 >> 8) : (t0 >> 11), kv0 = ctx ? (t0 & 255) : CTXL + (t0 & 2047);
        unsigned char* vt = (unsigned char*)Vb + ((size_t)(b * 8 + (png - 16)) * 256 + c) * KVL + kv0 + 4 * fr;
#pragma unroll
        for (int j = 0; j < 8; ++j) { *(unsigned*)(vt + (size_t)j * KVL) = w[j]; *(unsigned*)(vt + (size_t)(128 + j) * KVL) = w[8 + j]; }
    }
    __device__ __forceinline__ void upre(const Unit&, int, UPre&) const {}
    __device__ __forceinline__ void pre(const Unit& u, int r, int c, Pre& p) const {
        { const int s = (u.pm * 256 + r) & 2047, a = (c >> 5) & 1, j0 = c & 31, pos = a ? (s & 63) : (s >> 6);
            p.c0 = *(const f32x4*)(ropec + pos * 32 + j0); p.c1 = *(const f32x4*)(ropec + pos * 32 + j0 + 4); p.s0 = *(const f32x4*)(ropes + pos * 32 + j0); p.s1 = *(const f32x4*)(ropes + pos * 32 + j0 + 4); }
    }
    __device__ __forceinline__ void put(const Unit& u, int r, int c, const float (&lo)[8], const float (&hi)[8], const Pre& p, const UPre&) const {
        const int ctx = u.e, t = u.pm * 256 + r, png = u.pn + 8 * ctx;
        int b, s; size_t kvrow;
        if (ctx) { b = t >> 8; s = t & 255; kvrow = (size_t)b * KVL + s; } else { b = t >> 11; s = t & 2047; kvrow = (size_t)b * KVL + CTXL + s; }
        if (png < 16) {
            const int head = png & 7, m = c >> 6, a = (c >> 5) & 1, j0 = c & 31;
            float ol[8], oh[8];
            if (!ctx) { const f32x4 c0 = p.c0, c1 = p.c1, s0 = p.s0, s1 = p.s1;
#pragma unroll
                for (int j = 0; j < 8; ++j) { const float cs = j < 4 ? c0[j & 3] : c1[j & 3], sn = j < 4 ? s0[j & 3] : s1[j & 3]; ol[j] = lo[j] * cs - hi[j] * sn; oh[j] = hi[j] * cs + lo[j] * sn; } }
            else {
#pragma unroll
                for (int j = 0; j < 8; ++j) { ol[j] = lo[j]; oh[j] = hi[j]; } }
#if F8_QK
            unsigned char* d = (png < 8 ? (unsigned char*)Q + (size_t)t * D : (unsigned char*)Kb + kvrow * D) + head * 256 + m * 128 + a * 64 + (j0 >> 3) * 16;
            u32x4 w; w.x = pack_fp8x4(clamp8(ol[0]), clamp8(ol[1]), clamp8(ol[2]), clamp8(ol[3])); w.y = pack_fp8x4(clamp8(ol[4]), clamp8(ol[5]), clamp8(ol[6]), clamp8(ol[7]));
            w.z = pack_fp8x4(clamp8(oh[0]), clamp8(oh[1]), clamp8(oh[2]), clamp8(oh[3])); w.w = pack_fp8x4(clamp8(oh[4]), clamp8(oh[5]), clamp8(oh[6]), clamp8(oh[7]));
            *(u32x4*)d = w;
#else
            bf16_t* d = (png < 8 ? Q + (size_t)t * D : Kb + kvrow * D) + head * 256 + m * 128 + a * 64 + j0;
            st16(d, pack8(ol)); st16((d + 32), pack8(oh));
#endif
        } else {
#if F8_PV
            unsigned char* vt = (unsigned char*)Vb + ((size_t)(b * 8 + (png - 16)) * 256 + c) * KVL + (kvrow - (size_t)b * KVL);
#pragma unroll
            for (int j = 0; j < 8; ++j) { vt[(size_t)j * KVL] = (unsigned char)pack_fp8x1(clamp8(lo[j])); vt[(size_t)(128 + j) * KVL] = (unsigned char)pack_fp8x1(clamp8(hi[j])); }
#else
            bf16_t* d = Vb + kvrow * D + (png - 16) * 256 + c; st16(d, pack8(lo)); st16((d + 128), pack8(hi));
#endif
        }
    }
};
}

__device__ __forceinline__ void scan_phase(const Frame& F, const Params& p) {
    unsigned char* ws = F.ws;
    const bf16_t* P = (const bf16_t*)(ws + WS_R1); const bf16_t* GB = P + (size_t)NTOK * 1024; const bf16_t* GY = GB + (size_t)NTOK * 1024; const bf16_t* XB = GY + (size_t)NTOK * 1024;
    bf16_t* A3 = (bf16_t*)(ws + WS_HB);
    float* HS = (float*)(ws + WS_HID);
    const int tid = F.tid, lane = F.lane, w = F.wave;
    {
        const float* cw = inptr(p, 10);
        for (int it = F.bx * 512 + tid; it < NTOK * 128; it += F.G * 512) {
            const int t = it >> 7, ch = (it & 127) * 8;
            int s, len; if (t < NLAT) { s = t & 2047; len = SEQ; } else { s = (t - NLAT) & 255; len = CTXL; }
            float pm[8], pc[8], pp[8], gb[8], o[8];
            unpack8(*(const u32x4*)(P + (size_t)t * 1024 + ch), pc);
            if (s >= 1) unpack8(*(const u32x4*)(P + (size_t)(t - 1) * 1024 + ch), pm); else {
#pragma unroll
                for (int j = 0; j < 8; ++j) pm[j] = 0.f; }
            if (s + 1 < len) unpack8(*(const u32x4*)(P + (size_t)(t + 1) * 1024 + ch), pp); else {
#pragma unroll
                for (int j = 0; j < 8; ++j) pp[j] = 0.f; }
            unpack8(*(const u32x4*)(GB + (size_t)t * 1024 + ch), gb);
#pragma unroll
            for (int j = 0; j < 8; ++j) o[j] = gb[j] * (cw[ch + j] * pm[j] + cw[1024 + ch + j] * pc[j] + cw[2048 + ch + j] * pp[j]);
            if (F8_G3) { u32x2 w8; w8.x = pack_fp8x4(clamp8(A8_SCALE * o[0]), clamp8(A8_SCALE * o[1]), clamp8(A8_SCALE * o[2]), clamp8(A8_SCALE * o[3])); w8.y = pack_fp8x4(clamp8(A8_SCALE * o[4]), clamp8(A8_SCALE * o[5]), clamp8(A8_SCALE * o[6]), clamp8(A8_SCALE * o[7]));
                *(u32x2*)((unsigned char*)A3 + (size_t)t * D + ch) = w8; }
            else *(u32x4*)(A3 + (size_t)t * D + ch) = pack8(o);
        }
    }
    LAS unsigned char* lds = F.lds;
    LAS bf16_t* Ush = (LAS bf16_t*)lds;
    LAS bf16_t* Gsh = (LAS bf16_t*)(lds + 34816);
    LAS float* Ash = (LAS float*)(lds + 69632); LAS float* Bsh = (LAS float*)(lds + 102400);
    LAS float* SA = (LAS float*)(lds + 135168); LAS float* SB = (LAS float*)(lds + 137216); LAS float* carry = (LAS float*)(lds + 139264);
    for (int unit = F.bx; unit < 256; unit += F.G) {
        const int b = unit >> 4, hd = (unit >> 1) & 7, half = unit & 1;
        const int cg = (tid & 15) * 8, chg = hd * 128 + cg;
        LAS float* cwl = (LAS float*)(lds + 139520);
        { const float* cbw = inptr(p, 11); const float* cbb = inptr(p, 12);
          __syncthreads();
          cwl[tid] = cbw[(tid >> 7) * 1024 + hd * 128 + (tid & 127)]; if (tid < 128) cwl[512 + tid] = cbb[hd * 128 + tid];
          __syncthreads(); }
        const int tb = w & 3, cbk = w >> 2, r32 = lane & 31, hi = lane >> 5;
        const int chl = cbk * 32 + r32, chglob = hd * 128 + half * 64 + chl;
        const int sch = tid & 63, chunk = tid >> 6, schglob = hd * 128 + half * 64 + sch;
        for (int dir = 0; dir < 2; ++dir) {
            const bf16_t* gw = (const bf16_t*)(ws + WS_GW) + ((size_t)((dir * 8 + hd) * 2 + half) * 128) * 128;
            __syncthreads();
#pragma unroll
            for (int it = 0; it < 4; ++it) { const int q = tid + 512 * it, row = q >> 4, pc = q & 15; *(LAS u32x4*)(Gsh + row * 136 + pc * 8) = *(const u32x4*)(gw + (size_t)row * 128 + pc * 8); }
            const float ba = inptr(p, 14)[dir * 1024 + chglob], bi = inptr(p, 16)[dir * 1024 + chglob];
            const float cl = 8.0f * log1pf(expf(-(inptr(p, 17)[dir * 1024 + chglob])));
            if (tid < 64) carry[tid] = 0.f;
            __syncthreads();
            for (int ti = 0; ti < 18; ++ti) {
                int seg_ctx, s0;
                if (ti < 2) { seg_ctx = 1; s0 = dir == 0 ? ti * 128 : (1 - ti) * 128; } else { seg_ctx = 0; s0 = dir == 0 ? (ti - 2) * 128 : (17 - ti) * 128; }
                const int len = seg_ctx ? CTXL : SEQ; const size_t row0 = seg_ctx ? (size_t)NLAT + b * CTXL : (size_t)b * SEQ;
                {
                    const int g4 = (tid >> 4) * 4;
                    u32x4 xp[7];
#pragma unroll
                    for (int r = 0; r < 7; ++r) { const int sq = s0 + g4 + r - 2; xp[r] = (u32x4){0u, 0u, 0u, 0u};
                        if (sq >= 0 && sq < len) xp[r] = *(const u32x4*)(XB + (row0 + sq) * 1024 + chg); }
                    float uacc[4][8];
                    { const f32x4 b0 = *(const LAS f32x4*)(cwl + 512 + cg), b1 = *(const LAS f32x4*)(cwl + 512 + cg + 4);
#pragma unroll
                      for (int i = 0; i < 4; ++i)
#pragma unroll
                        for (int j = 0; j < 4; ++j) { uacc[i][j] = b0[j]; uacc[i][4 + j] = b1[j]; } }
#pragma unroll
                    for (int r = 0; r < 7; ++r) { float xv[8]; unpack8(xp[r], xv);
#pragma unroll
                        for (int i = 0; i < 4; ++i) { const int q = r - i;
                            if (q >= 0 && q < 4) { const f32x4 w0 = *(const LAS f32x4*)(cwl + q * 128 + cg), w1 = *(const LAS f32x4*)(cwl + q * 128 + cg + 4);
#pragma unroll
                                for (int j = 0; j < 4; ++j) { uacc[i][j] += w0[j] * xv[j]; uacc[i][4 + j] += w1[j] * xv[4 + j]; } } } }
#pragma unroll
                    for (int i = 0; i < 4; ++i) *(LAS u32x4*)(Ush + (g4 + i) * 136 + cg) = pack8(uacc[i]);
                }
                __syncthreads();
                f32x16 ar = {}, ai = {};
#pragma unroll
                for (int ks = 0; ks < 8; ++ks) { const bf16x8 af = *(const LAS bf16x8*)(Ush + (tb * 32 + r32) * 136 + ks * 16 + hi * 8);
                    const bf16x8 br = *(const LAS bf16x8*)(Gsh + (cbk * 32 + r32) * 136 + ks * 16 + hi * 8), bi8 = *(const LAS bf16x8*)(Gsh + (64 + cbk * 32 + r32) * 136 + ks * 16 + hi * 8);
                    ar = __builtin_amdgcn_mfma_f32_32x32x16_bf16(af, br, ar, 0, 0, 0); ai = __builtin_amdgcn_mfma_f32_32x32x16_bf16(af, bi8, ai, 0, 0, 0); }
#pragma unroll
                for (int rg = 0; rg < 16; ++rg) { const int tok = tb * 32 + (rg & 3) + 8 * (rg >> 2) + 4 * hi;
                    const float rr = fsigmoid(ar[rg] + ba), ii = fsigmoid(ai[rg] + bi);
                    const float la = -cl * rr, a = __expf(la);
                    const float om = 1.0f - a * a;
                    const float uu = bf2f(Ush[tok * 136 + half * 64 + chl]);
                    Ash[tok * 64 + chl] = a; Bsh[tok * 64 + chl] = __builtin_amdgcn_sqrtf(om) * ii * uu; }
                __syncthreads();
                {
                    const int tile_id = seg_ctx ? (s0 >> 7) : 2 + (s0 >> 7);
                    float* hsp = HS + (((size_t)unit * 18 + tile_id) * 512 + tid) * 16;
                    const size_t rowc = row0 + s0 + chunk * 16;
                    f32x4 hf4[4]; unsigned short gyv[16];
                    if (dir == 1) {
#pragma unroll
                        for (int q = 0; q < 4; ++q) hf4[q] = *(const f32x4*)(hsp + 4 * q);
#pragma unroll
                        for (int i = 0; i < 16; ++i) gyv[i] = GY[(rowc + i) * 1024 + schglob];
                    }
                    float av[16], bv[16];
#pragma unroll
                    for (int i = 0; i < 16; ++i) { av[i] = Ash[(chunk * 16 + i) * 64 + sch]; bv[i] = Bsh[(chunk * 16 + i) * 64 + sch]; }
                    float Aa = 1.f, Hh = 0.f;
                    if (dir == 0) {
#pragma unroll
                        for (int i = 0; i < 16; ++i) { Hh = av[i] * Hh + bv[i]; Aa *= av[i]; } }
                    else {
#pragma unroll
                        for (int i = 15; i >= 0; --i) { Hh = av[i] * Hh + bv[i]; Aa *= av[i]; } }
                    SA[chunk * 64 + sch] = Aa; SB[chunk * 64 + sch] = Hh;
                    __syncthreads();
                    float c = carry[sch];
                    if (dir == 0) { for (int j = 0; j < chunk; ++j) c = SA[j * 64 + sch] * c + SB[j * 64 + sch]; }
                    else { for (int j = 7; j > chunk; --j) c = SA[j * 64 + sch] * c + SB[j * 64 + sch]; }
                    __syncthreads();
                    if (chunk == (dir == 0 ? 7 : 0)) carry[sch] = Aa * c + Hh;
                    float h = c;
                    if (dir == 0) {
                        float hv[16];
#pragma unroll
                        for (int i = 0; i < 16; ++i) { h = av[i] * h + bv[i]; hv[i] = h; }
#pragma unroll
                        for (int q = 0; q < 4; ++q) *(f32x4*)(hsp + 4 * q) = (f32x4){hv[4 * q], hv[4 * q + 1], hv[4 * q + 2], hv[4 * q + 3]};
                    } else {
#pragma unroll
                        for (int i = 15; i >= 0; --i) { h = av[i] * h + bv[i];
                            const float yv = bf2f(gyv[i]) * (hf4[i >> 2][i & 3] + h);
                            if (F8_G3) ((unsigned char*)A3)[(rowc + i) * D + 1024 + schglob] = (unsigned char)pack_fp8x1(clamp8(A8_SCALE * yv));
                            else A3[(rowc + i) * D + 1024 + schglob] = (bf16_t)(cvt_pk_bf16(yv, 0.f) & 0xffffu); }
                    }
                }
            }
            __syncthreads();
        }
    }
}

namespace att {
constexpr int DH = 128, NW = 8, QBLK = 32, KVBLK = 64, LDQ = 2048, LDK = 2048, LDO = 2048, KVL8 = 2304;
constexpr float SCALE = 0.088388347648318440f;
constexpr float THR = F8_PV ? 6.f : 8.f;
#ifndef ATT_SDEPTH
#define ATT_SDEPTH 1
#endif
constexpr int SDEPTH = ATT_SDEPTH;
constexpr int SHM_V = KVBLK * DH * 2, SHM_K = KVBLK * DH * 2;
constexpr int SHM_ATTN = 2 * SHM_V + 2 * SHM_K + NW * 64 * 4 + NW * 32 * 4;
#define KSWZ(row, colB) ((row) * 256 + ((colB) ^ (((row) & 7) << 4)))
#define SBAR() __builtin_amdgcn_sched_barrier(0)
__device__ __forceinline__ int crow(int r, int hi) { return (r & 3) + 8 * (r >> 2) + 4 * hi; }
__device__ __forceinline__ unsigned cvtpk(float lo, float hi) { unsigned r; asm volatile("v_cvt_pk_bf16_f32 %0, %1, %2" : "=v"(r) : "v"(lo), "v"(hi)); return r; }
__device__ __forceinline__ void partialSM(f32x16& p0, f32x16& p1, float& m_reg, float& mn, float& alpha) {
  constexpr float C = SCALE * 1.4426950408889634f;
  float pmax = p0[0]; for (int r = 1; r < 16; ++r) pmax = fmaxf(pmax, p0[r]); for (int r = 0; r < 16; ++r) pmax = fmaxf(pmax, p1[r]);
  { auto rr = __builtin_amdgcn_permlane32_swap(__float_as_uint(pmax), __float_as_uint(pmax), false, false);
    pmax = fmaxf(__uint_as_float(rr[0]), __uint_as_float(rr[1])); }
  if (__builtin_expect(__all(pmax - m_reg <= THR / SCALE), 1)) { mn = m_reg; alpha = 1.f; }
  else { mn = fmaxf(m_reg, pmax); alpha = __builtin_amdgcn_exp2f((m_reg - mn) * C); m_reg = mn; }
  float mnC = -mn * C;
  for (int r = 0; r < 16; ++r) p0[r] = fmaf(p0[r], C, mnC); for (int r = 0; r < 16; ++r) p1[r] = fmaf(p1[r], C, mnC);
  for (int r = 0; r < 16; ++r) p0[r] = __builtin_amdgcn_exp2f(p0[r]);
}
__device__ __forceinline__ void finishSM(f32x16& p0, f32x16& p1, float alpha, float& l_reg, bf16x8& pa0, bf16x8& pa1, bf16x8& pa2, bf16x8& pa3) {
  for (int r = 0; r < 16; ++r) p1[r] = __builtin_amdgcn_exp2f(p1[r]);
  float ps = 0; for (int r = 0; r < 16; ++r) ps += p0[r]; for (int r = 0; r < 16; ++r) ps += p1[r];
  { auto rr = __builtin_amdgcn_permlane32_swap(__float_as_uint(ps), __float_as_uint(ps), false, false);
    ps = __uint_as_float(rr[0]) + __uint_as_float(rr[1]); }
  l_reg = l_reg * alpha + ps;
#define PK4(P, BASE, OUT) do { unsigned a0 = cvtpk(P[BASE + 0], P[BASE + 1]), a1 = cvtpk(P[BASE + 2], P[BASE + 3]);   \
    unsigned b0 = cvtpk(P[BASE + 4], P[BASE + 5]), b1 = cvtpk(P[BASE + 6], P[BASE + 7]);                              \
    auto r0 = __builtin_amdgcn_permlane32_swap(a0, b0, false, false); auto r1 = __builtin_amdgcn_permlane32_swap(a1, b1, false, false); \
    u32x4 w = {r0[0], r1[0], r0[1], r1[1]}; OUT = *reinterpret_cast<bf16x8*>(&w); } while (0)
  PK4(p0, 0, pa0); PK4(p0, 8, pa1); PK4(p1, 0, pa2); PK4(p1, 8, pa3);
#undef PK4
}
__device__ __forceinline__ void qkt(f32x16& p0, f32x16& p1, const bf16_t* Ks, const bf16x8* qr, int r32, int hi) {
  p0 = f32x16{}; p1 = f32x16{};
  for (int d0 = 0; d0 < 8; ++d0) { int cb = (d0 * 16 + hi * 8) * 2;
    bf16x8 b0 = *reinterpret_cast<const bf16x8*>((const char*)Ks + KSWZ(r32, cb));
    bf16x8 b1 = *reinterpret_cast<const bf16x8*>((const char*)Ks + KSWZ(32 + r32, cb));
    p0 = __builtin_amdgcn_mfma_f32_32x32x16_bf16(b0, qr[d0], p0, 0, 0, 0);
    p1 = __builtin_amdgcn_mfma_f32_32x32x16_bf16(b1, qr[d0], p1, 0, 0, 0); }
}
__device__ __forceinline__ int v_st(int k, int c) { const int kk = (k & ~0xC) | ((k & 4) << 1) | ((k & 8) >> 1); return ((kk >> 3) * 4 + (c >> 5)) * 512 + ((kk & 7) * 32 + (c & 31)) * 2; }
__device__ __forceinline__ int v_rd_base(int lane) { return ((lane & 3) << 3) | (((lane >> 2) & 3) << 6) | (((lane >> 4) & 1) << 5) | (((lane >> 5) & 1) << 8); }
constexpr int v_rd_off(int d0, int ks, int half) { return d0 * 512 + ks * 4096 + half * 2048; }
template <int OFF> __device__ __forceinline__ s16x4 tr_read(int vb) {
  s16x4 r; asm volatile("ds_read_b64_tr_b16 %0, %1 offset:%2" : "=&v"(r) : "v"(vb), "i"(OFF) : "memory"); return r;
}
template <int D0> __device__ __forceinline__ void pv_one(f32x16& od, int vb, bf16x8 pa0, bf16x8 pa1, bf16x8 pa2, bf16x8 pa3) {
  const s16x4 l0 = tr_read<v_rd_off(D0, 0, 0)>(vb), h0 = tr_read<v_rd_off(D0, 0, 1)>(vb), l1 = tr_read<v_rd_off(D0, 1, 0)>(vb), h1 = tr_read<v_rd_off(D0, 1, 1)>(vb);
  const s16x4 l2 = tr_read<v_rd_off(D0, 2, 0)>(vb), h2 = tr_read<v_rd_off(D0, 2, 1)>(vb), l3 = tr_read<v_rd_off(D0, 3, 0)>(vb), h3 = tr_read<v_rd_off(D0, 3, 1)>(vb);
  asm volatile("s_waitcnt lgkmcnt(0)" ::: "memory"); SBAR();
#define PK(L, H) (bf16x8){L[0], L[1], L[2], L[3], H[0], H[1], H[2], H[3]}
  od = __builtin_amdgcn_mfma_f32_32x32x16_bf16(pa0, PK(l0, h0), od, 0, 0, 0);
  od = __builtin_amdgcn_mfma_f32_32x32x16_bf16(pa1, PK(l1, h1), od, 0, 0, 0);
  od = __builtin_amdgcn_mfma_f32_32x32x16_bf16(pa2, PK(l2, h2), od, 0, 0, 0);
  od = __builtin_amdgcn_mfma_f32_32x32x16_bf16(pa3, PK(l3, h3), od, 0, 0, 0);
#undef PK
}
__device__ __forceinline__ void pv_d0(f32x16* o, int vb, bf16x8 pa0, bf16x8 pa1, bf16x8 pa2, bf16x8 pa3) {
  pv_one<0>(o[0], vb, pa0, pa1, pa2, pa3); pv_one<1>(o[1], vb, pa0, pa1, pa2, pa3); pv_one<2>(o[2], vb, pa0, pa1, pa2, pa3); pv_one<3>(o[3], vb, pa0, pa1, pa2, pa3);
}
__device__ __forceinline__ void attn_pass(const bf16_t* __restrict__ Qb, const bf16_t* __restrict__ Kh, const bf16_t* __restrict__ Vh, bf16_t* __restrict__ Ob,
                                          float* __restrict__ scr, const int wave_in, const int pass, const float lam, const float onem, const float* __restrict__ subg, int seq, char* lds) {
  const int tid = tid_rebuild(wave_in), wid = wave_in;
  const int lane = tid & 63, r32 = lane & 31, hi = lane >> 5;
  bf16_t* V_lds = (bf16_t*)lds; bf16_t* K_lds = (bf16_t*)(lds + 2 * SHM_V);
  float* wsl = (float*)(lds + 2 * SHM_V + 2 * SHM_K) + wid * 64; float* li_l = wsl; float* al_l = wsl + 32;
  float* rq = (float*)(lds + 2 * SHM_V + 2 * SHM_K + NW * 64 * 4) + wid * 32;
  float m_reg = -1e30f, l_reg = 0; f32x16 o[4] = {}; bf16x8 qr[8];
  const bf16_t* Qw = Qb + (long)(wid * QBLK + r32) * LDQ + hi * 8;
#pragma unroll
  for (int d0 = 0; d0 < 8; ++d0) qr[d0] = *reinterpret_cast<const bf16x8*>(Qw + d0 * 16);
  const int sr = tid >> 4, sc = (tid & 15) * 8, vst0 = v_st(sr, sc), vst1 = v_st(32 + sr, sc);
  const int vb0 = (int)(uintptr_t)V_lds + v_rd_base(lane);
  struct { bf16x8 vs0, vs1, ks0, ks1; } sr_[SDEPTH];
#define SLOAD(i, k0) do { sr_[i].vs0 = *reinterpret_cast<const bf16x8*>(&Vh[(long)((k0) + sr) * LDK + sc]); sr_[i].vs1 = *reinterpret_cast<const bf16x8*>(&Vh[(long)((k0) + 32 + sr) * LDK + sc]); \
    sr_[i].ks0 = *reinterpret_cast<const bf16x8*>(&Kh[(long)((k0) + sr) * LDK + sc]); sr_[i].ks1 = *reinterpret_cast<const bf16x8*>(&Kh[(long)((k0) + 32 + sr) * LDK + sc]); } while (0)
#define SWRITE(b, i) do { *(bf16x8*)((char*)V_lds + (b) * SHM_V + vst0) = sr_[i].vs0;          \
    *(bf16x8*)((char*)V_lds + (b) * SHM_V + vst1) = sr_[i].vs1; int kc = sc * 2;               \
    *(bf16x8*)((char*)K_lds + (b) * SHM_K + KSWZ(sr, kc)) = sr_[i].ks0;                       \
    *(bf16x8*)((char*)K_lds + (b) * SHM_K + KSWZ(32 + sr, kc)) = sr_[i].ks1; } while (0)
#define SWAIT() do { if constexpr (SDEPTH == 2) asm volatile("s_waitcnt vmcnt(4)" ::: "memory"); else asm volatile("s_waitcnt vmcnt(0)" ::: "memory"); } while (0)
#define RESC(a) do { if (__any((a) < 1.f)) { if (hi == 0) al_l[r32] = (a); asm volatile("s_waitcnt lgkmcnt(0)" ::: "memory"); \
    for (int d = 0; d < 4; ++d) for (int r = 0; r < 16; ++r) o[d][r] *= al_l[crow(r, hi)]; } } while (0)
  f32x16 pA0, pA1, pB0, pB1; float mnA, mnB, alA, alB; bf16x8 pa0, pa1, pa2, pa3; const int NT = seq / KVBLK;
  constexpr int SE = 0, SO = SDEPTH - 1;
  SLOAD(SE, 0); asm volatile("s_waitcnt vmcnt(0)" ::: "memory"); SWRITE(0, SE); __syncthreads();
  qkt(pA0, pA1, K_lds, qr, r32, hi); partialSM(pA0, pA1, m_reg, mnA, alA);
  SLOAD(SO, KVBLK); if constexpr (SDEPTH == 2) { if (2 < NT) SLOAD(SE, 2 * KVBLK); }
  SWAIT(); SWRITE(1, SO); __syncthreads();
  for (int j = 1; j + 1 < NT; j += 2) {
    SBAR(); qkt(pB0, pB1, (bf16_t*)((char*)K_lds + SHM_K), qr, r32, hi);
    finishSM(pA0, pA1, alA, l_reg, pa0, pa1, pa2, pa3); SBAR();
    SLOAD(SO, (j + SDEPTH) * KVBLK); SBAR();
    pv_d0(o, vb0, pa0, pa1, pa2, pa3); partialSM(pB0, pB1, m_reg, mnB, alB);
    __syncthreads(); SWAIT(); SWRITE(0, SE);
    RESC(alB); __syncthreads();
    SBAR(); qkt(pA0, pA1, K_lds, qr, r32, hi);
    finishSM(pB0, pB1, alB, l_reg, pa0, pa1, pa2, pa3); SBAR();
    if (SDEPTH == 1 || j + 3 < NT) SLOAD(SE, (j + 1 + SDEPTH) * KVBLK); SBAR();
    pv_d0(o, vb0 + (int)SHM_V, pa0, pa1, pa2, pa3); partialSM(pA0, pA1, m_reg, mnA, alA);
    __syncthreads(); SWAIT(); SWRITE(1, SO);
    RESC(alA); __syncthreads();
  }
  SBAR(); qkt(pB0, pB1, (bf16_t*)((char*)K_lds + SHM_K), qr, r32, hi);
  finishSM(pA0, pA1, alA, l_reg, pa0, pa1, pa2, pa3); SBAR();
  pv_d0(o, vb0, pa0, pa1, pa2, pa3); partialSM(pB0, pB1, m_reg, mnB, alB);
  __syncthreads(); RESC(alB);
  finishSM(pB0, pB1, alB, l_reg, pa0, pa1, pa2, pa3); SBAR();
  pv_d0(o, vb0 + (int)SHM_V, pa0, pa1, pa2, pa3);
  if (hi == 0) li_l[r32] = l_reg; asm volatile("s_waitcnt lgkmcnt(0)" ::: "memory");
  float rli[16];
#pragma unroll
  for (int r = 0; r < 16; ++r) rli[r] = __builtin_amdgcn_rcpf(li_l[crow(r, hi)]);
  typedef __attribute__((address_space(1))) float gf32; typedef __attribute__((address_space(1))) bf16_t gbf16;
  gf32* scr_l = (gf32*)scr; gbf16* Ob_l = (gbf16*)Ob; int lane_e = lane; asm volatile("" : "+s"(scr_l), "+s"(Ob_l), "+v"(lane_e));
  const int r32e = lane_e & 31, hie = lane_e >> 5;
  gf32* S = scr_l + (size_t)wid * 4096 + lane_e + (pass >= 2 ? 32768 : 0);
#define ATT_BASE(ptr, d0) gf32* ptr = S + (d0) * 1024; asm volatile("" : "+v"(ptr))
  if (pass == 0 || pass == 2) {
#pragma unroll
    for (int d0 = 0; d0 < 4; ++d0) { ATT_BASE(dst, d0);
#pragma unroll
      for (int r = 0; r < 16; ++r) dst[r * 64] = o[d0][r] * rli[r]; }
  } else {
    float q[16];
#pragma unroll
    for (int d0 = 0; d0 < 4; ++d0) { ATT_BASE(srcp, d0);
#pragma unroll
      for (int r = 0; r < 16; ++r) { const float c = srcp[r * 64] - lam * o[d0][r] * rli[r]; o[d0][r] = c; q[r] = d0 == 0 ? c * c : q[r] + c * c; }
      asm volatile("" ::: "memory"); }
#pragma unroll
    for (int r = 0; r < 16; ++r) {
#pragma unroll
      for (int off = 1; off <= 16; off <<= 1) q[r] += shfl_xor_l(q[r], off, lane_e); }
    if (pass == 1) {
#pragma unroll
      for (int d0 = 0; d0 < 4; ++d0) { ATT_BASE(dst, d0);
#pragma unroll
        for (int r = 0; r < 16; ++r) dst[r * 64] = o[d0][r]; }
      if (r32e == 0) {
#pragma unroll
        for (int r = 0; r < 16; ++r) rq[hie * 16 + r] = q[r]; }
    } else {
      if (r32e == 0) {
#pragma unroll
        for (int r = 0; r < 16; ++r) rq[hie * 16 + r] = onem * __builtin_amdgcn_rsqf((q[r] + rq[hie * 16 + r]) * (1.0f / 256.0f) + EPS); }
      asm volatile("s_waitcnt lgkmcnt(0)" ::: "memory");
      float g0[4], g1[4];
#pragma unroll
      for (int d0 = 0; d0 < 4; ++d0) { g0[d0] = subg[d0 * 32 + r32e]; g1[d0] = subg[128 + d0 * 32 + r32e]; }
      S = scr_l + (size_t)wid * 4096 + lane_e;
      ATT_BASE(s0a, 0); ATT_BASE(s0b, 1); ATT_BASE(s0c, 2); ATT_BASE(s0d, 3);
#pragma unroll
      for (int r = 0; r < 16; ++r) { const float rs = rq[hie * 16 + r];
        gbf16* orow = Ob_l + (long)(wid * QBLK + crow(r, hie)) * LDO + r32e; asm volatile("" : "+v"(orow) :: "memory");
        const float h0 = s0a[r * 64], h1 = s0b[r * 64], h2 = s0c[r * 64], h3 = s0d[r * 64];
        orow[128 +  0] = (bf16_t)(cvtpk(o[0][r] * rs * g1[0], 0.f) & 0xffffu); orow[128 + 32] = (bf16_t)(cvtpk(o[1][r] * rs * g1[1], 0.f) & 0xffffu);
        orow[128 + 64] = (bf16_t)(cvtpk(o[2][r] * rs * g1[2], 0.f) & 0xffffu); orow[128 + 96] = (bf16_t)(cvtpk(o[3][r] * rs * g1[3], 0.f) & 0xffffu);
        orow[ 0] = (bf16_t)(cvtpk(h0 * rs * g0[0], 0.f) & 0xffffu); orow[32] = (bf16_t)(cvtpk(h1 * rs * g0[1], 0.f) & 0xffffu);
        orow[64] = (bf16_t)(cvtpk(h2 * rs * g0[2], 0.f) & 0xffffu); orow[96] = (bf16_t)(cvtpk(h3 * rs * g0[3], 0.f) & 0xffffu); }
    }
  }
#undef ATT_BASE
#undef SLOAD
#undef SWRITE
#undef SWAIT
#undef RESC
}

constexpr int A2_V = 0, A2_K = 65536, A2_PEX = 98304, A2_MEX = 114688, A2_LEX = 115712, A2_RQ = 117760, A2_LDS = 118784;
#define A2_TR4(D0, l0, h0, l1, h1) const s16x4 l0 = tr_read<v_rd_off(D0, 0, 0)>(vbk), h0 = tr_read<v_rd_off(D0, 0, 1)>(vbk), l1 = tr_read<v_rd_off(D0, 1, 0)>(vbk), h1 = tr_read<v_rd_off(D0, 1, 1)>(vbk)
#define A2_PK(L, H) (bf16x8){L[0], L[1], L[2], L[3], H[0], H[1], H[2], H[3]}
#define A2_MM(od, l0, h0, l1, h1) do { od = __builtin_amdgcn_mfma_f32_32x32x16_bf16(pa, A2_PK(l0, h0), od, 0, 0, 0); od = __builtin_amdgcn_mfma_f32_32x32x16_bf16(pb, A2_PK(l1, h1), od, 0, 0, 0); } while (0)
__device__ __forceinline__ void pv_half(f32x16* o, int vb, int kh, bf16x8 pa, bf16x8 pb) {
  const int vbk = vb + kh * 8192;
  A2_TR4(0, a0, b0, a1, b1); A2_TR4(1, c0, d0, c1, d1);
  asm volatile("s_waitcnt lgkmcnt(4)" ::: "memory"); SBAR(); A2_MM(o[0], a0, b0, a1, b1); SBAR();
  A2_TR4(2, e0, f0, e1, f1);
  asm volatile("s_waitcnt lgkmcnt(4)" ::: "memory"); SBAR(); A2_MM(o[1], c0, d0, c1, d1); SBAR();
  A2_TR4(3, g0, h0, g1, h1);
  asm volatile("s_waitcnt lgkmcnt(4)" ::: "memory"); SBAR(); A2_MM(o[2], e0, f0, e1, f1); SBAR();
  asm volatile("s_waitcnt lgkmcnt(0)" ::: "memory"); SBAR(); A2_MM(o[3], g0, h0, g1, h1);
}
#undef A2_TR4
#undef A2_PK
#undef A2_MM
__device__ __forceinline__ void attn_pass2(const bf16_t* __restrict__ Qb, const bf16_t* __restrict__ Kh, const bf16_t* __restrict__ Vh, bf16_t* __restrict__ Ob,
                                           float* __restrict__ scr, const int wave_in, const int pass, const float lam, const float onem, const float* __restrict__ subg, int seq, char* lds) {
  constexpr float C = SCALE * 1.4426950408889634f;
  const int tid = tid_rebuild(wave_in), wid = wave_in;
  const int lane = tid & 63, r32 = lane & 31, hi = lane >> 5, pair = wid >> 1, rho = wid & 1;
  char* V_lds = lds + A2_V; char* K_lds = lds + A2_K;
  char* pex_own = lds + A2_PEX + wid * 2048; char* pex_par = lds + A2_PEX + (wid ^ 1) * 2048;
  float* mex_own = (float*)(lds + A2_MEX) + wid * 32; float* mex_par = (float*)(lds + A2_MEX) + (wid ^ 1) * 32;
  float* lex = (float*)(lds + A2_LEX) + wid * 64; float* lex_par = (float*)(lds + A2_LEX) + (wid ^ 1) * 64; float* al_l = lex + 32;
  float* rq = (float*)(lds + A2_RQ) + wid * 32; float* rq_par = (float*)(lds + A2_RQ) + (wid ^ 1) * 32;
  float m_reg = -1e30f, l_reg = 0; f32x16 o[4] = {};
#if F8_QK
  pg8::i32x8v q8[2];
  { const unsigned char* Q8w = (const unsigned char*)Qb + (long)(pair * QBLK + r32) * LDQ + hi * 32;
#pragma unroll
    for (int st = 0; st < 2; ++st) q8[st] = pg8::cat8(*reinterpret_cast<const bf16x8*>(Q8w + st * 64), *reinterpret_cast<const bf16x8*>(Q8w + st * 64 + 16)); }
  const int krow8 = tid >> 3, kch8 = tid & 7, krowp8 = F8_PV ? 4 * (krow8 & 15) + (krow8 >> 4) : krow8;
#define K8OFF(row, ch) ((row) * 128 + ((((ch)) ^ (((row) >> 1) & 7)) << 4))
#else
  bf16x8 qr[8];
  const bf16_t* Qw = Qb + (long)(pair * QBLK + r32) * LDQ + hi * 8;
#pragma unroll
  for (int d0 = 0; d0 < 8; ++d0) qr[d0] = *reinterpret_cast<const bf16x8*>(Qw + d0 * 16);
#endif
  const int sr = tid >> 4, sc = (tid & 15) * 8, vst0 = v_st(sr, sc), vst1 = v_st(32 + sr, sc);
  const int vrb = (int)(uintptr_t)V_lds + v_rd_base(lane) + rho * 16384;
  struct Stg { bf16x8 ks0, ks1, v00, v10, v01, v11; } sA, sB;
#if F8_QK
#define SLOADK(T, k0) T.ks0 = *reinterpret_cast<const bf16x8*>((const unsigned char*)Kh + (long)((k0) + krow8) * LDK + kch8 * 16)
#if F8_PV
#define SLN "3"
#else
#define SLN "5"
#endif
#else
#define SLOADK(T, k0) T.ks0 = *reinterpret_cast<const bf16x8*>(&Kh[(long)((k0) + sr) * LDK + sc]); T.ks1 = *reinterpret_cast<const bf16x8*>(&Kh[(long)((k0) + 32 + sr) * LDK + sc])
#define SLN "6"
#endif
#if F8_PV
  const int vrow0 = tid >> 2, vch = tid & 3;
#define V8OFF(row, ch) ((row) * 64 + ((((ch)) ^ (((row) >> 2) & 3)) << 4))
#define SLOAD2(T, k0) do { SLOADK(T, k0); \
    T.v00 = *reinterpret_cast<const bf16x8*>((const unsigned char*)Vh + (long)vrow0 * KVL8 + (k0) + vch * 16); T.v10 = *reinterpret_cast<const bf16x8*>((const unsigned char*)Vh + (long)(128 + vrow0) * KVL8 + (k0) + vch * 16); } while (0)
#else
#define SLOAD2(T, k0) do { SLOADK(T, k0); \
    T.v00 = *reinterpret_cast<const bf16x8*>(&Vh[(long)((k0) + sr) * LDK + sc]); T.v10 = *reinterpret_cast<const bf16x8*>(&Vh[(long)((k0) + 32 + sr) * LDK + sc]); \
    T.v01 = *reinterpret_cast<const bf16x8*>(&Vh[(long)((k0) + sr) * LDK + 128 + sc]); T.v11 = *reinterpret_cast<const bf16x8*>(&Vh[(long)((k0) + 32 + sr) * LDK + 128 + sc]); } while (0)
#endif
#if F8_QK
#define SWRITE_K(T, b) do { *(bf16x8*)(K_lds + (b) * 16384 + K8OFF(krowp8, kch8)) = T.ks0; } while (0)
#else
#define SWRITE_K(T, b) do { const int kc_ = sc * 2; *(bf16x8*)(K_lds + (b) * 16384 + KSWZ(sr, kc_)) = T.ks0; *(bf16x8*)(K_lds + (b) * 16384 + KSWZ(32 + sr, kc_)) = T.ks1; } while (0)
#endif
#if F8_PV
#define SWRITE_V(T, b) do { *(bf16x8*)(V_lds + (b) * 16384 + V8OFF(vrow0, vch)) = T.v00; *(bf16x8*)(V_lds + (b) * 16384 + V8OFF(128 + vrow0, vch)) = T.v10; } while (0)
#define PUB8(P, alpha, pown) do { \
    float ps_ = 0.f; _Pragma("unroll") for (int r = 0; r < 16; ++r) ps_ += P[r]; \
    { auto rr_ = __builtin_amdgcn_permlane32_swap(__float_as_uint(ps_), __float_as_uint(ps_), false, false); ps_ = __uint_as_float(rr_[0]) + __uint_as_float(rr_[1]); } \
    l_reg = l_reg * (alpha) + ps_; \
    { const unsigned d0_ = pack_fp8x4(P[0], P[1], P[2], P[3]), d1_ = pack_fp8x4(P[4], P[5], P[6], P[7]), d2_ = pack_fp8x4(P[8], P[9], P[10], P[11]), d3_ = pack_fp8x4(P[12], P[13], P[14], P[15]); \
      auto r0 = __builtin_amdgcn_permlane32_swap(d0_, d0_, false, false); auto r1 = __builtin_amdgcn_permlane32_swap(d1_, d1_, false, false); \
      auto r2 = __builtin_amdgcn_permlane32_swap(d2_, d2_, false, false); auto r3 = __builtin_amdgcn_permlane32_swap(d3_, d3_, false, false); \
      pown = (pg8::i32x8v){(int)r0[0], (int)r0[1], (int)r1[0], (int)r1[1], (int)r2[0], (int)r2[1], (int)r3[0], (int)r3[1]}; \
      if (hi == 0) { *(u32x4*)(pex_own + r32 * 16) = (u32x4){r0[0], r0[1], r1[0], r1[1]}; *(u32x4*)(pex_own + 512 + r32 * 16) = (u32x4){r2[0], r2[1], r3[0], r3[1]}; } } } while (0)
#define PV8(b, pown) do { const u32x4 qa_ = *(const u32x4*)(pex_par + r32 * 16), qb_ = *(const u32x4*)(pex_par + 512 + r32 * 16); \
    const pg8::i32x8v ppar_ = {(int)qa_[0], (int)qa_[1], (int)qa_[2], (int)qa_[3], (int)qb_[0], (int)qb_[1], (int)qb_[2], (int)qb_[3]}; \
    pg8::i32x8v pA_; _Pragma("unroll") for (int e = 0; e < 8; ++e) pA_[e] = (hi == rho) ? pown[e] : ppar_[e]; \
    _Pragma("unroll") for (int d0 = 0; d0 < 4; ++d0) { const int vr_ = 128 * rho + 32 * d0 + r32; \
      const pg8::i32x8v vf_ = pg8::cat8(*reinterpret_cast<const bf16x8*>(V_lds + (b) * 16384 + V8OFF(vr_, 2 * hi)), *reinterpret_cast<const bf16x8*>(V_lds + (b) * 16384 + V8OFF(vr_, 2 * hi + 1))); \
      o[d0] = __builtin_amdgcn_mfma_scale_f32_32x32x64_f8f6f4(pA_, vf_, o[d0], 0, 0, 0, 0x7f7f7f7f, 0, 0x7f7f7f7f); } } while (0)
#else
#define SWRITE_V(T, b) do { *(bf16x8*)(V_lds + (b) * 32768 + vst0) = T.v00; *(bf16x8*)(V_lds + (b) * 32768 + vst1) = T.v10; \
    *(bf16x8*)(V_lds + (b) * 32768 + 16384 + vst0) = T.v01; *(bf16x8*)(V_lds + (b) * 32768 + 16384 + vst1) = T.v11; } while (0)
#endif
#if F8_QK
#define KFRAG8(b, st) pg8::cat8(*reinterpret_cast<const bf16x8*>(K_lds + (b) * 16384 + K8OFF(32 * rho + r32, 4 * (st) + 2 * hi)), *reinterpret_cast<const bf16x8*>(K_lds + (b) * 16384 + K8OFF(32 * rho + r32, 4 * (st) + 2 * hi + 1)))
#define MFMA8(kf, st, Pin) __builtin_amdgcn_mfma_scale_f32_32x32x64_f8f6f4(kf, q8[st], Pin, 0, 0, 0, 0x7f7f7f7f, 0, 0x7f7f7f7f)
#define QKT2(P, b) do { const pg8::i32x8v k0_ = KFRAG8(b, 0), k1_ = KFRAG8(b, 1); P = MFMA8(k0_, 0, f32x16{}); P = MFMA8(k1_, 1, P); } while (0)
#define QKT2X(P, b, PP, mref) do { const float mnC_ = -(mref) * C; const pg8::i32x8v k0_ = KFRAG8(b, 0), k1_ = KFRAG8(b, 1); \
    SBAR(); _Pragma("unroll") for (int r = 0; r < 8; ++r) PP[r] = __builtin_amdgcn_exp2f(fmaf(PP[r], C, mnC_)); SBAR(); \
    P = MFMA8(k0_, 0, f32x16{}); SBAR(); \
    _Pragma("unroll") for (int r = 8; r < 16; ++r) PP[r] = __builtin_amdgcn_exp2f(fmaf(PP[r], C, mnC_)); SBAR(); \
    P = MFMA8(k1_, 1, P); SBAR(); } while (0)
#else
#define QKT2(P, b) do { P = f32x16{}; _Pragma("unroll") for (int d0 = 0; d0 < 8; ++d0) { const int cb_ = (d0 * 16 + hi * 8) * 2; \
    const bf16x8 kf_ = *reinterpret_cast<const bf16x8*>(K_lds + (b) * 16384 + KSWZ(32 * rho + r32, cb_)); P = __builtin_amdgcn_mfma_f32_32x32x16_bf16(kf_, qr[d0], P, 0, 0, 0); } } while (0)
#define KFRAG2(b, d0) (*reinterpret_cast<const bf16x8*>(K_lds + (b) * 16384 + KSWZ(32 * rho + r32, ((d0) * 16 + hi * 8) * 2)))
#define QKT2X(P, b, PP, mref) do { const float mnC_ = -(mref) * C; bf16x8 kfa_ = KFRAG2(b, 0), kfb_ = KFRAG2(b, 1); P = f32x16{}; \
    _Pragma("unroll") for (int d0 = 0; d0 < 8; d0 += 2) { \
      SBAR(); PP[2 * d0] = __builtin_amdgcn_exp2f(fmaf(PP[2 * d0], C, mnC_)); PP[2 * d0 + 1] = __builtin_amdgcn_exp2f(fmaf(PP[2 * d0 + 1], C, mnC_)); SBAR(); \
      P = __builtin_amdgcn_mfma_f32_32x32x16_bf16(kfa_, qr[d0], P, 0, 0, 0); SBAR(); if (d0 + 2 < 8) kfa_ = KFRAG2(b, d0 + 2); \
      SBAR(); PP[2 * d0 + 2] = __builtin_amdgcn_exp2f(fmaf(PP[2 * d0 + 2], C, mnC_)); PP[2 * d0 + 3] = __builtin_amdgcn_exp2f(fmaf(PP[2 * d0 + 3], C, mnC_)); SBAR(); \
      P = __builtin_amdgcn_mfma_f32_32x32x16_bf16(kfb_, qr[d0 + 1], P, 0, 0, 0); SBAR(); if (d0 + 3 < 8) kfb_ = KFRAG2(b, d0 + 3); } } while (0)
#endif
#define ROWMAX2(P, out) do { float pm_ = P[0]; _Pragma("unroll") for (int r = 1; r < 16; ++r) pm_ = fmaxf(pm_, P[r]); \
    auto rr_ = __builtin_amdgcn_permlane32_swap(__float_as_uint(pm_), __float_as_uint(pm_), false, false); out = fmaxf(__uint_as_float(rr_[0]), __uint_as_float(rr_[1])); } while (0)
#define DECIDE2(pm_own, alpha_out) do { const float pj_ = fmaxf(pm_own, mex_par[r32]); \
    if (__builtin_expect(__all(pj_ - m_reg <= THR / SCALE), 1)) { alpha_out = 1.f; } else { const float mn_ = fmaxf(m_reg, pj_); alpha_out = __builtin_amdgcn_exp2f((m_reg - mn_) * C); m_reg = mn_; } } while (0)
#define EXP2PUB(P, mref, alpha, pa_a, pa_b) do { const float mnC_ = -(mref) * C; _Pragma("unroll") for (int r = 0; r < 16; ++r) P[r] = __builtin_amdgcn_exp2f(fmaf(P[r], C, mnC_)); \
    float ps_ = 0.f; _Pragma("unroll") for (int r = 0; r < 16; ++r) ps_ += P[r]; \
    { auto rr_ = __builtin_amdgcn_permlane32_swap(__float_as_uint(ps_), __float_as_uint(ps_), false, false); ps_ = __uint_as_float(rr_[0]) + __uint_as_float(rr_[1]); } \
    l_reg = l_reg * (alpha) + ps_; \
    { unsigned a0 = cvtpk(P[0], P[1]), a1 = cvtpk(P[2], P[3]), b0 = cvtpk(P[4], P[5]), b1 = cvtpk(P[6], P[7]); \
      auto r0 = __builtin_amdgcn_permlane32_swap(a0, b0, false, false); auto r1 = __builtin_amdgcn_permlane32_swap(a1, b1, false, false); u32x4 w_ = {r0[0], r1[0], r0[1], r1[1]}; pa_a = *reinterpret_cast<bf16x8*>(&w_); } \
    { unsigned a0 = cvtpk(P[8], P[9]), a1 = cvtpk(P[10], P[11]), b0 = cvtpk(P[12], P[13]), b1 = cvtpk(P[14], P[15]); \
      auto r0 = __builtin_amdgcn_permlane32_swap(a0, b0, false, false); auto r1 = __builtin_amdgcn_permlane32_swap(a1, b1, false, false); u32x4 w_ = {r0[0], r1[0], r0[1], r1[1]}; pa_b = *reinterpret_cast<bf16x8*>(&w_); } \
    *(bf16x8*)(pex_own + lane * 16) = pa_a; *(bf16x8*)(pex_own + 1024 + lane * 16) = pa_b; } while (0)
#define PUB2(P, alpha, pa_a, pa_b) do { \
    float ps_ = 0.f; _Pragma("unroll") for (int r = 0; r < 16; ++r) ps_ += P[r]; \
    { auto rr_ = __builtin_amdgcn_permlane32_swap(__float_as_uint(ps_), __float_as_uint(ps_), false, false); ps_ = __uint_as_float(rr_[0]) + __uint_as_float(rr_[1]); } \
    l_reg = l_reg * (alpha) + ps_; \
    { unsigned a0 = cvtpk(P[0], P[1]), a1 = cvtpk(P[2], P[3]), b0 = cvtpk(P[4], P[5]), b1 = cvtpk(P[6], P[7]); \
      auto r0 = __builtin_amdgcn_permlane32_swap(a0, b0, false, false); auto r1 = __builtin_amdgcn_permlane32_swap(a1, b1, false, false); u32x4 w_ = {r0[0], r1[0], r0[1], r1[1]}; pa_a = *reinterpret_cast<bf16x8*>(&w_); } \
    { unsigned a0 = cvtpk(P[8], P[9]), a1 = cvtpk(P[10], P[11]), b0 = cvtpk(P[12], P[13]), b1 = cvtpk(P[14], P[15]); \
      auto r0 = __builtin_amdgcn_permlane32_swap(a0, b0, false, false); auto r1 = __builtin_amdgcn_permlane32_swap(a1, b1, false, false); u32x4 w_ = {r0[0], r1[0], r0[1], r1[1]}; pa_b = *reinterpret_cast<bf16x8*>(&w_); } \
    *(bf16x8*)(pex_own + lane * 16) = pa_a; *(bf16x8*)(pex_own + 1024 + lane * 16) = pa_b; } while (0)
#define RESC2(a) do { if (__any((a) < 1.f)) { if (hi == 0) al_l[r32] = (a); asm volatile("s_waitcnt lgkmcnt(0)" ::: "memory"); \
    for (int d = 0; d < 4; ++d) for (int r = 0; r < 16; ++r) o[d][r] *= al_l[crow(r, hi)]; } } while (0)
  const int NT = seq / KVBLK;
  f32x16 pc, pp; float pm_c, al_p = 1.f, al_c; bf16x8 pa_a, pa_b; pg8::i32x8v pown;
  SLOAD2(sA, 0); asm volatile("s_waitcnt vmcnt(0)" ::: "memory"); SWRITE_K(sA, 0); SWRITE_V(sA, 0);
  SLOAD2(sB, KVBLK); if (2 < NT) SLOAD2(sA, 2 * KVBLK);
  __syncthreads();
  QKT2(pp, 0); ROWMAX2(pp, pm_c); if (hi == 0) mex_own[r32] = pm_c;
  if (2 < NT) asm volatile("s_waitcnt vmcnt(" SLN ")" ::: "memory"); else asm volatile("s_waitcnt vmcnt(0)" ::: "memory");
  SWRITE_K(sB, 1); SWRITE_V(sB, 1); __syncthreads();
  DECIDE2(pm_c, al_p);
  float mref_p = m_reg;
  __syncthreads();
#if F8_PV
#define ATT2_MID(j, L) PUB8(pp, al_p, pown); SBAR(); \
    if ((j) + 2 < NT) SLOAD2(L, ((j) + 2) * KVBLK); SBAR(); \
    ROWMAX2(pc, pm_c); if (hi == 0) mex_own[r32] = pm_c; \
    __syncthreads(); \
    PV8(bp, pown);
#else
#define ATT2_MID(j, L) PUB2(pp, al_p, pa_a, pa_b); SBAR(); \
    if ((j) + 2 < NT) SLOAD2(L, ((j) + 2) * KVBLK); SBAR(); \
    pv_half(o, vrb + bp * 32768, rho, pa_a, pa_b); \
    ROWMAX2(pc, pm_c); if (hi == 0) mex_own[r32] = pm_c; \
    __syncthreads(); \
    { const bf16x8 qa = *(const bf16x8*)(pex_par + lane * 16), qb = *(const bf16x8*)(pex_par + 1024 + lane * 16); \
      pv_half(o, vrb + bp * 32768, rho ^ 1, qa, qb); }
#endif
#define ATT2_ITER(j, W, L) do { const int bj = (j) & 1, bp = bj ^ 1; \
    SBAR(); QKT2X(pc, bj, pp, mref_p); \
    ATT2_MID(j, L) \
    DECIDE2(pm_c, al_c); \
    if ((j) + 1 < NT) { if ((j) + 2 < NT) asm volatile("s_waitcnt vmcnt(" SLN ")" ::: "memory"); else asm volatile("s_waitcnt vmcnt(0)" ::: "memory"); SWRITE_K(W, bp); } \
    RESC2(al_c); \
    __syncthreads(); \
    if ((j) + 1 < NT) SWRITE_V(W, bp); \
    pp = pc; mref_p = m_reg; al_p = al_c; } while (0)
#pragma unroll 1
  for (int j = 1; j + 1 < NT; j += 2) { ATT2_ITER(j, sA, sB); ATT2_ITER(j + 1, sB, sA); }
  ATT2_ITER(NT - 1, sA, sB);
#undef ATT2_ITER
#undef ATT2_MID
  { const int bp = (NT - 1) & 1;
#if F8_PV
    { const float mnC_ = -mref_p * C;
#pragma unroll
      for (int r = 0; r < 16; ++r) pp[r] = __builtin_amdgcn_exp2f(fmaf(pp[r], C, mnC_)); }
    PUB8(pp, al_p, pown); SBAR();
    __syncthreads();
    PV8(bp, pown);
#else
    EXP2PUB(pp, mref_p, al_p, pa_a, pa_b); SBAR();
    pv_half(o, vrb + bp * 32768, rho, pa_a, pa_b);
    __syncthreads();
    { const bf16x8 qa = *(const bf16x8*)(pex_par + lane * 16), qb = *(const bf16x8*)(pex_par + 1024 + lane * 16);
      pv_half(o, vrb + bp * 32768, rho ^ 1, qa, qb); }
#endif
  }
  typedef __attribute__((address_space(1))) float gf32; typedef __attribute__((address_space(1))) bf16_t gbf16;
  gf32* scr_l = (gf32*)scr; gbf16* Ob_l = (gbf16*)Ob; int lane_e = lane; asm volatile("" : "+s"(scr_l), "+s"(Ob_l), "+v"(lane_e));
  const int r32e = lane_e & 31, hie = lane_e >> 5;
  if (hie == 0) lex[r32e] = l_reg;
  __syncthreads();
  float rli[16];
#pragma unroll
  for (int r = 0; r < 16; ++r) rli[r] = __builtin_amdgcn_rcpf(lex[crow(r, hie)] + lex_par[crow(r, hie)]);
  gf32* S = scr_l + (size_t)wid * 4096 + lane_e;
#define ATT_BASE(ptr, d0) gf32* ptr = S + (d0) * 1024; asm volatile("" : "+v"(ptr))
  if (pass == 0) {
#pragma unroll
    for (int d0 = 0; d0 < 4; ++d0) { ATT_BASE(dst, d0);
#pragma unroll
      for (int r = 0; r < 16; ++r) dst[r * 64] = o[d0][r] * rli[r]; }
  } else {
    float q[16];
    const float lam_e = *(const float*)(lds + LX_MISC + 256);
#pragma unroll
    for (int d0 = 0; d0 < 4; ++d0) { ATT_BASE(srcp, d0);
#pragma unroll
      for (int r = 0; r < 16; ++r) { const float c = srcp[r * 64] - lam_e * o[d0][r] * rli[r]; o[d0][r] = c; q[r] = d0 == 0 ? c * c : q[r] + c * c; }
      asm volatile("" ::: "memory"); }
#pragma unroll
    for (int r = 0; r < 16; ++r) {
#pragma unroll
      for (int off = 1; off <= 16; off <<= 1) q[r] += shfl_xor_l(q[r], off, lane_e); }
    if (r32e == 0) {
#pragma unroll
      for (int r = 0; r < 16; ++r) rq[hie * 16 + r] = q[r]; }
    __syncthreads();
    float g1[4];
#pragma unroll
    for (int d0 = 0; d0 < 4; ++d0) g1[d0] = subg[rho * 128 + d0 * 32 + r32e];
#pragma unroll
    for (int r = 0; r < 16; ++r) { const float rs = onem * __builtin_amdgcn_rsqf((rq[hie * 16 + r] + rq_par[hie * 16 + r]) * (1.0f / 256.0f) + EPS);
#if F8_WO
      typedef __attribute__((address_space(1))) unsigned char gu8;
      gu8* orow = (gu8*)Ob_l + (long)(pair * QBLK + crow(r, hie)) * LDO + rho * 128 + 4 * r32e; asm volatile("" : "+v"(orow) :: "memory");
      const float rs8 = rs * A8_SCALE;
      *(__attribute__((address_space(1))) unsigned*)orow = pack_fp8x4(clamp8(o[0][r] * rs8 * g1[0]), clamp8(o[1][r] * rs8 * g1[1]), clamp8(o[2][r] * rs8 * g1[2]), clamp8(o[3][r] * rs8 * g1[3])); }
#else
      gbf16* orow = Ob_l + (long)(pair * QBLK + crow(r, hie)) * LDO + rho * 128 + r32e; asm volatile("" : "+v"(orow) :: "memory");
      orow[ 0] = (bf16_t)(cvtpk(o[0][r] * rs * g1[0], 0.f) & 0xffffu); orow[32] = (bf16_t)(cvtpk(o[1][r] * rs * g1[1], 0.f) & 0xffffu);
      orow[64] = (bf16_t)(cvtpk(o[2][r] * rs * g1[2], 0.f) & 0xffffu); orow[96] = (bf16_t)(cvtpk(o[3][r] * rs * g1[3], 0.f) & 0xffffu); }
#endif
  }
#undef ATT_BASE
#undef SLOAD2
#undef SWRITE_K
#undef SWRITE_V
#undef QKT2
#undef ROWMAX2
#undef DECIDE2
#undef EXP2PUB
#undef PUB2
#undef QKT2X
#undef KFRAG2
#undef RESC2
}
}

__device__ __forceinline__ void attn_phase(const Frame& F, const Params& p) {
    unsigned char* ws = F.ws;
    const bf16_t* Q = (const bf16_t*)(ws + WS_HID); const bf16_t* Kb = (const bf16_t*)(ws + WS_R1); const bf16_t* Vb = Kb + (size_t)NB * KVL * D;
    bf16_t* O = (bf16_t*)(ws + WS_HB);
    float* scr = (float*)(ws + WS_ATTSCR) + (size_t)F.bx * 65536;
    const float* q1 = inptr(p, 20); const float* k1 = inptr(p, 21); const float* q2 = inptr(p, 22); const float* k2 = inptr(p, 23); const float* subg = inptr(p, 24);
    float d1 = q1[F.lane] * k1[F.lane] + q1[64 + F.lane] * k1[64 + F.lane];
    float d2 = q2[F.lane] * k2[F.lane] + q2[64 + F.lane] * k2[64 + F.lane];
#pragma unroll
    for (int o = 32; o >= 1; o >>= 1) { d1 += shfl_xor_l(d1, o, F.lane); d2 += shfl_xor_l(d2, o, F.lane); }
    const float lam_init = 0.8f - 0.6f * 0.7408182206817179f;
    const float lam = expf(d1) - expf(d2) + lam_init, onem = 1.0f - lam_init;
    if (F.tid == 0) *(LAS float*)(F.lds + LX_MISC + 256) = lam;
    const int vcu = (F.G % 8 == 0) ? (F.bx % 8) * (F.G / 8) + F.bx / 8 : F.bx;
#if MK_ATT2
#pragma unroll 1
    for (int U = vcu; U < NB * 8 * 16; U += F.G) {
        const int bh = U >> 4, b = bh >> 3, h = bh & 7, qb = U & 15;
#if F8_QK
        const bf16_t* Qb = (const bf16_t*)((const unsigned char*)Q + ((size_t)b * SEQ + qb * 128) * D + h * 256);
        const bf16_t* Kh = (const bf16_t*)((const unsigned char*)Kb + (size_t)b * KVL * D + h * 256);
#else
        const bf16_t* Qb = Q + ((size_t)b * SEQ + qb * 128) * D + h * 256;
        const bf16_t* Kh = Kb + (size_t)b * KVL * D + h * 256;
#endif
#if F8_PV
        const bf16_t* Vh = (const bf16_t*)((const unsigned char*)Vb + ((size_t)(b * 8 + h) * 256) * KVL);
#else
        const bf16_t* Vh = Vb + (size_t)b * KVL * D + h * 256;
#endif
        bf16_t* Ob = F8_WO ? (bf16_t*)((unsigned char*)O + ((size_t)b * SEQ + qb * 128) * D + h * 256) : O + ((size_t)b * SEQ + qb * 128) * D + h * 256;
#pragma unroll 1
        for (int pass = 0; pass < 2; ++pass) {
            __syncthreads();
#if F8_QK
            att::attn_pass2((const bf16_t*)((const unsigned char*)Qb + pass * 128), (const bf16_t*)((const unsigned char*)Kh + pass * 128), Vh, Ob, scr, F.wave, pass, lam, onem, subg, KVL, (char*)F.lds);
#else
            att::attn_pass2(Qb + pass * 128, Kh + pass * 128, Vh, Ob, scr, F.wave, pass, lam, onem, subg, KVL, (char*)F.lds);
#endif
        }
    }
#else
#pragma unroll 1
    for (int U = vcu; U < NB * 8 * 8; U += F.G) {
        const int bh = U >> 3, b = bh >> 3, h = bh & 7, qb = U & 7;
        const bf16_t* Qb = Q + ((size_t)b * SEQ + qb * 256) * D + h * 256;
        const bf16_t* Kh = Kb + (size_t)b * KVL * D + h * 256;
        const bf16_t* Vh = Vb + (size_t)b * KVL * D + h * 256;
        bf16_t* Ob = O + ((size_t)b * SEQ + qb * 256) * D + h * 256;
#pragma unroll 1
        for (int pass = 0; pass < 4; ++pass) {
            const int m = pass & 1, vh = pass >> 1;
            __syncthreads();
            att::attn_pass(Qb + m * 128, Kh + m * 128, Vh + vh * 128, Ob, scr, F.wave, pass, lam, onem, subg, KVL, (char*)F.lds);
        }
    }
#endif
    __syncthreads();
}

__device__ __forceinline__ void moe_setup(const Frame& F, int l) {
    LAS int* pre = (LAS int*)(F.lds + LX_PRE); LAS int* cnt = (LAS int*)(F.lds + LX_CNT);
    __syncthreads();
    if (F.tid == 0) {
        const unsigned* cntg = (const unsigned*)(F.ws + WS_CTL) + CW_CNT + l * 64; int acc = 0;
        for (int e = 0; e < 16; ++e) { const int c = (int)__hip_atomic_load(cntg + e, __ATOMIC_RELAXED, __HIP_MEMORY_SCOPE_AGENT); cnt[e] = c; pre[e] = acc; acc += (c + 255) >> 8; }
        pre[16] = acc;
    }
    __syncthreads();
}

__global__ void __launch_bounds__(512, 2) mega_fwd(Params p) {
    extern __shared__ __attribute__((aligned(16))) unsigned char lds_raw[];
    Frame F;
    F.lds = (LAS unsigned char*)lds_raw;
    F.wave = __builtin_amdgcn_readfirstlane(threadIdx.x >> 6); refresh(F);
    F.G = gridDim.x; F.bx = blockIdx.x; F.ws = p.ws; F.out = p.out;
    if (F.tid < 4) ((LAS unsigned*)(F.lds + LX_BAR))[F.tid] = 0u;
    __syncthreads();
    XcdBarrier bar = xcd_barrier_post((unsigned*)(p.ws + WS_CTL) + CW_BAR, (volatile LAS unsigned*)(F.lds + LX_BAR));
    const int lo = p.ph_lo, hi = p.ph_hi, stop = p.stop;
#define PHR(v) ({ int _v = (v); asm volatile("" : "+s"(_v)); _v; })
    unsigned char* ws = p.ws;
    const float* mod = (const float*)(ws + WS_MOD);
    int ph = 0;
#ifndef MK_MASK
#define MK_MASK 0x1ffff
#endif
#define RUN(k) (((MK_MASK >> (k)) & 1) && PHR(lo) <= (k) && (k) < PHR(hi) && ((k) < PHR(stop) || (k) == NPHASE - 1))
#define REP(k) for (int rep_ = 0; rep_ <= ((MK_REPEAT >> (k)) & 1); ++rep_)
#define SEAM(k) do { if ((k) + 1 < PHR(hi)) xcd_barrier(bar); } while (0)

    if (RUN(0)) { refresh(F); REP(0) p0_prologue(F, p); } if (PHR(lo) <= 0 && 0 < PHR(hi)) SEAM(0);
    if (false) { refresh(F); p1_modreduce(F, p);
#ifdef MK_XBAR
        for (int xb_ = 0; xb_ < MK_XBAR; ++xb_) xcd_barrier(bar);
#endif
    }
    if (RUN(2)) { refresh(F); REP(2) row_phase<0>(F, p, 0, 0); } if (PHR(lo) <= 2 && 2 < PHR(hi)) SEAM(2);
    ph = 3;
    if (RUN(3)) { refresh(F);
        pg8::DenseSched<F8_G1 != 0, I8_G1 != 0> S{(const char*)(ws + WS_HB), (const char*)(ws + WS_W1), NTOK / 256, 5120 / 256, 2048, F.G, F.bx, 0x79797979, 0x7f7f7f7f};
        bf16_t* g1o = (bf16_t*)(ws + WS_R1);
        pg8::EpiIn0 E{g1o, g1o + (size_t)NTOK * 1024, g1o + (size_t)2 * NTOK * 1024, g1o + (size_t)3 * NTOK * 1024, (const float*)(ws + WS_ASC)};
        REP(3) pg8::gemm_run(F.lds, F.wave, 2048, S, E);
#if MK_TAILFILL
        refresh(F); tail_fill(F, p, 0, 0, false);
#endif
    } if (PHR(lo) <= 3 && 3 < PHR(hi)) SEAM(3);
    if (RUN(4)) { refresh(F); REP(4) scan_phase(F, p); } if (PHR(lo) <= 4 && 4 < PHR(hi)) SEAM(4);
    if (RUN(5)) { refresh(F);
        pg8::DenseSched<F8_G3 != 0> S{(const char*)(ws + WS_HB), (const char*)(ws + WS_W3), NTOK / 256, 2048 / 256, 2048, F.G, F.bx, 0x79797979, 0x7c7c7c7c};
        pg8::EpiRes<true> E{inptr(p, 0), inptr(p, 2), (bf16_t*)(ws + WS_XR), mod + 4096};
        REP(5) pg8::gemm_run(F.lds, F.wave, 2048, S, E);
#if MK_TAILFILL
        refresh(F); tail_fill(F, p, 0, 1, false);
#endif
    } if (PHR(lo) <= 5 && 5 < PHR(hi)) SEAM(5);
    for (int l = 0; l < 2; ++l) {
        const int base = l == 0 ? 6 : 13;
        if (l == 1) {
            if (RUN(10)) { refresh(F);
                pg8::EpiQKV E{(bf16_t*)(ws + WS_HID), (bf16_t*)(ws + WS_R1), (bf16_t*)(ws + WS_R1) + (size_t)NB * KVL * D, (const float*)(ws + WS_ROPE), (const float*)(ws + WS_ROPE) + 2048};
                pg8::QkvSched<F8_QKV != 0> S{(const char*)(ws + WS_HB), (const char*)(ws + WS_WQKV), 2048, F.G, F.bx, 0x79797979, 0x7f7f7f7f};
                REP(10) pg8::gemm_run(F.lds, F.wave, 2048, S, E);
            } if (PHR(lo) <= 10 && 10 < PHR(hi)) SEAM(10);
            if (RUN(11)) { refresh(F); REP(11) attn_phase(F, p); } if (PHR(lo) <= 11 && 11 < PHR(hi)) SEAM(11);
            if (RUN(12)) { refresh(F);
                pg8::DenseSched<F8_WO != 0> S{(const char*)(ws + WS_HB), (const char*)(ws + WS_WO), NLAT / 256, 2048 / 256, 2048, F.G, F.bx, 0x79797979, 0x7c7c7c7c};
                pg8::EpiRes<false> E{nullptr, nullptr, (bf16_t*)(ws + WS_XR), mod + (size_t)17 * MODW + 4096};
                pg8::gemm_run(F.lds, F.wave, 2048, S, E);
            } if (PHR(lo) <= 12 && 12 < PHR(hi)) SEAM(12);
        }
        if (RUN(base)) { refresh(F);
#if MK_TAILFILL
            tail_fill(F, p, l, 0, true); refresh(F);
#endif
            row_phase<1>(F, p, l, 0); } if (PHR(lo) <= base && base < PHR(hi)) SEAM(base);
        if (RUN(base + 1)) { refresh(F);
            moe_setup(F, l);
            pg8::MoeSched<true> S{(const char*)(ws + WS_HB), (const char*)(ws + WS_WGU) + (size_t)l * WGU_LSTRIDE, (size_t)2048 * 2048,
                                  (const LAS int*)(F.lds + LX_PRE), (const LAS int*)(F.lds + LX_CNT), (const int*)(ws + WS_LIST), 2048, F.G, F.bx, 0x79797979, 0x7f7f7f7f};
            pg8::EpiGU E{ws + WS_HID};
            REP(7) pg8::gemm_run(F.lds, F.wave, 2048, S, E);
#if MK_TAILFILL
            if (l == 0) { refresh(F); tail_fill(F, p, 1, 2, false); }
#endif
        } if (PHR(lo) <= base + 1 && base + 1 < PHR(hi)) SEAM(base + 1);
        if (RUN(base + 2)) { refresh(F);
            moe_setup(F, l);
            pg8::MoeSched<false> S{(const char*)(ws + WS_HID), (const char*)(ws + WS_WD) + (size_t)l * WD_LSTRIDE, (size_t)2048 * 1024,
                                   (const LAS int*)(F.lds + LX_PRE), (const LAS int*)(F.lds + LX_CNT), (const int*)(ws + WS_LIST), 1024, F.G, F.bx, 0x79797979, 0x7d7d7d7d};
            pg8::EpiDN E{(bf16_t*)(ws + WS_R1), (const int*)(ws + WS_LIST), (const float*)(ws + WS_LISTG)};
            REP(8) pg8::gemm_run(F.lds, F.wave, 1024, S, E);
#if MK_TAILFILL
#endif
        } if (PHR(lo) <= base + 2 && base + 2 < PHR(hi)) SEAM(base + 2);
        if (l == 0) { if (RUN(9)) { refresh(F); row_phase<2>(F, p, 0, 0); } if (PHR(lo) <= 9 && 9 < PHR(hi)) SEAM(9); }
        else { if (RUN(16)) { refresh(F); REP(16) row_phase<3>(F, p, 1, p.fin_mode); } }
    }
    (void)ph;
#undef RUN
#undef SEAM
}

extern "C" void kernel_launch(void* const* d_in, const int* in_sizes, int n_in, void* d_out, int out_size, void* d_ws, size_t ws_size, hipStream_t stream) {
    static int grid = 0;
    if (grid == 0) {
        if (n_in != 31 || in_sizes[0] != NLAT * D || out_size != NLAT * D || ws_size < WS_END) {
            fprintf(stderr, "kernel_launch: shape/workspace mismatch: n_in %d in0 %d out %d ws %zu (need %zu)\n", n_in, n_in > 0 ? in_sizes[0] : -1, out_size, ws_size, (size_t)WS_END); grid = -1; return; }
        int dev = 0, cus = 0, per_cu = 0;
        if (hipGetDevice(&dev) != hipSuccess || hipDeviceGetAttribute(&cus, hipDeviceAttributeMultiprocessorCount, dev) != hipSuccess) { grid = -1; return; }
        if (hipFuncSetAttribute((const void*)mega_fwd, hipFuncAttributeMaxDynamicSharedMemorySize, LDS_BYTES) != hipSuccess) { fprintf(stderr, "kernel_launch: hipFuncSetAttribute failed\n"); grid = -1; return; }
        if (hipOccupancyMaxActiveBlocksPerMultiprocessor(&per_cu, (const void*)mega_fwd, 512, LDS_BYTES) != hipSuccess || per_cu < 1)
            fprintf(stderr, "kernel_launch: occupancy query reports %d blocks per CU\n", per_cu);
        (void)hipGetLastError();
        grid = cus;
    }
    if (grid < 0) return;
    (void)hipMemsetAsync((char*)d_ws + WS_CTL, 0, CTL_BYTES, stream);
    Params p{};
    for (int i = 0; i < 31; ++i) p.in[i] = (const float*)d_in[i];
    p.out = (float*)d_out; p.ws = (unsigned char*)d_ws;
    p.stop = MK_STOP;
    p.fin_mode = (MK_STOP >= NPHASE - 1) ? 0 : (MK_STOP <= 5 ? 2 : 1);
#if MK_LAUNCHES
    for (int ph = 0; ph < NPHASE; ++ph) {
        if (!(ph < MK_STOP || ph == NPHASE - 1)) continue;
        p.ph_lo = ph; p.ph_hi = ph + 1;
        hipLaunchKernelGGL(mega_fwd, dim3(grid), dim3(512), LDS_BYTES, stream, p);
    }
#else
    p.ph_lo = 0; p.ph_hi = NPHASE;
    hipLaunchKernelGGL(mega_fwd, dim3(grid), dim3(512), LDS_BYTES, stream, p);
#endif
    const hipError_t le = hipPeekAtLastError();
    if (le != hipSuccess) fprintf(stderr, "kernel_launch: launch failed: %s\n", hipGetErrorName(le));
}
```
